# Optimizing an MI355X kernel written in HIP

```python
import math
import jax, jax.numpy as jnp
from jax import lax
import numpy as np

D_MODEL = 1024
BATCH = 16
SEQ = 4096
DEPTH = 2

ATTN_WIDTH = D_MODEL // 2
ATTN_HEAD_DIM = 64
N_ATTN_HEADS = ATTN_WIDTH // ATTN_HEAD_DIM
Q_BLOCK = 128
SSM_WIDTH = D_MODEL // 4
SSM_GROUP_CH = 16
SSM_GROUPS = SSM_WIDTH // SSM_GROUP_CH
SSM_STATE = 64
POOL_WIDTH = D_MODEL // 4
POOL_WINDOWS = (2, 4, 8, 16)
POOL_GROUPS = len(POOL_WINDOWS)
POOL_CH = POOL_WIDTH // POOL_GROUPS
N_BRANCHES = 3
D_FF = 4 * D_MODEL
NORM_EPS = 1e-6
IN_SPLITS = (ATTN_WIDTH, ATTN_WIDTH, ATTN_WIDTH, N_ATTN_HEADS, SSM_WIDTH, POOL_WIDTH, N_BRANCHES * D_MODEL)
IN_COLS = sum(IN_SPLITS)
IN_OFFSETS = tuple(int(o) for o in np.cumsum(IN_SPLITS)[:-1])

kernel_name = 'hybrid_fox_s5_pool_gated_trunk'


def _rms_norm(x, gain):
    xf = x.astype(jnp.float32)
    y = xf * lax.rsqrt(jnp.mean(xf * xf, axis=-1, keepdims=True) + NORM_EPS)
    return y * gain.astype(jnp.float32)


def _forgetting_attention(q, k, v, f_logit, q_gain, k_gain):
    b, s, h, dh = q.shape
    q = _rms_norm(q, q_gain) * (dh ** -0.5)
    k = _rms_norm(k, k_gain)
    v = v.astype(jnp.float32)
    cum = jnp.cumsum(jax.nn.log_sigmoid(f_logit.astype(jnp.float32)), axis=1)
    cum = cum.transpose(0, 2, 1)
    n_blk = s // Q_BLOCK
    q_blocks = q.reshape(b, n_blk, Q_BLOCK, h, dh).transpose(1, 0, 2, 3, 4)
    c_blocks = cum.reshape(b, h, n_blk, Q_BLOCK).transpose(2, 0, 1, 3)
    k_pos = jnp.arange(s)

    def one_block(args):
        blk, qb, cb = args
        q_pos = blk * Q_BLOCK + jnp.arange(Q_BLOCK)
        logits = jnp.einsum('bqhd,bkhd->bhqk', qb, k) + (cb[..., :, None] - cum[..., None, :])
        logits = jnp.where(k_pos[None, :] <= q_pos[:, None], logits, -jnp.inf)
        p = jax.nn.softmax(logits, axis=-1)
        return jnp.einsum('bhqk,bkhd->bqhd', p, v)

    out = lax.map(one_block, (jnp.arange(n_blk), q_blocks, c_blocks))
    return out.transpose(1, 0, 2, 3, 4).reshape(b, s, h * dh)


def _s5_mixer(u, a_re, a_im, log_dt, b_re, b_im, c_re, c_im, d, w_glu):
    bsz, s, _ = u.shape
    f32 = jnp.float32
    uf = u.astype(f32)
    ug = uf.reshape(bsz, s, SSM_GROUPS, SSM_GROUP_CH)
    a_re, a_im = a_re.astype(f32), a_im.astype(f32)
    b_re, b_im = b_re.astype(f32), b_im.astype(f32)
    c_re, c_im = c_re.astype(f32), c_im.astype(f32)
    dt = jnp.exp(log_dt.astype(f32))[:, None]
    mag = jnp.exp(a_re * dt)
    ab_re = mag * jnp.cos(a_im * dt)
    ab_im = mag * jnp.sin(a_im * dt)
    den = a_re * a_re + a_im * a_im
    nr, ni = ab_re - 1.0, ab_im
    coef_re = ((nr * a_re + ni * a_im) / den)[..., None]
    coef_im = ((ni * a_re - nr * a_im) / den)[..., None]
    bb_re = coef_re * b_re - coef_im * b_im
    bb_im = coef_re * b_im + coef_im * b_re
    bu_re = jnp.einsum('gnc,bsgc->bsgn', bb_re, ug)
    bu_im = jnp.einsum('gnc,bsgc->bsgn', bb_im, ug)
    a_seq_re = jnp.broadcast_to(ab_re, (1, s, SSM_GROUPS, SSM_STATE))
    a_seq_im = jnp.broadcast_to(ab_im, (1, s, SSM_GROUPS, SSM_STATE))

    def combine(e1, e2):
        a1r, a1i, b1r, b1i = e1
        a2r, a2i, b2r, b2i = e2
        return (a1r * a2r - a1i * a2i,
                a1r * a2i + a1i * a2r,
                a2r * b1r - a2i * b1i + b2r,
                a2r * b1i + a2i * b1r + b2i)

    _, _, x_re, x_im = lax.associative_scan(combine, (a_seq_re, a_seq_im, bu_re, bu_im), axis=1)
    y = jnp.einsum('gcn,bsgn->bsgc', c_re, x_re) - jnp.einsum('gcn,bsgn->bsgc', c_im, x_im)
    y = y.reshape(bsz, s, SSM_WIDTH) + d.astype(f32) * uf
    y = jax.nn.gelu(y)
    g_a, g_b = jnp.split(y @ w_glu.astype(f32), 2, axis=-1)
    return g_a * jax.nn.sigmoid(g_b)


def _multiscale_pool(p, pool_w, pool_scale):
    bsz, s, _ = p.shape
    pf = p.astype(jnp.float32)
    positions = jnp.arange(1, s + 1, dtype=jnp.float32)
    outs = []
    for g, w in enumerate(POOL_WINDOWS):
        pg = pf[..., g * POOL_CH:(g + 1) * POOL_CH]
        cs = jnp.cumsum(pg, axis=1)
        lagged = jnp.pad(cs, ((0, 0), (w, 0), (0, 0)))[:, :s]
        mean = (cs - lagged) / jnp.minimum(positions, w)[None, :, None]
        outs.append(mean - pg)
    pooled = jnp.stack(outs, axis=2)
    mixed = jnp.einsum('bsgc,gcd->bsgd', pooled, pool_w.astype(jnp.float32))
    return mixed.reshape(bsz, s, POOL_WIDTH) * pool_scale.astype(jnp.float32)


def setup_inputs(seed: int = 0) -> dict:
    key = jax.random.key(seed)
    ks = jax.random.split(key, 32)
    f32 = jnp.float32
    L = DEPTH
    nrm = lambda k, shape, scale: jax.random.normal(k, shape, f32) * scale
    a_im_base = math.pi * jnp.arange(SSM_STATE, dtype=f32)
    return {
        'x': nrm(ks[0], (BATCH, SEQ, D_MODEL), 1.0),
        'mix_norm': 1.0 + nrm(ks[1], (L, D_MODEL), 0.02),
        'w_in': nrm(ks[2], (L, D_MODEL, IN_COLS), D_MODEL ** -0.5),
        'b_forget': jax.random.uniform(ks[3], (L, N_ATTN_HEADS), f32, 1.0, 5.0),
        'q_norm': 1.0 + nrm(ks[4], (L, ATTN_HEAD_DIM), 0.02),
        'k_norm': 1.0 + nrm(ks[5], (L, ATTN_HEAD_DIM), 0.02),
        'ssm_a_re': -0.5 + nrm(ks[6], (L, SSM_GROUPS, SSM_STATE), 0.01),
        'ssm_a_im': a_im_base + nrm(ks[7], (L, SSM_GROUPS, SSM_STATE), 0.01),
        'ssm_log_dt': jax.random.uniform(ks[8], (L, SSM_GROUPS), f32, math.log(1e-3), math.log(1e-1)),
        'ssm_b_re': nrm(ks[9], (L, SSM_GROUPS, SSM_STATE, SSM_GROUP_CH), (2 * SSM_GROUP_CH) ** -0.5),
        'ssm_b_im': nrm(ks[10], (L, SSM_GROUPS, SSM_STATE, SSM_GROUP_CH), (2 * SSM_GROUP_CH) ** -0.5),
        'ssm_c_re': nrm(ks[11], (L, SSM_GROUPS, SSM_GROUP_CH, SSM_STATE), SSM_STATE ** -0.5),
        'ssm_c_im': nrm(ks[12], (L, SSM_GROUPS, SSM_GROUP_CH, SSM_STATE), SSM_STATE ** -0.5),
        'ssm_d': nrm(ks[13], (L, SSM_WIDTH), 1.0),
        'w_glu': nrm(ks[14], (L, SSM_WIDTH, 2 * SSM_WIDTH), SSM_WIDTH ** -0.5),
        'pool_w': nrm(ks[15], (L, POOL_GROUPS, POOL_CH, POOL_CH), POOL_CH ** -0.5),
        'pool_scale': 1.0 + nrm(ks[16], (L, POOL_WIDTH), 0.02),
        'w_br_attn': nrm(ks[17], (L, ATTN_WIDTH, D_MODEL), ATTN_WIDTH ** -0.5),
        'w_br_ssm': nrm(ks[18], (L, SSM_WIDTH, D_MODEL), SSM_WIDTH ** -0.5),
        'w_br_pool': nrm(ks[19], (L, POOL_WIDTH, D_MODEL), POOL_WIDTH ** -0.5),
        'b_gate': nrm(ks[20], (L, N_BRANCHES * D_MODEL), 0.01),
        'w_out': nrm(ks[21], (L, D_MODEL, D_MODEL), D_MODEL ** -0.5),
        'mlp_norm': 1.0 + nrm(ks[22], (L, D_MODEL), 0.02),
        'w_up': nrm(ks[23], (L, D_MODEL, D_FF), D_MODEL ** -0.5),
        'w_down': nrm(ks[24], (L, D_FF, D_MODEL), D_FF ** -0.5),
    }


def reference(x, mix_norm, w_in, b_forget, q_norm, k_norm, ssm_a_re, ssm_a_im, ssm_log_dt,
              ssm_b_re, ssm_b_im, ssm_c_re, ssm_c_im, ssm_d, w_glu, pool_w, pool_scale,
              w_br_attn, w_br_ssm, w_br_pool, b_gate, w_out, mlp_norm, w_up, w_down):
    bsz, s, _ = x.shape
    dt = x.dtype
    for l in range(DEPTH):
        h = _rms_norm(x, mix_norm[l]).astype(dt)
        z = h @ w_in[l]
        q, k, v, f_logit, u_ssm, u_pool, gate_logit = jnp.split(z, IN_OFFSETS, axis=-1)
        heads = (bsz, s, N_ATTN_HEADS, ATTN_HEAD_DIM)
        y_attn = _forgetting_attention(q.reshape(heads), k.reshape(heads), v.reshape(heads),
                                       f_logit + b_forget[l], q_norm[l], k_norm[l]).astype(dt)
        y_ssm = _s5_mixer(u_ssm, ssm_a_re[l], ssm_a_im[l], ssm_log_dt[l], ssm_b_re[l], ssm_b_im[l],
                          ssm_c_re[l], ssm_c_im[l], ssm_d[l], w_glu[l]).astype(dt)
        y_pool = _multiscale_pool(u_pool, pool_w[l], pool_scale[l]).astype(dt)
        gates = jax.nn.sigmoid(gate_logit.astype(jnp.float32) + b_gate[l].astype(jnp.float32))
        gates = gates.reshape(bsz, s, N_BRANCHES, D_MODEL)
        merged = (gates[:, :, 0] * (y_attn @ w_br_attn[l])
                  + gates[:, :, 1] * (y_ssm @ w_br_ssm[l])
                  + gates[:, :, 2] * (y_pool @ w_br_pool[l]))
        x = (x + merged.astype(dt) @ w_out[l]).astype(dt)
        h = _rms_norm(x, mlp_norm[l]).astype(dt)
        act = jnp.square(jax.nn.relu(h @ w_up[l]))
        x = (x + act @ w_down[l]).astype(dt)
    return x
```

```cpp
#include <hip/hip_runtime.h>
#include <hip/hip_cooperative_groups.h>
#include <cstdio>
#include <cstdint>
namespace pg8 {
#define PG8_LAS __attribute__((address_space(3)))
typedef unsigned short bf16_t;
typedef short bf16x8 __attribute__((ext_vector_type(8)));
typedef float f32x4 __attribute__((ext_vector_type(4)));
typedef unsigned u32x4 __attribute__((ext_vector_type(4)));
constexpr int BM = 256, BK = 64, HALF = 128, HTB = HALF * BK * 2  , STAGE_BYTES = 8 * HTB, NXCD = 8, WGM = 8;

__host__ __device__ __forceinline__ int lds_byte(int r, int c) { const int st = (r >> 4) * 2 + (c >> 5), rr = r & 15, cc = c & 31, ob = rr * 64 + cc * 2; return st * 1024 + (ob ^ (((ob >> 9) & 1) << 5)); }
__host__ __device__ __forceinline__ void stage_rc(int b, int& R, int& C) { const int st = b / 1024, sb = b % 1024, swz = sb ^ (((sb >> 9) & 1) << 5); R = (st >> 1) * 16 + swz / 64; C = (st & 1) * 32 + (swz % 64) / 2; }
__host__ __device__ __forceinline__ int perm32(int rho) { const int n = rho >> 4, i = rho & 15; return 8 * (i >> 2) + 4 * n + (i & 3); }

struct Unit { int pm, pn; };
struct Gemm { const bf16_t* A; const bf16_t* Bt; int M, N, K, lda, ldb; };

struct StaticOrder {
    int nM, nN, nwg, G, c;
    __host__ __device__ void init(int M, int N, int G_, int c_) { nM = M / BM; nN = N / BM; nwg = nM * nN; G = G_; c = c_; }
    __host__ __device__ bool next(int i, Unit& u) const {
        const long L = (long)i * G + c; if (L >= nwg) return false;
        int wgid = (int)L; { const int q = nwg / NXCD, r = nwg % NXCD, xcd = wgid % NXCD, off = wgid / NXCD; wgid = (xcd < r ? xcd * (q + 1) : r * (q + 1) + (xcd - r) * q) + off; }
        const int nig = WGM * nN, gid = wgid / nig, fm = gid * WGM, gsz = (nM - fm) < WGM ? (nM - fm) : WGM;
        u.pm = fm + ((wgid % nig) % gsz); u.pn = (wgid % nig) / gsz; return true;
    }
    __device__ __forceinline__ void a_ready(const Unit&) const {}
    __device__ __forceinline__ void done(const Unit&) const {}
};

__device__ __forceinline__ unsigned cvt_pk_bf16(float lo, float hi) { unsigned r; asm volatile("v_cvt_pk_bf16_f32 %0, %1, %2" : "=v"(r) : "v"(lo), "v"(hi)); return r; }
typedef float f32x2 __attribute__((ext_vector_type(2)));
__device__ __forceinline__ f32x2 gelu_pk(f32x2 v) {
    const f32x2 av = __builtin_elementwise_abs(v), d = av * 0.2316418882f + 1.0f;
    f32x2 t; t.x = __builtin_amdgcn_rcpf(d.x); t.y = __builtin_amdgcn_rcpf(d.y);
    f32x2 q = t * 0.5307027145f + (-0.7265760135f); q = q * t + 0.7107068705f; q = q * t + (-0.142248368f); q = q * t + 0.127414796f; q = q * t;
    const f32x2 s = (v * v) * (-0.72134752044f);
    f32x2 e; e.x = __builtin_amdgcn_exp2f(s.x); e.y = __builtin_amdgcn_exp2f(s.y);
    const f32x2 m = v * (q * e), r = v - m;
    f32x2 o; o.x = v.x < 0.f ? m.x : r.x; o.y = v.y < 0.f ? m.y : r.y; return o;
}

template <int ACT  > struct EpiBf16 {
    static constexpr bool PERM = true, AFTER_DRAIN = false; static_assert(ACT == 0 || ACT == 1, "EpiBf16: ACT is 0 (none) or 1 (gelu_pk)");
    bf16_t* O; int ldc; const float* bias; int split_cols; size_t split_stride; float scale0;
    __device__ __forceinline__ void operator()(const f32x4 (&acc)[2][2][4][2], const Unit& u, int wr, int wc, int fr, int fq) const {
        const int row0 = u.pm * BM + wr * 64 + fr; int colt = u.pn * BM; bf16_t* base = O;
        float sc = 1.f; if (split_cols) { const int t = colt / split_cols; base += (size_t)t * split_stride; colt -= t * split_cols; if (t == 0) sc = scale0; }
        const int col0 = colt + wc * 32 + 8 * fq, bcol0 = u.pn * BM + wc * 32 + 8 * fq;
        f32x4 bv[2][2];
#pragma unroll
        for (int bj = 0; bj < 2; ++bj)
#pragma unroll
            for (int n = 0; n < 2; ++n) bv[bj][n] = bias ? *(const f32x4*)(bias + bcol0 + bj * HALF + 4 * n) : (f32x4){0.f, 0.f, 0.f, 0.f};
#pragma unroll
        for (int ai = 0; ai < 2; ++ai)
#pragma unroll
            for (int m = 0; m < 4; ++m) { bf16_t* rowp = base + (size_t)(row0 + ai * HALF + m * 16) * ldc + col0;
#pragma unroll
                for (int bj = 0; bj < 2; ++bj) { f32x4 v0 = acc[ai][bj][m][0] + bv[bj][0], v1 = acc[ai][bj][m][1] + bv[bj][1];
                    if (ACT == 1) { f32x2 a = gelu_pk((f32x2){v0[0], v0[1]}), b = gelu_pk((f32x2){v0[2], v0[3]}), c = gelu_pk((f32x2){v1[0], v1[1]}), d = gelu_pk((f32x2){v1[2], v1[3]});
                        v0 = (f32x4){a.x, a.y, b.x, b.y}; v1 = (f32x4){c.x, c.y, d.x, d.y}; }
                    v0 = v0 * sc; v1 = v1 * sc; u32x4 w; w.x = cvt_pk_bf16(v0[0], v0[1]); w.y = cvt_pk_bf16(v0[2], v0[3]); w.z = cvt_pk_bf16(v1[0], v1[1]); w.w = cvt_pk_bf16(v1[2], v1[3]);
                    *(u32x4*)(rowp + bj * HALF) = w; } }
    }
};


template <class Epi, class Sched, bool ALIGN_EPI = false, bool SP2 = false>
__device__ __forceinline__ void gemm_phase(PG8_LAS unsigned char* lds, const Gemm g, const Sched& S, const Epi& E) {
    int tid_l = threadIdx.x; asm volatile("" : "+v"(tid_l));
    const int tid = tid_l, wid = __builtin_amdgcn_readfirstlane(tid >> 6), lane = tid & 63, wr = wid >> 2, wc = wid & 3, fr = lane & 15, fq = lane >> 4;
    const int K = g.K, nt = K / BK;
    unsigned voffA[2], voffB[2];
#pragma unroll
    for (int i = 0; i < 2; ++i) { int R, C; stage_rc(tid * 16 + i * 8192, R, C); const int Rb = Epi::PERM ? ((R & ~31) + perm32(R & 31)) : R;
        voffA[i] = (unsigned)(R * g.lda + C) * 2u; voffB[i] = (unsigned)(Rb * g.ldb + C) * 2u; }
    const size_t kstep = (size_t)(BK * 2);
    const size_t hstepA = (size_t)HALF * g.lda * 2, hstepB = (size_t)HALF * g.ldb * 2;
    const size_t tstepA = 2 * hstepA, tstepB = 2 * hstepB;
    const unsigned ldsw = (unsigned)wid * 1024u;
    const int aoff = lds_byte(wr * 64 + fr, fq * 8), boff = lds_byte(wc * 32 + fr, fq * 8);
#define PG8_SA(b, h) (((b) * 2 + (h)) * HTB)
#define PG8_SB(b, h) ((4 + (b) * 2 + (h)) * HTB)
#define PG8_STAGE(bufoff, gbase, voff) do { _Pragma("unroll") for (int _i = 0; _i < 2; ++_i) \
        __builtin_amdgcn_global_load_lds((const unsigned*)((const char*)(gbase) + (voff)[_i]), (PG8_LAS unsigned*)(lds + (bufoff) + ldsw + _i * 8192), 16, 0, 0); } while (0)
#define PG8_LDA(dst, b, h) do { _Pragma("unroll") for (int m = 0; m < 4; ++m) _Pragma("unroll") for (int k = 0; k < 2; ++k) dst[m][k] = *(const PG8_LAS bf16x8*)(lds + PG8_SA(b, h) + aoff + m * 2048 + k * 1024); } while (0)
#define PG8_LDB(dst, b, h) do { _Pragma("unroll") for (int n = 0; n < 2; ++n) _Pragma("unroll") for (int k = 0; k < 2; ++k) dst[n][k] = *(const PG8_LAS bf16x8*)(lds + PG8_SB(b, h) + boff + n * 2048 + k * 1024); } while (0)
#define PG8_MMA(ai, bj, At, Bt) do { __builtin_amdgcn_s_setprio(1); _Pragma("unroll") for (int m = 0; m < 4; ++m) _Pragma("unroll") for (int n = 0; n < 2; ++n) _Pragma("unroll") for (int k = 0; k < 2; ++k) \
        acc[ai][bj][m][n] = __builtin_amdgcn_mfma_f32_16x16x32_bf16(Bt[n][k], At[m][k], acc[ai][bj][m][n], 0, 0, 0); __builtin_amdgcn_s_setprio(0); } while (0)
#define PG8_WAIT_V(n) asm volatile("s_waitcnt vmcnt(" #n ")" ::: "memory")
#define PG8_WAIT_L(n) asm volatile("s_waitcnt lgkmcnt(" #n ")" ::: "memory")
#define PG8_BAR __builtin_amdgcn_s_barrier()
#define PG8_SCHED __builtin_amdgcn_sched_barrier(0)
    Unit cur, nxt; int ui = 0;
    if (!S.next(0, cur)) return;
    f32x4 acc[2][2][4][2];
#pragma unroll
    for (int a = 0; a < 2; ++a)
#pragma unroll
        for (int b = 0; b < 2; ++b)
#pragma unroll
            for (int m = 0; m < 4; ++m)
#pragma unroll
                for (int n = 0; n < 2; ++n) acc[a][b][m][n] = (f32x4){0.f, 0.f, 0.f, 0.f};
    bf16x8 At[4][2], B0[2][2], B1[2][2];
    const char* cA = (const char*)g.A + (size_t)cur.pm * tstepA; const char* cB = (const char*)g.Bt + (size_t)cur.pn * tstepB;
    S.a_ready(cur);
    if constexpr (SP2) {
        PG8_STAGE(PG8_SB(0, 0), cB, voffB); PG8_STAGE(PG8_SB(0, 1), cB + hstepB, voffB); PG8_STAGE(PG8_SA(0, 0), cA, voffA); PG8_STAGE(PG8_SA(0, 1), cA + hstepA, voffA);
        if (wr == 1) PG8_BAR;
        PG8_WAIT_V(2); PG8_BAR;
        PG8_STAGE(PG8_SB(1, 0), cB + kstep, voffB); PG8_STAGE(PG8_SA(1, 0), cA + kstep, voffA); PG8_STAGE(PG8_SB(1, 1), cB + hstepB + kstep, voffB);
        PG8_WAIT_V(6); PG8_BAR;
    } else {
        PG8_STAGE(PG8_SB(0, 0), cB, voffB); PG8_STAGE(PG8_SA(0, 0), cA, voffA); PG8_STAGE(PG8_SB(0, 1), cB + hstepB, voffB); PG8_STAGE(PG8_SA(0, 1), cA + hstepA, voffA);
        if (wr == 1) PG8_BAR;
        PG8_WAIT_V(4); PG8_BAR;
        PG8_STAGE(PG8_SB(1, 0), cB + kstep, voffB); PG8_STAGE(PG8_SA(1, 0), cA + kstep, voffA); PG8_STAGE(PG8_SB(1, 1), cB + hstepB + kstep, voffB);
        PG8_WAIT_V(6); PG8_BAR;
    }
    for (;;) {
        const bool has_next = S.next(ui + 1, nxt);
        const char* nA = has_next ? (const char*)g.A + (size_t)nxt.pm * tstepA : cA; const char* nB = has_next ? (const char*)g.Bt + (size_t)nxt.pn * tstepB : cB;
#pragma unroll 1
        for (int t = 0; t < nt; t += 2) {
            const bool last = (t == nt - 2);
            const char* a1 = cA + (size_t)(t + 1) * kstep;
            const char* a2 = last ? nA : cA + (size_t)(t + 2) * kstep; const char* b2 = last ? nB : cB + (size_t)(t + 2) * kstep;
            const char* a3 = a2 + kstep; const char* b3 = b2 + kstep;
            if (last && has_next) S.a_ready(nxt);
            if constexpr (SP2) {
            PG8_LDB(B0, 0, 0); PG8_LDB(B1, 0, 1); PG8_SCHED; PG8_LDA(At, 0, 0); PG8_STAGE(PG8_SA(1, 1), a1 + hstepA, voffA);
            PG8_WAIT_V(8); PG8_WAIT_L(0); PG8_BAR; PG8_MMA(0, 0, At, B0); PG8_MMA(0, 1, At, B1); PG8_BAR; PG8_SCHED;
            PG8_LDA(At, 0, 1); PG8_STAGE(PG8_SB(0, 0), b2, voffB); PG8_STAGE(PG8_SB(0, 1), b2 + hstepB, voffB); PG8_STAGE(PG8_SA(0, 0), a2, voffA);
            PG8_WAIT_V(8); PG8_WAIT_L(0); PG8_BAR; PG8_MMA(1, 0, At, B0); PG8_MMA(1, 1, At, B1); PG8_BAR; PG8_SCHED;
            PG8_LDB(B0, 1, 0); PG8_LDB(B1, 1, 1); PG8_SCHED; PG8_LDA(At, 1, 0); PG8_STAGE(PG8_SA(0, 1), a2 + hstepA, voffA);
            PG8_WAIT_V(8); PG8_WAIT_L(0); PG8_BAR; PG8_MMA(0, 0, At, B0); PG8_MMA(0, 1, At, B1); PG8_BAR; PG8_SCHED;
            PG8_LDA(At, 1, 1); PG8_STAGE(PG8_SB(1, 0), b3, voffB); PG8_STAGE(PG8_SB(1, 1), b3 + hstepB, voffB); PG8_STAGE(PG8_SA(1, 0), a3, voffA);
            PG8_WAIT_V(8); PG8_WAIT_L(0); PG8_BAR; PG8_MMA(1, 0, At, B0); PG8_MMA(1, 1, At, B1); PG8_BAR; PG8_SCHED;
            } else {
            PG8_LDB(B0, 0, 0); PG8_SCHED; PG8_LDA(At, 0, 0); PG8_STAGE(PG8_SA(1, 1), a1 + hstepA, voffA);
            PG8_WAIT_L(8); PG8_BAR; PG8_WAIT_L(0); PG8_MMA(0, 0, At, B0); PG8_BAR; PG8_SCHED;
            PG8_LDB(B1, 0, 1); PG8_STAGE(PG8_SB(0, 0), b2, voffB);
            PG8_BAR; PG8_WAIT_L(0); PG8_MMA(0, 1, At, B1); PG8_BAR;
            PG8_LDA(At, 0, 1); PG8_STAGE(PG8_SA(0, 0), a2, voffA);
            PG8_BAR; PG8_WAIT_L(0); PG8_MMA(1, 0, At, B0); PG8_BAR; PG8_SCHED;
            PG8_STAGE(PG8_SB(0, 1), b2 + hstepB, voffB);
            PG8_WAIT_V(6); PG8_BAR; PG8_MMA(1, 1, At, B1); PG8_BAR;
            PG8_LDB(B0, 1, 0); PG8_SCHED; PG8_LDA(At, 1, 0); PG8_STAGE(PG8_SA(0, 1), a2 + hstepA, voffA);
            PG8_WAIT_L(8); PG8_BAR; PG8_WAIT_L(0); PG8_MMA(0, 0, At, B0); PG8_BAR; PG8_SCHED;
            PG8_LDB(B1, 1, 1); PG8_STAGE(PG8_SB(1, 0), b3, voffB);
            PG8_BAR; PG8_WAIT_L(0); PG8_MMA(0, 1, At, B1); PG8_BAR;
            PG8_LDA(At, 1, 1); PG8_STAGE(PG8_SA(1, 0), a3, voffA);
            PG8_BAR; PG8_WAIT_L(0); PG8_MMA(1, 0, At, B0); PG8_BAR; PG8_SCHED;
            PG8_STAGE(PG8_SB(1, 1), b3 + hstepB, voffB);
            PG8_WAIT_V(6); PG8_BAR; PG8_MMA(1, 1, At, B1); PG8_BAR;
            }
        }
        if constexpr (ALIGN_EPI) { if (wr == 0) PG8_BAR; }
        if constexpr (!Epi::AFTER_DRAIN) { E(acc, cur, wr, wc, fr, fq); S.done(cur); }
        if (!has_next) break;
#pragma unroll
        for (int a = 0; a < 2; ++a)
#pragma unroll
            for (int b = 0; b < 2; ++b)
#pragma unroll
                for (int m = 0; m < 4; ++m)
#pragma unroll
                    for (int n = 0; n < 2; ++n) acc[a][b][m][n] = (f32x4){0.f, 0.f, 0.f, 0.f};
        cur = nxt; cA = nA; cB = nB; ++ui;
        if constexpr (ALIGN_EPI) { if (wr == 1) PG8_BAR; }
    }
    PG8_WAIT_V(0);
    if constexpr (!ALIGN_EPI) { if (wr == 0) PG8_BAR; }
    PG8_BAR;
    if constexpr (Epi::AFTER_DRAIN) { E.fused(acc, cur, wr, wc, fr, fq, lds, wid, lane); S.done(cur); }
#undef PG8_SA
#undef PG8_SB
#undef PG8_STAGE
#undef PG8_LDA
#undef PG8_LDB
#undef PG8_MMA
#undef PG8_WAIT_V
#undef PG8_WAIT_L
#undef PG8_BAR
#undef PG8_SCHED
}
}
#include <hip/hip_bf16.h>
#include <cmath>
namespace attn_body {
using bf16=__hip_bfloat16;
using bf16x8=__attribute__((ext_vector_type(8)))short;
using s16x4=__attribute__((ext_vector_type(4)))short;
using f32x16=__attribute__((ext_vector_type(16)))float;
using u32x4=__attribute__((ext_vector_type(4)))unsigned;
using f32x4_t=__attribute__((ext_vector_type(4)))float;
constexpr int BATCH=16,NHEAD=8,SEQ=4096,D=64,DM=NHEAD*D;
constexpr int NW=8,QBLK=32,QB=QBLK*NW,KVBLK=64,NQB=SEQ/QB;
constexpr int ATTN_PITCH=DM, ATTN_UNIT_ROWS=QB;
__device__ __forceinline__ int crow(int r,int hi){return (r&3)+8*(r>>2)+4*hi;}
#define SBAR() __builtin_amdgcn_sched_barrier(0)
__device__ __forceinline__ void cmask(f32x16&p0,f32x16&p1,int jb,int qrel,int hi){
  const float NEG=-INFINITY; int kb=64*jb+4*hi;
  #pragma unroll
  for(int r=0;r<16;++r){int kv=kb+(r&3)+8*(r>>2); if(kv>qrel)p0[r]=NEG; if(kv+32>qrel)p1[r]=NEG;}
}

constexpr int NSLOT=3, SLOTB=8192;
constexpr int LDS_K=0, LDS_V=NSLOT*SLOTB, LDS_WS=2*NSLOT*SLOTB, LDS_OST=LDS_WS+NW*64*4, LDS_KB=LDS_OST+NW*4096, LDS_BYTES=LDS_KB+SEQ*4;
constexpr float C2=0.125f*1.4426950408889634f;
__device__ __forceinline__ void glds16(const void*gsrc,unsigned lds_dst){unsigned keep;
  asm volatile("s_mov_b32 %0, m0\n\ts_mov_b32 m0, %2\n\ts_nop 0\n\tglobal_load_lds_dwordx4 %1, off\n\ts_mov_b32 m0, %0":"=&s"(keep):"v"(gsrc),"s"(lds_dst):"memory");}
__device__ __forceinline__ float max3f(float a,float b,float c){float r;asm("v_max3_f32 %0, %1, %2, %3":"=v"(r):"v"(a),"v"(b),"v"(c));return r;}
__device__ __forceinline__ float max2f(float a,float b){float r;asm("v_max_f32_e32 %0, %1, %2":"=v"(r):"v"(a),"v"(b));return r;}
__device__ __forceinline__ float fadd_s(float a,float b){float r;asm("v_add_f32_e32 %0, %1, %2":"=v"(r):"v"(a),"v"(b));return r;}
__device__ __forceinline__ float fsub_s(float a,float b){float r;asm("v_sub_f32_e32 %0, %1, %2":"=v"(r):"v"(a),"v"(b));return r;}
typedef float f32x2_t __attribute__((ext_vector_type(2))); typedef __bf16 bf16x2_t __attribute__((ext_vector_type(2)));
__device__ __forceinline__ unsigned cvtpk_s(float lo,float hi){f32x2_t v={lo,hi};bf16x2_t b=__builtin_convertvector(v,bf16x2_t);return __builtin_bit_cast(unsigned,b);}
#define WAIT_BAR(N) asm volatile("s_waitcnt vmcnt(" #N ") lgkmcnt(0)\n\ts_barrier":::"memory")

__device__ __forceinline__ void qkt(f32x16&p0,f32x16&p1,const char*Kslot,const bf16x8*qr,int r32,int hi){
  const char*kb=Kslot+hi*1024+r32*16;
  #pragma unroll
  for(int d0=0;d0<4;++d0){
    const bf16x8 b0=*reinterpret_cast<const bf16x8*>(kb+d0*2048);
    const bf16x8 b1=*reinterpret_cast<const bf16x8*>(kb+d0*2048+512);
    {p0=__builtin_amdgcn_mfma_f32_32x32x16_bf16(b0,qr[d0],p0,0,0,0);p1=__builtin_amdgcn_mfma_f32_32x32x16_bf16(b1,qr[d0],p1,0,0,0);}}
}
typedef __attribute__((address_space(3))) const char* lds_cptr;
typedef short v4i16_t __attribute__((ext_vector_type(4)));
__device__ __forceinline__ void kload8(bf16x8*kf,lds_cptr kp){
  kf[0]=*(const __attribute__((address_space(3))) bf16x8*)(kp);      kf[1]=*(const __attribute__((address_space(3))) bf16x8*)(kp+512);
  kf[2]=*(const __attribute__((address_space(3))) bf16x8*)(kp+2048); kf[3]=*(const __attribute__((address_space(3))) bf16x8*)(kp+2560);
  kf[4]=*(const __attribute__((address_space(3))) bf16x8*)(kp+4096); kf[5]=*(const __attribute__((address_space(3))) bf16x8*)(kp+4608);
  kf[6]=*(const __attribute__((address_space(3))) bf16x8*)(kp+6144); kf[7]=*(const __attribute__((address_space(3))) bf16x8*)(kp+6656);
}
__device__ __forceinline__ void kload2(bf16x8*kf,lds_cptr kp,int j){ kf[2*j]=*(const __attribute__((address_space(3))) bf16x8*)(kp+j*2048); kf[2*j+1]=*(const __attribute__((address_space(3))) bf16x8*)(kp+j*2048+512); }
__device__ __forceinline__ s16x4 vtr(lds_cptr p){ return __builtin_bit_cast(s16x4,__builtin_amdgcn_ds_read_tr16_b64_v4i16((__attribute__((address_space(3))) v4i16_t*)p)); }
__device__ __forceinline__ float rowmax(const f32x16&p0,const f32x16&p1){
  float a=max3f(p0[0],p0[1],p1[0]),b=max3f(p0[2],p0[3],p1[1]);a=max3f(a,p1[2],p1[3]);
  #pragma unroll
  for(int r=4;r<16;r+=4){a=max3f(a,p0[r],p0[r+1]);b=max3f(b,p0[r+2],p0[r+3]);a=max3f(a,p1[r],p1[r+1]);b=max3f(b,p1[r+2],p1[r+3]);}
  const float m=max2f(a,b);
  auto rr=__builtin_amdgcn_permlane32_swap(__float_as_uint(m),__float_as_uint(m),false,false);
  return max2f(__uint_as_float(rr[0]),__uint_as_float(rr[1]));
}
__device__ __forceinline__ void pv(f32x16*o,int vb,bf16x8 pa0,bf16x8 pa1,bf16x8 pa2,bf16x8 pa3){
  #pragma unroll
  for(int d0=0;d0<2;++d0){s16x4 lo[4],hi[4];
    #pragma unroll
    for(int ks=0;ks<4;++ks){
      asm volatile("ds_read_b64_tr_b16 %0,%1 offset:%c2":"=&v"(lo[ks]):"v"(vb),"i"(d0*4096+ks*1024):"memory");
      asm volatile("ds_read_b64_tr_b16 %0,%1 offset:%c2":"=&v"(hi[ks]):"v"(vb),"i"(d0*4096+ks*1024+512):"memory");}
    asm volatile("s_waitcnt lgkmcnt(0)":::"memory");SBAR();
    #define PK(k) (bf16x8){lo[k][0],lo[k][1],lo[k][2],lo[k][3],hi[k][0],hi[k][1],hi[k][2],hi[k][3]}
    o[d0]=__builtin_amdgcn_mfma_f32_32x32x16_bf16(pa0,PK(0),o[d0],0,0,0);
    o[d0]=__builtin_amdgcn_mfma_f32_32x32x16_bf16(pa1,PK(1),o[d0],0,0,0);
    o[d0]=__builtin_amdgcn_mfma_f32_32x32x16_bf16(pa2,PK(2),o[d0],0,0,0);
    o[d0]=__builtin_amdgcn_mfma_f32_32x32x16_bf16(pa3,PK(3),o[d0],0,0,0);
    #undef PK
  }
}

#ifndef ATTN_STORE16
#define ATTN_STORE16(p,v) (*(u32x4*)(p)=(v))
#endif
template<int THRL> __device__ __forceinline__ void attn_unit(int b,int h,int qb,const bf16*Q,const bf16*__restrict__ K,const bf16*__restrict__ V,bf16*O,const float*__restrict__ KBG,char*shm){
  int tid_l=threadIdx.x; asm volatile("":"+v"(tid_l));
  const int tid=tid_l,lane=tid&63,r32=lane&31,hi=lane>>5; const int wid=__builtin_amdgcn_readfirstlane(tid>>6);
  const long rowbase=(long)b*SEQ; const int q0=qb*QB;
  const bf16*Qw=Q+(rowbase+q0+wid*QBLK)*DM+h*D;
  const bf16*Kh=K+rowbase*DM+h*D,*Vh=V+rowbase*DM+h*D;
  const lds_cptr shm3=(lds_cptr)shm;
  const unsigned lds0=(unsigned)(uintptr_t)shm;
  float*wsf=(float*)(shm+LDS_WS)+wid*64;
  const bf16*ksrc=Kh+(long)lane*DM+wid*8;
  const bf16*vsrc=Vh+(long)(16*(wid&3)+(lane>>2))*DM+(wid>>2)*32+(lane&3)*8;
  const unsigned kdst=lds0+LDS_K+wid*1024, vdst=lds0+LDS_V+wid*1024;
  #define DMA_K(t,slot) glds16(ksrc+(long)(t)*KVBLK*DM,(unsigned)__builtin_amdgcn_readfirstlane(kdst+(slot)))
  #define DMA_V(t,slot) glds16(vsrc+(long)(t)*KVBLK*DM,(unsigned)__builtin_amdgcn_readfirstlane(vdst+(slot)))
  const int vb0=(int)(lds0+LDS_V)+((lane>>4)&1)*32+(lane&3)*8+(4*hi+((lane&15)>>2))*64;
  const char*Kbase=shm+LDS_K; bf16x8 kf[8];
  const lds_cptr kp0=shm3+LDS_K+hi*1024+r32*16; const lds_cptr vp0=shm3+LDS_V+((lane>>4)&1)*32+(lane&3)*8+(4*hi+((lane&15)>>2))*64;
  const int NT=(q0+QB)/KVBLK;
  {
    const float*kg=KBG+((long)b*NHEAD+h)*SEQ; const float ref=kg[q0]; float*kbl=(float*)(shm+LDS_KB);
    for(int j=tid;j<q0+QB;j+=NW*64)kbl[j]=kg[j]-ref;
    asm volatile("s_waitcnt vmcnt(0) lgkmcnt(0)\n\ts_barrier":::"memory"); }
  const __attribute__((address_space(3))) float*kbp0=(const __attribute__((address_space(3))) float*)(shm3+LDS_KB)+4*hi;
  DMA_K(0,0);DMA_V(0,0);DMA_K(1,SLOTB);
  bf16x8 qr[4];
  #pragma unroll
  for(int d0=0;d0<4;++d0)qr[d0]=*reinterpret_cast<const bf16x8*>(&Qw[(long)r32*DM+d0*16+hi*8]);
  float mhat=0.f,l_reg=0.f;f32x16 o[2];o[0]=f32x16{};o[1]=f32x16{};
  const int qrel=wid*QBLK+r32;
  #define CMASK(P0,P1,t) do{int jb_=(t)-(NT-4); if(jb_>=0)cmask(P0,P1,jb_,qrel,hi);}while(0)
  #define KBP(t,i) (kbp0+64*(t)+(((i)<4)?8*(i):32+8*((i)-4)))
  #define KINIT(P0,P1,t,MH) do{ _Pragma("unroll") for(int k_=0;k_<4;++k_){ const f32x4_t a_=*(const __attribute__((address_space(3))) f32x4_t*)KBP(t,k_); const f32x4_t b_=*(const __attribute__((address_space(3))) f32x4_t*)KBP(t,k_+4); \
      P0[4*k_]=a_[0]-(MH);P0[4*k_+1]=a_[1]-(MH);P0[4*k_+2]=a_[2]-(MH);P0[4*k_+3]=a_[3]-(MH); P1[4*k_]=b_[0]-(MH);P1[4*k_+1]=b_[1]-(MH);P1[4*k_+2]=b_[2]-(MH);P1[4*k_+3]=b_[3]-(MH); } }while(0)
  #define KLD(G,t,i) do{ if(G){ kt##i=*(const __attribute__((address_space(3))) f32x4_t*)KBP((t)+1,i); } }while(0)
  #define KSUB(G,i,P) do{ if(G){ P[4*((i)&3)]=kt##i[0]-mhat; P[4*((i)&3)+1]=kt##i[1]-mhat; P[4*((i)&3)+2]=kt##i[2]-mhat; P[4*((i)&3)+3]=kt##i[3]-mhat; } }while(0)
  bool resc=false;
  #define START(P0,P1) do{ const float rm=rowmax(P0,P1); resc=false; \
    { const float dl=rm; mhat=fadd_s(mhat,dl); \
      _Pragma("unroll") for(int r=0;r<16;++r){P0[r]=fsub_s(P0[r],dl);P1[r]=fsub_s(P1[r],dl);} \
      } \
    _Pragma("unroll") for(int r=0;r<16;++r)P0[r]=__builtin_amdgcn_exp2f(P0[r]); }while(0)
  #define RESC() do{ if(resc){ asm volatile("s_waitcnt lgkmcnt(0)":::"memory"); \
      _Pragma("unroll") for(int d_=0;d_<2;++d_) _Pragma("unroll") for(int r=0;r<16;++r)o[d_][r]*=wsf[crow(r,hi)]; } }while(0)
  int sl_prev=0,sl_cur=0,sl_next=SLOTB;
  #define ROT() do{sl_prev=sl_cur;sl_cur=sl_next;sl_next=(sl_next==(NSLOT-1)*SLOTB)?0:sl_next+SLOTB;}while(0)
  DMA_K(2,2*SLOTB);
  WAIT_BAR(3);
  f32x16 pA0,pA1,pB0,pB1;
  KINIT(pA0,pA1,0,0.f);
  qkt(pA0,pA1,Kbase,qr,r32,hi);asm volatile("s_nop 15\n\ts_nop 7":"+v"(pA0),"+v"(pA1));CMASK(pA0,pA1,0);
  START(pA0,pA1);
  KINIT(pB0,pB1,1,mhat);
  _Pragma("unroll") for(int r=0;r<16;++r)pA1[r]=__builtin_amdgcn_exp2f(pA1[r]);
  WAIT_BAR(0);
  DMA_K(3,0);DMA_V(1,SLOTB);
  ROT();
  kload8(kf,kp0+sl_cur);
  WAIT_BAR(2);
  s16x4 vlo[8],vhi[8]; u32x4 pw0,pw1,pw2,pw3;
  #define PKW(P,B) cvtpk_s(P[B],P[B+1])
  #define PAF(k) __builtin_bit_cast(bf16x8,pw##k)
  #define VFR(i) (bf16x8){vlo[i][0],vlo[i][1],vlo[i][2],vlo[i][3],vhi[i][0],vhi[i][1],vhi[i][2],vhi[i][3]}
  #define PIN(x) asm volatile("":"+v"(x))
  #define MX3(a,b,c) __builtin_fmaxf(__builtin_fmaxf((a),(b)),(c))
  #define GAPA(MF,A0,A1,A2,A3,W0,W1,PW) do{ MF; sacc+=A0; sacc+=A1; sacc+=A2; sacc+=A3; PIN(sacc); W0; W1; PIN(PW); SBAR(); }while(0)
  #define EX(v) __builtin_amdgcn_exp2f(v)
  #define GAPB(MF,X,B) do{ MF; X[B]=EX(X[B]); X[B+1]=EX(X[B+1]); X[B+2]=EX(X[B+2]); X[B+3]=EX(X[B+3]); PIN(X); SBAR(); }while(0)
  #define VRD(i) do{ vlo[i]=vtr(vp_+(((i)>>2)*4096+((i)&3)*1024)); vhi[i]=vtr(vp_+(((i)>>2)*4096+((i)&3)*1024+512)); }while(0)
  #define KRD(G,j) do{ if(G){ kload2(kf,kp0+sl_next,j); SBAR(); } }while(0)
  #define STEP(C0,C1,P0,P1,t,GK,GV,GL) do{ SBAR(); \
    const lds_cptr vp_=vp0+sl_prev; \
    VRD(0); SBAR(); float sacc=(P0[0]+P0[1]); \
    GAPA(C0=__builtin_amdgcn_mfma_f32_32x32x16_bf16(kf[0],qr[0],C0,0,0,0), P0[2],P0[3],P0[4],P0[5],     pw0[0]=PKW(P0,0), pw0[1]=PKW(P0,2), pw0); \
    VRD(4); SBAR(); GAPA(C1=__builtin_amdgcn_mfma_f32_32x32x16_bf16(kf[1],qr[0],C1,0,0,0), P0[6],P0[7],P0[8],P0[9],     pw0[2]=PKW(P0,4), pw0[3]=PKW(P0,6), pw0); \
    VRD(1); SBAR(); GAPA(C0=__builtin_amdgcn_mfma_f32_32x32x16_bf16(kf[2],qr[1],C0,0,0,0),   P0[10],P0[11],P0[12],P0[13], pw1[0]=PKW(P0,8), pw1[1]=PKW(P0,10), pw1); \
    VRD(5); SBAR(); GAPA(C1=__builtin_amdgcn_mfma_f32_32x32x16_bf16(kf[3],qr[1],C1,0,0,0),   P0[14],P0[15],P1[0],P1[1],   pw1[2]=PKW(P0,12),pw1[3]=PKW(P0,14), pw1); \
    VRD(2); SBAR(); GAPA(C0=__builtin_amdgcn_mfma_f32_32x32x16_bf16(kf[4],qr[2],C0,0,0,0),   P1[2],P1[3],P1[4],P1[5],     pw2[0]=PKW(P1,0), pw2[1]=PKW(P1,2), pw2); \
    VRD(6); SBAR(); GAPA(C1=__builtin_amdgcn_mfma_f32_32x32x16_bf16(kf[5],qr[2],C1,0,0,0),   P1[6],P1[7],P1[8],P1[9],     pw2[2]=PKW(P1,4), pw2[3]=PKW(P1,6), pw2); \
    VRD(3); SBAR(); GAPA(C0=__builtin_amdgcn_mfma_f32_32x32x16_bf16(kf[6],qr[3],C0,0,0,0),   P1[10],P1[11],P1[12],P1[13], pw3[0]=PKW(P1,8), pw3[1]=PKW(P1,10), pw3); \
    VRD(7); SBAR(); GAPA(C1=__builtin_amdgcn_mfma_f32_32x32x16_bf16(kf[7],qr[3],C1,0,0,0),   P1[14],P1[15],0.f,0.f,       pw3[2]=PKW(P1,12),pw3[3]=PKW(P1,14), pw3); \
    l_reg+=sacc; \
    if(GK){DMA_K((t)+3,sl_cur);} if(GV){DMA_V((t)+1,sl_next);} \
    CMASK(C0,C1,t); \
    { float a=MX3(C0[0],C0[1],C1[0]),b=MX3(C0[2],C0[3],C1[1]); a=MX3(a,C1[2],C1[3]); \
      _Pragma("unroll") for(int r=4;r<16;r+=4){a=MX3(a,C0[r],C0[r+1]);b=MX3(b,C0[r+2],C0[r+3]);a=MX3(a,C1[r],C1[r+1]);b=MX3(b,C1[r+2],C1[r+3]);} \
      float rm=__builtin_fmaxf(a,b); { auto rr=__builtin_amdgcn_permlane32_swap(__float_as_uint(rm),__float_as_uint(rm),false,false); rm=__builtin_fmaxf(__uint_as_float(rr[0]),__uint_as_float(rr[1])); } \
      resc=false; \
      if(__builtin_expect(__any(rm>(float)THRL),0)){ const float dl=__builtin_fmaxf(rm,0.f); mhat+=dl; \
        _Pragma("unroll") for(int r=0;r<16;++r){C0[r]-=dl;C1[r]-=dl;} \
        const float f=__builtin_amdgcn_exp2f(-dl); l_reg*=f; if(hi==0)wsf[r32]=f; resc=true; } } \
    SBAR(); \
    f32x4_t kt0,kt1,kt2,kt3,kt4,kt5,kt6,kt7; \
    KLD(GL,t,0); GAPB(o[0]=__builtin_amdgcn_mfma_f32_32x32x16_bf16(PAF(0),VFR(0),o[0],0,0,0), C0,0); \
    KLD(GL,t,1); KSUB(GL,0,P0); GAPB(o[1]=__builtin_amdgcn_mfma_f32_32x32x16_bf16(PAF(0),VFR(4),o[1],0,0,0), C0,4); \
    KRD(GL,0); KLD(GL,t,2); KSUB(GL,1,P0); GAPB(o[0]=__builtin_amdgcn_mfma_f32_32x32x16_bf16(PAF(1),VFR(1),o[0],0,0,0), C0,8); \
    KRD(GL,1); KLD(GL,t,3); KSUB(GL,2,P0); GAPB(o[1]=__builtin_amdgcn_mfma_f32_32x32x16_bf16(PAF(1),VFR(5),o[1],0,0,0), C0,12); \
    KRD(GL,2); KLD(GL,t,4); KSUB(GL,3,P0); GAPB(o[0]=__builtin_amdgcn_mfma_f32_32x32x16_bf16(PAF(2),VFR(2),o[0],0,0,0), C1,0); \
    KRD(GL,3); KLD(GL,t,5); KSUB(GL,4,P1); GAPB(o[1]=__builtin_amdgcn_mfma_f32_32x32x16_bf16(PAF(2),VFR(6),o[1],0,0,0), C1,4); \
    KLD(GL,t,6); KSUB(GL,5,P1); GAPB(o[0]=__builtin_amdgcn_mfma_f32_32x32x16_bf16(PAF(3),VFR(3),o[0],0,0,0), C1,8); \
    KLD(GL,t,7); KSUB(GL,6,P1); GAPB(o[1]=__builtin_amdgcn_mfma_f32_32x32x16_bf16(PAF(3),VFR(7),o[1],0,0,0), C1,12); \
    KSUB(GL,7,P1); \
    }while(0)
  int t=1;
  #undef CMASK
  #define CMASK(P0,P1,t) do{}while(0)
  for(;t+5<NT;t+=2){
    STEP(pB0,pB1,pA0,pA1,t,true,true,true);     WAIT_BAR(2); RESC(); ROT();
    STEP(pA0,pA1,pB0,pB1,t+1,true,true,true);   WAIT_BAR(2); RESC(); ROT();
  }
  #undef CMASK
  #define CMASK(P0,P1,t) do{int jb_=(t)-(NT-4); if(jb_>=0)cmask(P0,P1,jb_,qrel,hi);}while(0)
  #define ENDW(tt) do{ if((tt)+3<NT){WAIT_BAR(2);} else if((tt)+2<NT){WAIT_BAR(1);} else {WAIT_BAR(0);} }while(0)
  for(;t+1<NT;t+=2){
    STEP(pB0,pB1,pA0,pA1,t,(t+3<NT),(t+1<NT),(t+1<NT));       ENDW(t);   RESC(); ROT();
    STEP(pA0,pA1,pB0,pB1,t+1,(t+4<NT),(t+2<NT),(t+2<NT));     ENDW(t+1); RESC(); ROT();
  }
  STEP(pB0,pB1,pA0,pA1,NT-1,false,false,false); RESC();
  { float sacc=pB0[0]+pB0[1]; _Pragma("unroll") for(int r=2;r<16;++r)sacc+=pB0[r]; _Pragma("unroll") for(int r=0;r<16;++r)sacc+=pB1[r]; l_reg+=sacc;
    pw0=(u32x4){PKW(pB0,0),PKW(pB0,2),PKW(pB0,4),PKW(pB0,6)};pw1=(u32x4){PKW(pB0,8),PKW(pB0,10),PKW(pB0,12),PKW(pB0,14)};pw2=(u32x4){PKW(pB1,0),PKW(pB1,2),PKW(pB1,4),PKW(pB1,6)};pw3=(u32x4){PKW(pB1,8),PKW(pB1,10),PKW(pB1,12),PKW(pB1,14)};
    SBAR(); pv(o,vb0+sl_cur,PAF(0),PAF(1),PAF(2),PAF(3)); }
  #undef PKW
  #undef PAF
  #undef VFR
  #undef PIN
  #undef MX3
  #undef GAPA
  #undef GAPB
  #undef EX
  #undef VRD
  #undef KRD
  #undef STEP
  #undef ENDW
  {auto rr=__builtin_amdgcn_permlane32_swap(__float_as_uint(l_reg),__float_as_uint(l_reg),false,false);l_reg=__uint_as_float(rr[0])+__uint_as_float(rr[1]);}
  if(hi==0)wsf[32+r32]=l_reg;asm volatile("s_waitcnt lgkmcnt(0)":::"memory");
  float rli[16];
  #pragma unroll
  for(int r=0;r<16;++r)rli[r]=__builtin_amdgcn_rcpf(wsf[32+crow(r,hi)]);
  bf16*Ow=O+(rowbase+q0+wid*QBLK)*DM+h*D;
  { bf16*stg=(bf16*)(shm+LDS_OST)+wid*2048;
    #pragma unroll
    for(int r=0;r<16;++r){const int orow=crow(r,hi);
      #pragma unroll
      for(int d0=0;d0<2;++d0)stg[orow*64+d0*32+r32]=__float2bfloat16(o[d0][r]*rli[r]);}
    asm volatile("s_waitcnt lgkmcnt(0)":::"memory");
    #pragma unroll
    for(int i=0;i<4;++i){const int row=i*8+(lane>>3),ch=lane&7; const u32x4 v=*(const u32x4*)(stg+row*64+ch*8); ATTN_STORE16(Ow+(long)row*DM+ch*8,v);} }
  asm volatile("s_waitcnt lgkmcnt(0)\n\ts_barrier":::"memory");
  #undef DMA_K
  #undef DMA_V
  #undef CMASK
  #undef KINIT
  #undef KLD
  #undef KSUB
  #undef KBP
  #undef START
  #undef RESC
  #undef ROT
}
constexpr int ATTN_LDS_BYTES=LDS_BYTES;
struct AttnTensors { const bf16* Q; const bf16* K; const bf16* V; bf16* O; const float* KB; };
template<int THRL=8> __device__ __forceinline__ void attn_phase(char*lds,const AttnTensors&T,int vcu,int G){
  _Pragma("unroll 1") for(int v=vcu;v<BATCH*NHEAD*2;v+=G){ const int bh=v>>1,s=v&1;
    _Pragma("unroll 1") for(int i=7;i>=0;--i){ const int qb=4*(i>>1)+((i&1)?3-s:s); attn_unit<THRL>(bh/NHEAD,bh%NHEAD,qb,T.Q,T.K,T.V,T.O,T.KB,lds); } }
}
#undef SBAR
#undef WAIT_BAR
}
namespace cg = cooperative_groups;
#define LAS __attribute__((address_space(3)))
typedef unsigned short bf16;
using pg8::f32x4; using pg8::u32x4; using pg8::Unit; using pg8::cvt_pk_bf16;
typedef unsigned u32x2 __attribute__((ext_vector_type(2)));

constexpr int NB = 16, SEQ = 4096, T = NB * SEQ, D = 1024, FF = 4096, INC = 5128, NIN = 5376, UP = 640, NLAYER = 2;
constexpr float EPS = 1e-6f, LOG2E = 1.4426950408889634f, C2Q = 0.125f * LOG2E;
enum { I_X = 0, I_MIXN, I_WIN, I_BF, I_QN, I_KN, I_ARE, I_AIM, I_LDT, I_BRE, I_BIM, I_CRE, I_CIM, I_SD, I_WGLU, I_PW, I_PS, I_WBA, I_WBS, I_WBP, I_BG, I_WOUT, I_MLPN, I_WUP, I_WDN, N_IN };

constexpr size_t MiB = 1u << 20;
constexpr size_t WL_STRIDE = 48 * MiB;
constexpr size_t WL_WIN = 0, WL_WA = 11 * MiB, WL_WS = 12 * MiB, WL_WP = 12 * MiB + 512 * 1024, WL_WOUT = 13 * MiB, WL_WUP = 15 * MiB, WL_WDN = 23 * MiB,
                 WL_WGLU = 31 * MiB, WL_TZ = 32 * MiB, WL_MEND = 42 * MiB, WL_DL = 46 * MiB;
constexpr size_t WS_XB = 96 * MiB, WS_SSQ = 224 * MiB, WS_Q = 228 * MiB, WS_K = 292 * MiB, WS_V = 356 * MiB, WS_MERGED = WS_K, WS_U = 420 * MiB, WS_UPOOL = 460 * MiB,
                 WS_GATES = 492 * MiB, WS_FLOG = 876 * MiB, WS_KB = 878 * MiB, WS_S = 880 * MiB, WS_YPRE = 896 * MiB, WS_YSSM = 928 * MiB, WS_POOLED = 960 * MiB,
                 WS_DBG = 992 * MiB, WS_END = 993 * MiB, WS_ACT = WS_Q;
static_assert(WS_ACT + (size_t)T * FF * 2 <= WS_FLOG, "act overlay");
constexpr int LDS_BYTES = 147456;

struct Params { const float* in[N_IN]; float* out; unsigned char* ws; int ph_lo, ph_hi, dbg, pad; };

__device__ __forceinline__ u32x4 pack8(f32x4 a, f32x4 b) { u32x4 w; w.x = cvt_pk_bf16(a[0], a[1]); w.y = cvt_pk_bf16(a[2], a[3]); w.z = cvt_pk_bf16(b[0], b[1]); w.w = cvt_pk_bf16(b[2], b[3]); return w; }
__device__ __forceinline__ void unpack8(u32x4 w, f32x4& a, f32x4& b) {
    a[0] = __uint_as_float(w.x << 16); a[1] = __uint_as_float(w.x & 0xffff0000u); a[2] = __uint_as_float(w.y << 16); a[3] = __uint_as_float(w.y & 0xffff0000u);
    b[0] = __uint_as_float(w.z << 16); b[1] = __uint_as_float(w.z & 0xffff0000u); b[2] = __uint_as_float(w.w << 16); b[3] = __uint_as_float(w.w & 0xffff0000u); }
__device__ __forceinline__ float bf2f(bf16 v) { return __uint_as_float((unsigned)v << 16); }
__device__ __forceinline__ float dot4(f32x4 a) { return (a[0] * a[0] + a[1] * a[1]) + (a[2] * a[2] + a[3] * a[3]); }
__device__ __forceinline__ float row_rstd(const float* ssq, int row) {
    const f32x4* p = (const f32x4*)(ssq + (size_t)row * 16); const f32x4 a = p[0], b = p[1], c = p[2], d = p[3];
    const float s = ((a[0] + a[1]) + (a[2] + a[3])) + ((b[0] + b[1]) + (b[2] + b[3])) + ((c[0] + c[1]) + (c[2] + c[3])) + ((d[0] + d[1]) + (d[2] + d[3]));
    return __builtin_amdgcn_rsqf(s * (1.0f / D) + EPS); }
__device__ __forceinline__ float sigm(float x) { return 1.0f / (1.0f + __expf(-x)); }
__device__ __forceinline__ f32x4 sigm4(f32x4 x) { f32x4 r; r[0] = sigm(x[0]); r[1] = sigm(x[1]); r[2] = sigm(x[2]); r[3] = sigm(x[3]); return r; }
__device__ __forceinline__ float gelu_t(float y) { const float z = 1.5957691216057308f * (y + 0.044715f * y * y * y); return y / (1.0f + __expf(-z)); }
__device__ __forceinline__ f32x4 gelu4(f32x4 x) { f32x4 r; r[0] = gelu_t(x[0]); r[1] = gelu_t(x[1]); r[2] = gelu_t(x[2]); r[3] = gelu_t(x[3]); return r; }
__device__ __forceinline__ float logsig(float x) { return fminf(x, 0.f) - log1pf(__expf(-fabsf(x))); }

struct EpiIn {
    static constexpr bool PERM = true, AFTER_DRAIN = false;
    bf16 *q, *k, *v, *U, *upool, *gates; float* flog; const float* ssq; const float *qg, *kg, *bgate, *bforget;
    __device__ __forceinline__ void operator()(const f32x4 (&acc)[2][2][4][2], const Unit& u, int wr, int wc, int fr, int fq) const {
        const int tile = u.pn, row0 = u.pm * 256 + wr * 64 + fr, cc0 = wc * 32 + 8 * fq;
        if (tile < 4) {
            const bool isq = tile < 2; const float* gp = (isq ? qg : kg) + 8 * fq; bf16* O = isq ? q : k; const int head = (tile & 1) * 4 + wc; const float sc = isq ? C2Q : 1.f;
            f32x4 g[2][2];
#pragma unroll
            for (int bj = 0; bj < 2; ++bj)
#pragma unroll
                for (int n = 0; n < 2; ++n) g[bj][n] = *(const f32x4*)(gp + 32 * bj + 4 * n);
#pragma unroll
            for (int ai = 0; ai < 2; ++ai)
#pragma unroll
                for (int m = 0; m < 4; ++m) { const int row = row0 + ai * 128 + m * 16; const float rs = row_rstd(ssq, row);
                    f32x4 vv[2][2]; float ss = 0.f;
#pragma unroll
                    for (int bj = 0; bj < 2; ++bj)
#pragma unroll
                        for (int n = 0; n < 2; ++n) { vv[bj][n] = acc[ai][bj][m][n] * rs; ss += dot4(vv[bj][n]); }
                    ss += __shfl_xor(ss, 16); ss += __shfl_xor(ss, 32);
                    const float r = __builtin_amdgcn_rsqf(ss * (1.0f / 64.0f) + EPS) * sc;
#pragma unroll
                    for (int bj = 0; bj < 2; ++bj) *(u32x4*)(O + (size_t)row * 512 + head * 64 + 32 * bj + 8 * fq) = pack8(vv[bj][0] * r * g[bj][0], vv[bj][1] * r * g[bj][1]); __builtin_amdgcn_sched_barrier(0); }
        } else if (tile < 8) {
#pragma unroll
            for (int ai = 0; ai < 2; ++ai)
#pragma unroll
                for (int m = 0; m < 4; ++m) { const int row = row0 + ai * 128 + m * 16; const float rs = row_rstd(ssq, row);
#pragma unroll
                    for (int bj = 0; bj < 2; ++bj) { const int cc = 128 * bj + cc0; bf16* dst;
                        if (tile < 6) dst = v + (size_t)row * 512 + (tile - 4) * 256 + cc;
                        else if (tile == 6) { const int g = cc >> 4, ci0 = cc & 15, b = row >> 12, s = row & 4095; dst = U + ((size_t)(g * 2048 + b * 128 + (s >> 5)) * UP + (s & 31) * 16 + ci0); }
                        else dst = upool + (size_t)row * 256 + cc;
                        *(u32x4*)dst = pack8(acc[ai][bj][m][0] * rs, acc[ai][bj][m][1] * rs); } __builtin_amdgcn_sched_barrier(0); }
        } else if (tile < 20) {
#pragma unroll
            for (int bj = 0; bj < 2; ++bj) { const int col = (tile - 8) * 256 + 128 * bj + cc0; const f32x4 b0 = *(const f32x4*)(bgate + col), b1 = *(const f32x4*)(bgate + col + 4);
#pragma unroll
                for (int ai = 0; ai < 2; ++ai)
#pragma unroll
                    for (int m = 0; m < 4; ++m) { const int row = row0 + ai * 128 + m * 16; const float rs = row_rstd(ssq, row);
                        *(u32x4*)(gates + (size_t)row * 3072 + col) = pack8(sigm4(acc[ai][bj][m][0] * rs + b0), sigm4(acc[ai][bj][m][1] * rs + b1)); __builtin_amdgcn_sched_barrier(0); } }
        } else {
            if (wc == 0 && fq == 0) { const f32x4 b0 = *(const f32x4*)(bforget), b1 = *(const f32x4*)(bforget + 4);
#pragma unroll
                for (int ai = 0; ai < 2; ++ai)
#pragma unroll
                    for (int m = 0; m < 4; ++m) { const int row = row0 + ai * 128 + m * 16; const float rs = row_rstd(ssq, row);
                        const f32x4 x0 = acc[ai][0][m][0] * rs + b0, x1 = acc[ai][0][m][1] * rs + b1; f32x4 o0, o1;
#pragma unroll
                        for (int e = 0; e < 4; ++e) { o0[e] = logsig(x0[e]); o1[e] = logsig(x1[e]); }
                        *(f32x4*)(flog + (size_t)row * 8) = o0; *(f32x4*)(flog + (size_t)row * 8 + 4) = o1; } }
        }
    }
};
struct EpiSend {
    static constexpr bool PERM = true, AFTER_DRAIN = false;
    float* S;
    __device__ __forceinline__ void operator()(const f32x4 (&acc)[2][2][4][2], const Unit& u, int wr, int wc, int fr, int fq) const {
        const int row0 = u.pm * 256 + wr * 64 + fr, cc0 = wc * 32 + 8 * fq;
#pragma unroll
        for (int ai = 0; ai < 2; ++ai)
#pragma unroll
            for (int m = 0; m < 4; ++m) { float* p = S + (size_t)(row0 + ai * 128 + m * 16) * 128 + cc0; *(f32x4*)p = acc[ai][0][m][0]; *(f32x4*)(p + 4) = acc[ai][0][m][1]; }
    }
};
struct EpiSsmY {
    static constexpr bool PERM = true, AFTER_DRAIN = false;
    const bf16* U; const float* sd; bf16* ypre;
    __device__ __forceinline__ void operator()(const f32x4 (&acc)[2][2][4][2], const Unit& u, int wr, int wc, int fr, int fq) const {
        const int g = u.pm >> 3, pnl = u.pn & 1, row0 = u.pm * 256 + wr * 64 + fr, cc0 = wc * 32 + 8 * fq;
#pragma unroll
        for (int bj = 0; bj < 2; ++bj) { const int colidx = pnl * 256 + 128 * bj + cc0, t = colidx >> 4, co0 = colidx & 15;
            const f32x4 d0 = *(const f32x4*)(sd + g * 16 + co0), d1 = *(const f32x4*)(sd + g * 16 + co0 + 4);
#pragma unroll
            for (int ai = 0; ai < 2; ++ai)
#pragma unroll
                for (int m = 0; m < 4; ++m) { const int grow = row0 + ai * 128 + m * 16, rl = grow & 2047, b = rl >> 7, c = rl & 127;
                    f32x4 ua, ub; unpack8(*(const u32x4*)(U + (size_t)grow * UP + colidx), ua, ub);
                    *(u32x4*)(ypre + (size_t)(b * 4096 + c * 32 + t) * 256 + g * 16 + co0) = pack8(gelu4(acc[ai][bj][m][0] + d0 * ua), gelu4(acc[ai][bj][m][1] + d1 * ub)); __builtin_amdgcn_sched_barrier(0); } }
    }
};
struct EpiGlu {
    static constexpr bool PERM = true, AFTER_DRAIN = false;
    bf16* yssm;
    __device__ __forceinline__ void operator()(const f32x4 (&acc)[2][2][4][2], const Unit& u, int wr, int wc, int fr, int fq) const {
        const int row0 = u.pm * 256 + wr * 64 + fr, col = u.pn * 128 + wc * 32 + 8 * fq;
#pragma unroll
        for (int ai = 0; ai < 2; ++ai)
#pragma unroll
            for (int m = 0; m < 4; ++m) { const int row = row0 + ai * 128 + m * 16;
                *(u32x4*)(yssm + (size_t)row * 256 + col) = pack8(acc[ai][0][m][0] * sigm4(acc[ai][1][m][0]), acc[ai][0][m][1] * sigm4(acc[ai][1][m][1])); __builtin_amdgcn_sched_barrier(0); }
    }
};
template <bool FIRST> struct EpiGate {
    static constexpr bool PERM = true, AFTER_DRAIN = false;
    const bf16* gates; bf16* merged; int gi;
    __device__ __forceinline__ void operator()(const f32x4 (&acc)[2][2][4][2], const Unit& u, int wr, int wc, int fr, int fq) const {
        const int row0 = u.pm * 256 + wr * 64 + fr, cc0 = wc * 32 + 8 * fq;
#pragma unroll
        for (int ai = 0; ai < 2; ++ai)
#pragma unroll
            for (int m = 0; m < 4; ++m) { const int row = row0 + ai * 128 + m * 16;
#pragma unroll
                for (int bj = 0; bj < 2; ++bj) { const int col = u.pn * 256 + 128 * bj + cc0; f32x4 ga, gb; unpack8(*(const u32x4*)(gates + (size_t)row * 3072 + gi * 1024 + col), ga, gb);
                    f32x4 o0 = acc[ai][bj][m][0] * ga, o1 = acc[ai][bj][m][1] * gb; bf16* mp = merged + (size_t)row * 1024 + col;
                    if (!FIRST) { f32x4 pa, pb; unpack8(*(const u32x4*)mp, pa, pb); o0 += pa; o1 += pb; }
                    *(u32x4*)mp = pack8(o0, o1); } __builtin_amdgcn_sched_barrier(0); }
    }
};
struct EpiRes {
    static constexpr bool PERM = true, AFTER_DRAIN = false;
    const float* xin; float* xout; bf16* xb; float* ssq;
    __device__ __forceinline__ void operator()(const f32x4 (&acc)[2][2][4][2], const Unit& u, int wr, int wc, int fr, int fq) const {
        const int row0 = u.pm * 256 + wr * 64 + fr, cc0 = wc * 32 + 8 * fq;
#pragma unroll
        for (int ai = 0; ai < 2; ++ai)
#pragma unroll
            for (int m = 0; m < 4; ++m) { const int row = row0 + ai * 128 + m * 16; float ss = 0.f;
#pragma unroll
                for (int bj = 0; bj < 2; ++bj) { const size_t off = (size_t)row * 1024 + u.pn * 256 + 128 * bj + cc0;
                    const f32x4 a = *(const f32x4*)(xin + off) + acc[ai][bj][m][0], b = *(const f32x4*)(xin + off + 4) + acc[ai][bj][m][1];
                    *(f32x4*)(xout + off) = a; *(f32x4*)(xout + off + 4) = b;
                    if (xb) { *(u32x4*)(xb + off) = pack8(a, b); ss += dot4(a) + dot4(b); } }
                if (xb) { ss += __shfl_xor(ss, 16); ss += __shfl_xor(ss, 32); if (fq == 0) ssq[(size_t)row * 16 + u.pn * 4 + wc] = ss; } __builtin_amdgcn_sched_barrier(0); }
    }
};
struct EpiUp {
    static constexpr bool PERM = true, AFTER_DRAIN = false;
    bf16* act; const float* ssq;
    __device__ __forceinline__ void operator()(const f32x4 (&acc)[2][2][4][2], const Unit& u, int wr, int wc, int fr, int fq) const {
        const int row0 = u.pm * 256 + wr * 64 + fr, cc0 = wc * 32 + 8 * fq;
#pragma unroll
        for (int ai = 0; ai < 2; ++ai)
#pragma unroll
            for (int m = 0; m < 4; ++m) { const int row = row0 + ai * 128 + m * 16; const float rs = row_rstd(ssq, row);
#pragma unroll
                for (int bj = 0; bj < 2; ++bj) { f32x4 a = acc[ai][bj][m][0] * rs, b = acc[ai][bj][m][1] * rs;
#pragma unroll
                    for (int e = 0; e < 4; ++e) { const float x0 = fmaxf(a[e], 0.f), x1 = fmaxf(b[e], 0.f); a[e] = x0 * x0; b[e] = x1 * x1; }
                    *(u32x4*)(act + (size_t)row * FF + u.pn * 256 + 128 * bj + cc0) = pack8(a, b); } __builtin_amdgcn_sched_barrier(0); }
    }
};
struct BatchOrder {
    int nG, nMg, nNg, G, c;
    __device__ __forceinline__ bool next(int i, Unit& u) const { const long L = (long)i * G + c; if (L >= (long)nG * nMg * nNg) return false;
        const int l = (int)L, per = nMg * nNg, g = l / per, r = l % per; u.pm = g * nMg + (r % nMg); u.pn = g * nNg + (r / nMg); return true; }
    __device__ __forceinline__ void a_ready(const Unit&) const {}
    __device__ __forceinline__ void done(const Unit&) const {}
};

#define LDS_WAIT() asm volatile("s_waitcnt lgkmcnt(0)" ::: "memory")
__device__ __forceinline__ float wave_sum(float v) {
#pragma unroll
    for (int o = 1; o < 64; o <<= 1) v += __shfl_xor(v, o);
    return v; }
__device__ __forceinline__ unsigned f2bf(float f) { unsigned u = __builtin_bit_cast(unsigned, f); return (u + 0x7fffu + ((u >> 16) & 1u)) >> 16; }
__device__ __forceinline__ unsigned pk2(float lo, float hi) { return f2bf(lo) | (f2bf(hi) << 16); }
__device__ __forceinline__ int dst_row(int mode, int n) {
    if (mode == 1) {
        if (n < 1024) { const int base = n & ~511, nn = n & 511, h = nn >> 6, d = nn & 63; return base + (h >> 2) * 256 + (d >> 5) * 128 + (h & 3) * 32 + (d & 31); }
        if (n < 1536) return n;
        if (n < 1544) return 5120 + (n - 1536);
        return n - 8; }
    if (mode == 2) { const int hb = n >> 8, nn = n & 255; return (nn >> 7) * 256 + hb * 128 + (nn & 127); }
    return n; }
__device__ __forceinline__ void tr_item(const float* W, int K, int N, bf16* WT, int mode, const float* ksc, LAS float* scr, int item, int lane) {
    const int nblk = (N + 31) / 32, kb = item / nblk, nb = item % nblk, k0 = 64 * kb, n0 = 32 * nb; const int nn = n0 + (lane & 31); const bool ok = nn < N;
#pragma unroll 8
    for (int i = 0; i < 32; ++i) { const int kk = 2 * i + (lane >> 5); float w = ok ? W[(size_t)(k0 + kk) * N + nn] : 0.f; if (ksc) w *= ksc[k0 + kk]; scr[kk * 33 + (lane & 31)] = w; }
    LDS_WAIT(); asm volatile("" ::: "memory");
    const int c = lane & 7;
#pragma unroll
    for (int j = 0; j < 4; ++j) { const int n = (lane >> 3) + 8 * j; const LAS float* s = scr + (8 * c) * 33 + n;
        u32x4 o; o.x = pk2(s[0 * 33], s[1 * 33]); o.y = pk2(s[2 * 33], s[3 * 33]); o.z = pk2(s[4 * 33], s[5 * 33]); o.w = pk2(s[6 * 33], s[7 * 33]);
        if (n0 + n < N) *(u32x4*)(WT + (size_t)dst_row(mode, n0 + n) * K + k0 + 8 * c) = o; }
    LDS_WAIT(); asm volatile("" ::: "memory");
}
__device__ __forceinline__ void sincos_d(double x, double& s, double& c) {
    const double q = rint(x * 0.6366197723675814); const int n = (int)q;
    double r = fma(-q, 1.5707963267948966, x); r = fma(-q, 6.123233995736766e-17, r);
    const double r2 = r * r;
    const double sp = r * (1.0 + r2 * (-1.0 / 6 + r2 * (1.0 / 120 + r2 * (-1.0 / 5040 + r2 * (1.0 / 362880 + r2 * (-1.0 / 39916800 + r2 * (1.0 / 6227020800.0)))))));
    const double cp = 1.0 + r2 * (-0.5 + r2 * (1.0 / 24 + r2 * (-1.0 / 720 + r2 * (1.0 / 40320 + r2 * (-1.0 / 3628800 + r2 * (1.0 / 479001600 + r2 * (-1.0 / 87178291200.0)))))));
    const int k = n & 3; s = (k == 0) ? sp : (k == 1) ? cp : (k == 2) ? -sp : -cp; c = (k == 0) ? cp : (k == 1) ? -sp : (k == 2) ? -cp : sp; }
__device__ __forceinline__ double exp_small_d(double x) {
    double r = 1.0 / 479001600; r = r * x + 1.0 / 39916800; r = r * x + 1.0 / 3628800; r = r * x + 1.0 / 362880; r = r * x + 1.0 / 40320; r = r * x + 1.0 / 5040; r = r * x + 1.0 / 720;
    r = r * x + 1.0 / 120; r = r * x + 1.0 / 24; r = r * x + 1.0 / 6; r = r * x + 0.5; r = r * x + 1.0; r = r * x + 1.0; return r; }

__device__ __forceinline__ void ssm_gen(const Params& P, int l, int g, LAS unsigned char* lds, int tid) {
    LAS float* Ap = (LAS float*)lds;
    LAS float* Bb = Ap + 33 * 128;
    LAS float* Cc = Bb + 2048;
    LAS float* Kl = Cc + 2048;
    LAS float* Cf = Kl + 8192;
    const float* are = P.in[I_ARE] + (size_t)l * 1024 + g * 64; const float* aim = P.in[I_AIM] + (size_t)l * 1024 + g * 64;
    const float* bre = P.in[I_BRE] + (size_t)l * 16384 + g * 1024; const float* bim = P.in[I_BIM] + (size_t)l * 16384 + g * 1024;
    const float* cre = P.in[I_CRE] + (size_t)l * 16384 + g * 1024; const float* cim = P.in[I_CIM] + (size_t)l * 16384 + g * 1024;
    bf16* Tz = (bf16*)(P.ws + l * WL_STRIDE + WL_TZ) + (size_t)g * 512 * UP; bf16* Me = (bf16*)(P.ws + l * WL_STRIDE + WL_MEND) + (size_t)g * 256 * 512;
    float* DL = (float*)(P.ws + l * WL_STRIDE + WL_DL) + g * 128;
    if (tid < 64) { const int n = tid; const double dt = (double)expf(P.in[I_LDT][l * 16 + g]); const double ar = (double)are[n], ai = (double)aim[n];
        const double mag = exp_small_d(ar * dt); double sn, cs; sincos_d(ai * dt, sn, cs); const double abr = mag * cs, abi = mag * sn, den = ar * ar + ai * ai, nr = abr - 1.0, ni = abi;
        Cf[2 * n] = (float)((nr * ar + ni * ai) / den); Cf[2 * n + 1] = (float)((ni * ar - nr * ai) / den);
        double pr = 1.0, pi = 0.0;
        for (int k = 0; k <= 32; ++k) { Ap[(k * 64 + n) * 2] = (float)pr; Ap[(k * 64 + n) * 2 + 1] = (float)pi; const double t = pr * abr - pi * abi; pi = pr * abi + pi * abr; pr = t; }
        DL[2 * n] = Ap[(32 * 64 + n) * 2]; DL[2 * n + 1] = Ap[(32 * 64 + n) * 2 + 1]; }
    __syncthreads();
    for (int e = tid; e < 1024; e += 512) { const int n = e >> 4; const float cr = Cf[2 * n], ci = Cf[2 * n + 1], br = bre[e], bi = bim[e];
        Bb[2 * e] = cr * br - ci * bi; Bb[2 * e + 1] = cr * bi + ci * br; Cc[2 * e] = cre[e]; Cc[2 * e + 1] = cim[e]; }
    __syncthreads();
    for (int e = tid; e < 8192; e += 512) { const int lag = e >> 8, co = (e >> 4) & 15, ci = e & 15; float s = 0.f;
        for (int n = 0; n < 64; ++n) { const float cr = Cc[(co * 64 + n) * 2], cI = Cc[(co * 64 + n) * 2 + 1], ar = Ap[(lag * 64 + n) * 2], aI = Ap[(lag * 64 + n) * 2 + 1];
            const float car = cr * ar - cI * aI, cai = cr * aI + cI * ar; s += car * Bb[(n * 16 + ci) * 2] - cai * Bb[(n * 16 + ci) * 2 + 1]; }
        Kl[e] = s; }
    __syncthreads();
    for (int ch = tid; ch < 512 * 80; ch += 512) { const int row = ch / 80, cq = ch % 80, t = row >> 4, co = row & 15; float v[8];
        if (cq < 64) { const int j = cq >> 1, ci0 = (cq & 1) * 8;
#pragma unroll
            for (int i = 0; i < 8; ++i) v[i] = (j <= t) ? Kl[(t - j) * 256 + co * 16 + ci0 + i] : 0.f;
        } else { const int n0 = (cq - 64) * 8;
#pragma unroll
            for (int i = 0; i < 8; ++i) { const int nn = n0 + i, n = nn & 63; const float cr = Cc[(co * 64 + n) * 2], cI = Cc[(co * 64 + n) * 2 + 1], ar = Ap[((t + 1) * 64 + n) * 2], aI = Ap[((t + 1) * 64 + n) * 2 + 1];
                v[i] = (nn < 64) ? (cr * ar - cI * aI) : -(cr * aI + cI * ar); } }
        u32x4 o; o.x = pk2(v[0], v[1]); o.y = pk2(v[2], v[3]); o.z = pk2(v[4], v[5]); o.w = pk2(v[6], v[7]); *(u32x4*)(Tz + (size_t)row * UP + cq * 8) = o; }
    for (int ch = tid; ch < 256 * 64; ch += 512) { const int row = ch >> 6, cq = ch & 63, j = cq >> 1, ci0 = (cq & 1) * 8; float v[8];
#pragma unroll
        for (int i = 0; i < 8; ++i) { const int n = row & 63; const float ar = Ap[((31 - j) * 64 + n) * 2], aI = Ap[((31 - j) * 64 + n) * 2 + 1], br = Bb[(n * 16 + ci0 + i) * 2], bI = Bb[(n * 16 + ci0 + i) * 2 + 1];
            v[i] = (row < 64) ? (ar * br - aI * bI) : (row < 128) ? (ar * bI + aI * br) : 0.f; }
        u32x4 o; o.x = pk2(v[0], v[1]); o.y = pk2(v[2], v[3]); o.z = pk2(v[4], v[5]); o.w = pk2(v[6], v[7]); *(u32x4*)(Me + (size_t)row * 512 + cq * 8) = o; }
    __syncthreads();
}
__device__ __forceinline__ void wp_item(const Params& P, int l, int item, int lane) {
    const int kc = item >> 4, nb = item & 15, k0 = kc * 8, g = k0 >> 6, c0 = k0 & 63, n = nb * 64 + lane;
    const float* pw = P.in[I_PW] + (size_t)l * 16384 + g * 4096 + c0 * 64; const float* ps = P.in[I_PS] + l * 256 + g * 64; const float* wb = P.in[I_WBP] + (size_t)l * 262144 + (size_t)(g * 64) * 1024 + n;
    float a[8] = {0, 0, 0, 0, 0, 0, 0, 0};
    for (int d = 0; d < 64; ++d) { const float w = wb[(size_t)d * 1024] * ps[d];
#pragma unroll
        for (int i = 0; i < 8; ++i) a[i] += pw[i * 64 + d] * w; }
    u32x4 o; o.x = pk2(a[0], a[1]); o.y = pk2(a[2], a[3]); o.z = pk2(a[4], a[5]); o.w = pk2(a[6], a[7]);
    *(u32x4*)((bf16*)(P.ws + l * WL_STRIDE + WL_WP) + (size_t)n * 256 + k0) = o;
}
__device__ __forceinline__ void prologue(const Params& P, LAS unsigned char* lds, int tid, int lane, int wave, int bx, int G) {
    for (int it = bx; it < NLAYER * 16; it += G) ssm_gen(P, it >> 4, it & 15, lds, tid);
    __syncthreads();
    LAS float* scr = (LAS float*)(lds + wave * 16384);
    const int gw = bx * 8 + wave, NGW = G * 8;
    constexpr int I_IN = 16 * 161, I_A = 8 * 32, I_S = 4 * 32, I_O = 16 * 32, I_U = 16 * 128, I_D = 64 * 32, I_G = 4 * 16, I_P = 512, I_Z = 31, PER = I_IN + I_A + I_S + I_O + I_U + I_D + I_G + I_P + I_Z;
    for (int it = gw; it < NLAYER * PER; it += NGW) { const int l = it / PER; int r = it % PER; unsigned char* wl = P.ws + l * WL_STRIDE;
        if (r < I_IN) { tr_item(P.in[I_WIN] + (size_t)l * D * INC, D, INC, (bf16*)(wl + WL_WIN), 1, P.in[I_MIXN] + l * D, scr, r, lane); continue; } r -= I_IN;
        if (r < I_A) { tr_item(P.in[I_WBA] + (size_t)l * 512 * D, 512, D, (bf16*)(wl + WL_WA), 0, nullptr, scr, r, lane); continue; } r -= I_A;
        if (r < I_S) { tr_item(P.in[I_WBS] + (size_t)l * 256 * D, 256, D, (bf16*)(wl + WL_WS), 0, nullptr, scr, r, lane); continue; } r -= I_S;
        if (r < I_O) { tr_item(P.in[I_WOUT] + (size_t)l * D * D, D, D, (bf16*)(wl + WL_WOUT), 0, nullptr, scr, r, lane); continue; } r -= I_O;
        if (r < I_U) { tr_item(P.in[I_WUP] + (size_t)l * D * FF, D, FF, (bf16*)(wl + WL_WUP), 0, P.in[I_MLPN] + l * D, scr, r, lane); continue; } r -= I_U;
        if (r < I_D) { tr_item(P.in[I_WDN] + (size_t)l * FF * D, FF, D, (bf16*)(wl + WL_WDN), 0, nullptr, scr, r, lane); continue; } r -= I_D;
        if (r < I_G) { tr_item(P.in[I_WGLU] + (size_t)l * 256 * 512, 256, 512, (bf16*)(wl + WL_WGLU), 2, nullptr, scr, r, lane); continue; } r -= I_G;
        if (r < I_P) { wp_item(P, l, r, lane); continue; } r -= I_P;
        { u32x4* z = (u32x4*)((bf16*)(wl + WL_WIN) + (size_t)(5128 + 8 * r) * D) + lane; const u32x4 zero = {0u, 0u, 0u, 0u};
#pragma unroll
          for (int i = 0; i < 16; ++i) z[64 * i] = zero; }
    }
    const float* x = P.in[I_X]; bf16* xb = (bf16*)(P.ws + WS_XB); float* ssq = (float*)(P.ws + WS_SSQ);
    for (int m = gw; m < T; m += NGW) { const f32x4* xr = (const f32x4*)(x + (size_t)m * D) + lane; f32x4 v[4]; float s = 0.f;
#pragma unroll
        for (int j = 0; j < 4; ++j) { v[j] = xr[64 * j]; s += dot4(v[j]); }
        s = wave_sum(s);
        u32x2* o = (u32x2*)(xb + (size_t)m * D) + lane;
#pragma unroll
        for (int j = 0; j < 4; ++j) { u32x2 w; w.x = cvt_pk_bf16(v[j][0], v[j][1]); w.y = cvt_pk_bf16(v[j][2], v[j][3]); o[64 * j] = w; }
        if (lane < 16) ssq[(size_t)m * 16 + lane] = (lane == 0) ? s : 0.f; }
}
__device__ __forceinline__ void fcum_seq(const float* flog, float* kb, int sq, LAS unsigned char* lds, int tid, int lane, int wave) {
    const int b = sq >> 3, h = sq & 7; LAS float* wt = (LAS float*)lds;
    float v[8]; float run = 0.f;
#pragma unroll
    for (int i = 0; i < 8; ++i) { run += flog[((size_t)b * SEQ + tid * 8 + i) * 8 + h]; v[i] = run; }
    float inc = run;
#pragma unroll
    for (int o = 1; o < 64; o <<= 1) { const float t = __shfl_up(inc, o); if (lane >= o) inc += t; }
    if (lane == 63) wt[wave] = inc;
    __syncthreads();
    float off = inc - run;
    for (int w = 0; w < wave; ++w) off += wt[w];
#pragma unroll
    for (int i = 0; i < 8; ++i) kb[(size_t)sq * SEQ + tid * 8 + i] = -LOG2E * (off + v[i]);
    __syncthreads();
}
__device__ __forceinline__ void pool_pass(const bf16* up, bf16* pooled, int gtid, int NT) {
    for (int it = gtid; it < T * 32; it += NT) { const int tok = it >> 5, ch0 = (it & 31) * 8, w = 2 << (ch0 >> 6), s = tok & (SEQ - 1), cnt = (s + 1 < w) ? s + 1 : w;
        f32x4 sa = {0.f, 0.f, 0.f, 0.f}, sb = sa, ca, cb;
        for (int j = 0; j < cnt; ++j) { f32x4 a, b; unpack8(*(const u32x4*)(up + (size_t)(tok - j) * 256 + ch0), a, b); if (j == 0) { ca = a; cb = b; } sa += a; sb += b; }
        const float inv = 1.0f / (float)cnt;
        *(u32x4*)(pooled + (size_t)tok * 256 + ch0) = pack8(sa * inv - ca, sb * inv - cb); }
}
__device__ __forceinline__ void state_scan(const float* S, const float* DL, bf16* U, int gid) {
    const int g = gid >> 10, b = (gid >> 6) & 15, n = gid & 63; const float dr = DL[g * 128 + 2 * n], di = DL[g * 128 + 2 * n + 1];
    float xr = 0.f, xi = 0.f; const size_t r0 = (size_t)g * 2048 + b * 128;
#pragma unroll 8
    for (int c = 0; c < 128; ++c) { const float sr = S[(r0 + c) * 128 + n], si = S[(r0 + c) * 128 + 64 + n];
        U[(r0 + c) * UP + 512 + n] = (bf16)f2bf(xr); U[(r0 + c) * UP + 576 + n] = (bf16)f2bf(xi);
        const float t = dr * xr - di * xi + sr; xi = dr * xi + di * xr + si; xr = t; }
}

__global__ void __launch_bounds__(512, 2) fwd_kernel(Params P) {
    extern __shared__ __attribute__((aligned(16))) unsigned char lds_raw[];
    cg::grid_group grid = cg::this_grid();
    LAS unsigned char* lds = (LAS unsigned char*)lds_raw;
    const int G = gridDim.x, bx = blockIdx.x;
#define TIDS() int tid = threadIdx.x; asm volatile("" : "+v"(tid)); const int lane = tid & 63, wave = __builtin_amdgcn_readfirstlane(tid >> 6); (void)lane; (void)wave
    unsigned char* ws = P.ws;
    bf16* XB = (bf16*)(ws + WS_XB); float* SSQ = (float*)(ws + WS_SSQ); bf16* Qb = (bf16*)(ws + WS_Q); bf16* Kb = (bf16*)(ws + WS_K); bf16* Vb = (bf16*)(ws + WS_V); bf16* MG = (bf16*)(ws + WS_MERGED);
    bf16* Ub = (bf16*)(ws + WS_U); bf16* UPL = (bf16*)(ws + WS_UPOOL); bf16* GT = (bf16*)(ws + WS_GATES); float* FLOG = (float*)(ws + WS_FLOG); float* KBI = (float*)(ws + WS_KB);
    float* Sb = (float*)(ws + WS_S); bf16* YPRE = (bf16*)(ws + WS_YPRE); bf16* YSSM = (bf16*)(ws + WS_YSSM); bf16* PLD = (bf16*)(ws + WS_POOLED); bf16* ACT = (bf16*)(ws + WS_ACT);
#ifndef PHM
#define PHM 0x3ff
#endif
#define RUN(k) (P.ph_lo <= (k) && (k) < P.ph_hi)
#define EN(j) ((PHM >> (j)) & 1)
#define SEAM(k) do { if (RUN(k) && RUN((k) + 1)) grid.sync(); } while (0)
    if (RUN(0) && EN(0)) { TIDS(); prologue(P, lds, tid, lane, wave, bx, G); }
    SEAM(0);
    for (int l = 0; l < NLAYER; ++l) {
        const int p0 = 1 + 9 * l; unsigned char* wl = ws + l * WL_STRIDE;
        const float* xin = (l == 0) ? P.in[I_X] : P.out;
        if (RUN(p0 + 0) && EN(1)) {
            pg8::Gemm g{XB, (const bf16*)(wl + WL_WIN), T, NIN, D, D, D}; pg8::StaticOrder S; S.init(T, NIN, G, bx);
            EpiIn E{Qb, Kb, Vb, Ub, UPL, GT, FLOG, SSQ, P.in[I_QN] + l * 64, P.in[I_KN] + l * 64, P.in[I_BG] + l * 3072, P.in[I_BF] + l * 8};
            pg8::gemm_phase<EpiIn, pg8::StaticOrder, true, true>(lds, g, S, E); }
        SEAM(p0);
        if (RUN(p0 + 1) && EN(2)) {
            TIDS();
            for (int sq = bx; sq < NB * 8; sq += G) fcum_seq(FLOG, KBI, sq, lds, tid, lane, wave);
            pool_pass(UPL, PLD, bx * 512 + tid, G * 512);
            __syncthreads();
            pg8::Gemm g{Ub, (const bf16*)(wl + WL_MEND), 16 * 2048, 16 * 256, 512, UP, 512}; BatchOrder S{16, 8, 1, G, bx};
            EpiSend E{Sb};
            pg8::gemm_phase<EpiSend, BatchOrder, true, true>(lds, g, S, E); }
        SEAM(p0 + 1);
        if (RUN(p0 + 2) && EN(3)) {
            TIDS(); const int vcu = (G % 8 == 0) ? (bx % 8) * (G / 8) + bx / 8 : bx;
            for (int gid = bx * 512 + tid; gid < 16384; gid += G * 512) state_scan(Sb, (const float*)(wl + WL_DL), Ub, gid);
            __syncthreads();
            const attn_body::AttnTensors AT{(const attn_body::bf16*)Qb, (const attn_body::bf16*)Kb, (const attn_body::bf16*)Vb, (attn_body::bf16*)Qb, KBI};
            attn_body::attn_phase<8>((char*)lds_raw, AT, vcu, G); }
        SEAM(p0 + 2);
        if (RUN(p0 + 3) && EN(4)) {
            pg8::Gemm g{Ub, (const bf16*)(wl + WL_TZ), 16 * 2048, 16 * 512, UP, UP, UP}; BatchOrder S{16, 8, 2, G, bx};
            EpiSsmY E{Ub, P.in[I_SD] + l * 256, YPRE};
            pg8::gemm_phase<EpiSsmY, BatchOrder, true, true>(lds, g, S, E); }
        SEAM(p0 + 3);
        if (RUN(p0 + 4) && EN(5)) {
            pg8::Gemm g{YPRE, (const bf16*)(wl + WL_WGLU), T, 512, 256, 256, 256}; pg8::StaticOrder S; S.init(T, 512, G, bx);
            EpiGlu E{YSSM};
            pg8::gemm_phase<EpiGlu, pg8::StaticOrder, true, true>(lds, g, S, E); }
        SEAM(p0 + 4);
        if (RUN(p0 + 5) && EN(6)) {
            pg8::StaticOrder S; S.init(T, D, G, bx);
            { pg8::Gemm g{Qb, (const bf16*)(wl + WL_WA), T, D, 512, 512, 512}; EpiGate<true> E{GT, MG, 0}; pg8::gemm_phase<EpiGate<true>, pg8::StaticOrder, true, true>(lds, g, S, E); }
            { pg8::Gemm g{YSSM, (const bf16*)(wl + WL_WS), T, D, 256, 256, 256}; EpiGate<false> E{GT, MG, 1}; pg8::gemm_phase<EpiGate<false>, pg8::StaticOrder, true, true>(lds, g, S, E); }
            { pg8::Gemm g{PLD, (const bf16*)(wl + WL_WP), T, D, 256, 256, 256}; EpiGate<false> E{GT, MG, 2}; pg8::gemm_phase<EpiGate<false>, pg8::StaticOrder, true, true>(lds, g, S, E); } }
        SEAM(p0 + 5);
        if (RUN(p0 + 6) && EN(7)) {
            pg8::Gemm g{MG, (const bf16*)(wl + WL_WOUT), T, D, D, D, D}; pg8::StaticOrder S; S.init(T, D, G, bx);
            EpiRes E{xin, P.out, XB, SSQ};
            pg8::gemm_phase<EpiRes, pg8::StaticOrder, true, true>(lds, g, S, E); }
        SEAM(p0 + 6);
        if (RUN(p0 + 7) && EN(8)) {
            pg8::Gemm g{XB, (const bf16*)(wl + WL_WUP), T, FF, D, D, D}; pg8::StaticOrder S; S.init(T, FF, G, bx);
            EpiUp E{ACT, SSQ};
            pg8::gemm_phase<EpiUp, pg8::StaticOrder, true, true>(lds, g, S, E); }
        SEAM(p0 + 7);
        if (RUN(p0 + 8) && EN(9)) {
            pg8::Gemm g{ACT, (const bf16*)(wl + WL_WDN), T, D, FF, FF, FF}; pg8::StaticOrder S; S.init(T, D, G, bx);
            EpiRes E{P.out, P.out, (l + 1 < NLAYER) ? XB : nullptr, SSQ};
            pg8::gemm_phase<EpiRes, pg8::StaticOrder, true, true>(lds, g, S, E); }
        SEAM(p0 + 8);
    }
#undef RUN
#undef SEAM
}
constexpr int N_PHASES = 1 + 9 * NLAYER;

#ifndef MK_PER_PHASE
#define MK_PER_PHASE 0
#endif
extern "C" void kernel_launch(void* const* d_in, const int* in_sizes, int n_in, void* d_out, int out_size, void* d_ws, size_t ws_size, hipStream_t stream) {
    static int grid = 0;
    if (grid == 0) {
        if (n_in != N_IN || in_sizes[0] != T * D || out_size != T * D || ws_size < WS_END) { fprintf(stderr, "kernel_launch: unexpected shapes (n_in %d, in0 %d, out %d, ws %zu)\n", n_in, n_in > 0 ? in_sizes[0] : -1, out_size, ws_size); grid = -1; return; }
        int dev = 0, cus = 0, per_cu = 0;
        if (hipGetDevice(&dev) != hipSuccess || hipDeviceGetAttribute(&cus, hipDeviceAttributeMultiprocessorCount, dev) != hipSuccess) { grid = -1; return; }
        if (hipFuncSetAttribute((const void*)fwd_kernel, hipFuncAttributeMaxDynamicSharedMemorySize, LDS_BYTES) != hipSuccess) { fprintf(stderr, "kernel_launch: hipFuncSetAttribute failed\n"); grid = -1; return; }
        if (hipOccupancyMaxActiveBlocksPerMultiprocessor(&per_cu, (const void*)fwd_kernel, 512, LDS_BYTES) != hipSuccess || per_cu < 1) { fprintf(stderr, "kernel_launch: occupancy query says %d\n", per_cu); per_cu = 1; }
        (void)hipGetLastError();
        grid = cus;
    }
    if (grid < 0) return;
    Params p{};
    for (int i = 0; i < N_IN; ++i) p.in[i] = (const float*)d_in[i];
    p.out = (float*)d_out; p.ws = (unsigned char*)d_ws; p.dbg = 0; p.pad = 0;
#if MK_PER_PHASE
    for (int k = 0; k < N_PHASES; ++k) { p.ph_lo = k; p.ph_hi = k + 1; hipLaunchKernelGGL(fwd_kernel, dim3(grid), dim3(512), LDS_BYTES, stream, p); }
#else
    p.ph_lo = 0; p.ph_hi = N_PHASES;
    void* args[] = {&p};
    const hipError_t e = hipLaunchCooperativeKernel((const void*)fwd_kernel, dim3(grid), dim3(512), args, LDS_BYTES, stream);
    if (e != hipSuccess) fprintf(stderr, "kernel_launch: cooperative launch failed: %s (grid %d)\n", hipGetErrorString(e), grid);
#endif
}
```

```cpp
#include <hip/hip_runtime.h>
#include <hip/hip_cooperative_groups.h>
#include <cstdio>
#include <cstdint>
namespace pg8 {
#define PG8_LAS __attribute__((address_space(3)))
typedef unsigned short bf16_t;
typedef short bf16x8 __attribute__((ext_vector_type(8)));
typedef float f32x4 __attribute__((ext_vector_type(4)));
typedef unsigned u32x4 __attribute__((ext_vector_type(4)));
constexpr int BM = 256, BK = 64, HALF = 128, HTB = HALF * BK * 2  , STAGE_BYTES = 8 * HTB, NXCD = 8, WGM = 4;

__host__ __device__ __forceinline__ int lds_byte(int r, int c) { const int st = (r >> 4) * 2 + (c >> 5), rr = r & 15, cc = c & 31, ob = rr * 64 + cc * 2; return st * 1024 + (ob ^ (((ob >> 9) & 1) << 5)); }
__host__ __device__ __forceinline__ void stage_rc(int b, int& R, int& C) { const int st = b / 1024, sb = b % 1024, swz = sb ^ (((sb >> 9) & 1) << 5); R = (st >> 1) * 16 + swz / 64; C = (st & 1) * 32 + (swz % 64) / 2; }
__host__ __device__ __forceinline__ int perm32(int rho) { const int n = rho >> 4, i = rho & 15; return 8 * (i >> 2) + 4 * n + (i & 3); }

struct Unit { int pm, pn, ko = 0, nt = 0; };
struct Gemm { const bf16_t* A; const bf16_t* Bt; int M, N, K, lda, ldb; };

struct StaticOrder {
    int nM, nN, nwg, G, c;
    __host__ __device__ void init(int M, int N, int G_, int c_) { nM = M / BM; nN = N / BM; nwg = nM * nN; G = G_; c = c_; }
    __host__ __device__ bool next(int i, Unit& u) const {
        const long L = (long)i * G + c; if (L >= nwg) return false;
        int wgid = (int)L; { const int q = nwg / NXCD, r = nwg % NXCD, xcd = wgid % NXCD, off = wgid / NXCD; wgid = (xcd < r ? xcd * (q + 1) : r * (q + 1) + (xcd - r) * q) + off; }
        const int nig = WGM * nN, gid = wgid / nig, fm = gid * WGM, gsz = (nM - fm) < WGM ? (nM - fm) : WGM;
        u.pm = fm + ((wgid % nig) % gsz); u.pn = (wgid % nig) / gsz; return true;
    }
    __device__ __forceinline__ void a_ready(const Unit&) const {}
    __device__ __forceinline__ void done(const Unit&) const {}
};

typedef float f32x2c_t __attribute__((ext_vector_type(2))); typedef __bf16 bf16x2c_t __attribute__((ext_vector_type(2)));
__device__ __forceinline__ unsigned cvt_pk_bf16(float lo, float hi) { const f32x2c_t v = {lo, hi}; const bf16x2c_t b = __builtin_convertvector(v, bf16x2c_t); return __builtin_bit_cast(unsigned, b); }
typedef float f32x2 __attribute__((ext_vector_type(2)));
__device__ __forceinline__ f32x2 gelu_pk(f32x2 v) {
    const f32x2 av = __builtin_elementwise_abs(v), d = av * 0.2316418882f + 1.0f;
    f32x2 t; t.x = __builtin_amdgcn_rcpf(d.x); t.y = __builtin_amdgcn_rcpf(d.y);
    f32x2 q = t * 0.5307027145f + (-0.7265760135f); q = q * t + 0.7107068705f; q = q * t + (-0.142248368f); q = q * t + 0.127414796f; q = q * t;
    const f32x2 s = (v * v) * (-0.72134752044f);
    f32x2 e; e.x = __builtin_amdgcn_exp2f(s.x); e.y = __builtin_amdgcn_exp2f(s.y);
    const f32x2 m = v * (q * e), r = v - m;
    f32x2 o; o.x = v.x < 0.f ? m.x : r.x; o.y = v.y < 0.f ? m.y : r.y; return o;
}

template <int ACT  > struct EpiBf16 {
    static constexpr bool PERM = true, AFTER_DRAIN = false, KEEP = false; static_assert(ACT == 0 || ACT == 1, "EpiBf16: ACT is 0 (none) or 1 (gelu_pk)");
    bf16_t* O; int ldc; const float* bias; int split_cols; size_t split_stride; float scale0;
    __device__ __forceinline__ void operator()(const f32x4 (&acc)[2][2][4][2], const Unit& u, int wr, int wc, int fr, int fq) const {
        const int row0 = u.pm * BM + wr * 64 + fr; int colt = u.pn * BM; bf16_t* base = O;
        float sc = 1.f; if (split_cols) { const int t = colt / split_cols; base += (size_t)t * split_stride; colt -= t * split_cols; if (t == 0) sc = scale0; }
        const int col0 = colt + wc * 32 + 8 * fq, bcol0 = u.pn * BM + wc * 32 + 8 * fq;
        f32x4 bv[2][2];
#pragma unroll
        for (int bj = 0; bj < 2; ++bj)
#pragma unroll
            for (int n = 0; n < 2; ++n) bv[bj][n] = bias ? *(const f32x4*)(bias + bcol0 + bj * HALF + 4 * n) : (f32x4){0.f, 0.f, 0.f, 0.f};
#pragma unroll
        for (int ai = 0; ai < 2; ++ai)
#pragma unroll
            for (int m = 0; m < 4; ++m) { bf16_t* rowp = base + (size_t)(row0 + ai * HALF + m * 16) * ldc + col0;
#pragma unroll
                for (int bj = 0; bj < 2; ++bj) { f32x4 v0 = acc[ai][bj][m][0] + bv[bj][0], v1 = acc[ai][bj][m][1] + bv[bj][1];
                    if (ACT == 1) { f32x2 a = gelu_pk((f32x2){v0[0], v0[1]}), b = gelu_pk((f32x2){v0[2], v0[3]}), c = gelu_pk((f32x2){v1[0], v1[1]}), d = gelu_pk((f32x2){v1[2], v1[3]});
                        v0 = (f32x4){a.x, a.y, b.x, b.y}; v1 = (f32x4){c.x, c.y, d.x, d.y}; }
                    v0 = v0 * sc; v1 = v1 * sc; u32x4 w; w.x = cvt_pk_bf16(v0[0], v0[1]); w.y = cvt_pk_bf16(v0[2], v0[3]); w.z = cvt_pk_bf16(v1[0], v1[1]); w.w = cvt_pk_bf16(v1[2], v1[3]);
                    *(u32x4*)(rowp + bj * HALF) = w; } }
    }
};


template <class Epi, class Sched, bool ALIGN_EPI = false, bool SP2 = false>
__device__ __forceinline__ void gemm_phase(PG8_LAS unsigned char* lds, const Gemm g, const Sched& S, const Epi& E) {
    int tid_l = threadIdx.x; asm volatile("" : "+v"(tid_l));
    const int tid = tid_l, wid = __builtin_amdgcn_readfirstlane(tid >> 6), lane = tid & 63, wr = wid >> 2, wc = wid & 3, fr = lane & 15, fq = lane >> 4;
    const int K = g.K, nt = K / BK;
    unsigned voffA[2], voffB[2];
#pragma unroll
    for (int i = 0; i < 2; ++i) { int R, C; stage_rc(tid * 16 + i * 8192, R, C); const int Rb = Epi::PERM ? ((R & ~31) + perm32(R & 31)) : R;
        voffA[i] = (unsigned)(R * g.lda + C) * 2u; voffB[i] = (unsigned)(Rb * g.ldb + C) * 2u; }
    const size_t kstep = (size_t)(BK * 2);
    const size_t hstepA = (size_t)HALF * g.lda * 2, hstepB = (size_t)HALF * g.ldb * 2;
    const size_t tstepA = 2 * hstepA, tstepB = 2 * hstepB;
    const unsigned ldsw = (unsigned)wid * 1024u;
    const int aoff = lds_byte(wr * 64 + fr, fq * 8), boff = lds_byte(wc * 32 + fr, fq * 8);
#define PG8_SA(b, h) (((b) * 2 + (h)) * HTB)
#define PG8_SB(b, h) ((4 + (b) * 2 + (h)) * HTB)
#define PG8_STAGE(bufoff, gbase, voff) do { _Pragma("unroll") for (int _i = 0; _i < 2; ++_i) \
        __builtin_amdgcn_global_load_lds((const unsigned*)((const char*)(gbase) + (voff)[_i]), (PG8_LAS unsigned*)(lds + (bufoff) + ldsw + _i * 8192), 16, 0, 0); } while (0)
#define PG8_LDA(dst, b, h) do { _Pragma("unroll") for (int m = 0; m < 4; ++m) _Pragma("unroll") for (int k = 0; k < 2; ++k) dst[m][k] = *(const PG8_LAS bf16x8*)(lds + PG8_SA(b, h) + aoff + m * 2048 + k * 1024); } while (0)
#define PG8_LDB(dst, b, h) do { _Pragma("unroll") for (int n = 0; n < 2; ++n) _Pragma("unroll") for (int k = 0; k < 2; ++k) dst[n][k] = *(const PG8_LAS bf16x8*)(lds + PG8_SB(b, h) + boff + n * 2048 + k * 1024); } while (0)
#define PG8_MMA(ai, bj, At, Bt) do { __builtin_amdgcn_s_setprio(1); _Pragma("unroll") for (int m = 0; m < 4; ++m) _Pragma("unroll") for (int n = 0; n < 2; ++n) _Pragma("unroll") for (int k = 0; k < 2; ++k) \
        acc[ai][bj][m][n] = __builtin_amdgcn_mfma_f32_16x16x32_bf16(Bt[n][k], At[m][k], acc[ai][bj][m][n], 0, 0, 0); __builtin_amdgcn_s_setprio(0); } while (0)
#define PG8_WAIT_V(n) asm volatile("s_waitcnt vmcnt(" #n ")" ::: "memory")
#define PG8_WAIT_L(n) asm volatile("s_waitcnt lgkmcnt(" #n ")" ::: "memory")
#define PG8_BAR __builtin_amdgcn_s_barrier()
#define PG8_SCHED __builtin_amdgcn_sched_barrier(0)
    Unit cur, nxt; int ui = 0;
    if (!S.next(0, cur)) return;
    f32x4 acc[2][2][4][2];
#pragma unroll
    for (int a = 0; a < 2; ++a)
#pragma unroll
        for (int b = 0; b < 2; ++b)
#pragma unroll
            for (int m = 0; m < 4; ++m)
#pragma unroll
                for (int n = 0; n < 2; ++n) acc[a][b][m][n] = (f32x4){0.f, 0.f, 0.f, 0.f};
    bf16x8 At[4][2], B0[2][2], B1[2][2];
    const char* cA = (const char*)g.A + (size_t)cur.pm * tstepA + (size_t)cur.ko * 2; const char* cB = (const char*)g.Bt + (size_t)cur.pn * tstepB + (size_t)cur.ko * 2;
    S.a_ready(cur);
    if constexpr (SP2) {
        PG8_STAGE(PG8_SB(0, 0), cB, voffB); PG8_STAGE(PG8_SB(0, 1), cB + hstepB, voffB); PG8_STAGE(PG8_SA(0, 0), cA, voffA); PG8_STAGE(PG8_SA(0, 1), cA + hstepA, voffA);
        if (wr == 1) PG8_BAR;
        PG8_WAIT_V(2); PG8_BAR;
        PG8_STAGE(PG8_SB(1, 0), cB + kstep, voffB); PG8_STAGE(PG8_SA(1, 0), cA + kstep, voffA); PG8_STAGE(PG8_SB(1, 1), cB + hstepB + kstep, voffB);
        PG8_WAIT_V(6); PG8_BAR;
    } else {
        PG8_STAGE(PG8_SB(0, 0), cB, voffB); PG8_STAGE(PG8_SA(0, 0), cA, voffA); PG8_STAGE(PG8_SB(0, 1), cB + hstepB, voffB); PG8_STAGE(PG8_SA(0, 1), cA + hstepA, voffA);
        if (wr == 1) PG8_BAR;
        PG8_WAIT_V(4); PG8_BAR;
        PG8_STAGE(PG8_SB(1, 0), cB + kstep, voffB); PG8_STAGE(PG8_SA(1, 0), cA + kstep, voffA); PG8_STAGE(PG8_SB(1, 1), cB + hstepB + kstep, voffB);
        PG8_WAIT_V(6); PG8_BAR;
    }
    for (;;) {
        const bool has_next = S.next(ui + 1, nxt);
        const char* nA = has_next ? (const char*)g.A + (size_t)nxt.pm * tstepA + (size_t)nxt.ko * 2 : cA; const char* nB = has_next ? (const char*)g.Bt + (size_t)nxt.pn * tstepB + (size_t)nxt.ko * 2 : cB;
        const int ntu = cur.nt ? cur.nt : nt;
#pragma unroll 1
        for (int t = 0; t < ntu; t += 2) {
            const bool last = (t == ntu - 2);
            const char* a1 = cA + (size_t)(t + 1) * kstep;
            const char* a2 = last ? nA : cA + (size_t)(t + 2) * kstep; const char* b2 = last ? nB : cB + (size_t)(t + 2) * kstep;
            const char* a3 = a2 + kstep; const char* b3 = b2 + kstep;
            if (last && has_next) S.a_ready(nxt);
            if constexpr (SP2) {
            PG8_LDB(B0, 0, 0); PG8_LDB(B1, 0, 1); PG8_SCHED; PG8_LDA(At, 0, 0); PG8_STAGE(PG8_SA(1, 1), a1 + hstepA, voffA);
            PG8_WAIT_V(8); PG8_WAIT_L(0); PG8_BAR; PG8_MMA(0, 0, At, B0); PG8_MMA(0, 1, At, B1); PG8_BAR; PG8_SCHED;
            PG8_LDA(At, 0, 1); PG8_STAGE(PG8_SB(0, 0), b2, voffB); PG8_STAGE(PG8_SB(0, 1), b2 + hstepB, voffB); PG8_STAGE(PG8_SA(0, 0), a2, voffA);
            PG8_WAIT_V(8); PG8_WAIT_L(0); PG8_BAR; PG8_MMA(1, 0, At, B0); PG8_MMA(1, 1, At, B1); PG8_BAR; PG8_SCHED;
            PG8_LDB(B0, 1, 0); PG8_LDB(B1, 1, 1); PG8_SCHED; PG8_LDA(At, 1, 0); PG8_STAGE(PG8_SA(0, 1), a2 + hstepA, voffA);
            PG8_WAIT_V(8); PG8_WAIT_L(0); PG8_BAR; PG8_MMA(0, 0, At, B0); PG8_MMA(0, 1, At, B1); PG8_BAR; PG8_SCHED;
            PG8_LDA(At, 1, 1); PG8_STAGE(PG8_SB(1, 0), b3, voffB); PG8_STAGE(PG8_SB(1, 1), b3 + hstepB, voffB); PG8_STAGE(PG8_SA(1, 0), a3, voffA);
            PG8_WAIT_V(8); PG8_WAIT_L(0); PG8_BAR; PG8_MMA(1, 0, At, B0); PG8_MMA(1, 1, At, B1); PG8_BAR; PG8_SCHED;
            } else {
            PG8_LDB(B0, 0, 0); PG8_SCHED; PG8_LDA(At, 0, 0); PG8_STAGE(PG8_SA(1, 1), a1 + hstepA, voffA);
            PG8_WAIT_L(8); PG8_BAR; PG8_WAIT_L(0); PG8_MMA(0, 0, At, B0); PG8_BAR; PG8_SCHED;
            PG8_LDB(B1, 0, 1); PG8_STAGE(PG8_SB(0, 0), b2, voffB);
            PG8_BAR; PG8_WAIT_L(0); PG8_MMA(0, 1, At, B1); PG8_BAR;
            PG8_LDA(At, 0, 1); PG8_STAGE(PG8_SA(0, 0), a2, voffA);
            PG8_BAR; PG8_WAIT_L(0); PG8_MMA(1, 0, At, B0); PG8_BAR; PG8_SCHED;
            PG8_STAGE(PG8_SB(0, 1), b2 + hstepB, voffB);
            PG8_WAIT_V(6); PG8_BAR; PG8_MMA(1, 1, At, B1); PG8_BAR;
            PG8_LDB(B0, 1, 0); PG8_SCHED; PG8_LDA(At, 1, 0); PG8_STAGE(PG8_SA(0, 1), a2 + hstepA, voffA);
            PG8_WAIT_L(8); PG8_BAR; PG8_WAIT_L(0); PG8_MMA(0, 0, At, B0); PG8_BAR; PG8_SCHED;
            PG8_LDB(B1, 1, 1); PG8_STAGE(PG8_SB(1, 0), b3, voffB);
            PG8_BAR; PG8_WAIT_L(0); PG8_MMA(0, 1, At, B1); PG8_BAR;
            PG8_LDA(At, 1, 1); PG8_STAGE(PG8_SA(1, 0), a3, voffA);
            PG8_BAR; PG8_WAIT_L(0); PG8_MMA(1, 0, At, B0); PG8_BAR; PG8_SCHED;
            PG8_STAGE(PG8_SB(1, 1), b3 + hstepB, voffB);
            PG8_WAIT_V(6); PG8_BAR; PG8_MMA(1, 1, At, B1); PG8_BAR;
            }
        }
        if constexpr (ALIGN_EPI) { if (wr == 0) PG8_BAR; }
        if constexpr (!Epi::AFTER_DRAIN) { E(acc, cur, wr, wc, fr, fq); S.done(cur); }
        if (!has_next) break;
        bool keep_acc = false; if constexpr (Epi::KEEP) keep_acc = E.keep(cur);
        if (!keep_acc) {
#pragma unroll
        for (int a = 0; a < 2; ++a)
#pragma unroll
            for (int b = 0; b < 2; ++b)
#pragma unroll
                for (int m = 0; m < 4; ++m)
#pragma unroll
                    for (int n = 0; n < 2; ++n) acc[a][b][m][n] = (f32x4){0.f, 0.f, 0.f, 0.f};
        }
        cur = nxt; cA = nA; cB = nB; ++ui;
        if constexpr (ALIGN_EPI) { if (wr == 1) PG8_BAR; }
    }
    PG8_WAIT_V(0);
    if constexpr (!ALIGN_EPI) { if (wr == 0) PG8_BAR; }
    PG8_BAR;
    if constexpr (Epi::AFTER_DRAIN) { E.fused(acc, cur, wr, wc, fr, fq, lds, wid, lane); S.done(cur); }
#undef PG8_SA
#undef PG8_SB
#undef PG8_STAGE
#undef PG8_LDA
#undef PG8_LDB
#undef PG8_MMA
#undef PG8_WAIT_V
#undef PG8_WAIT_L
#undef PG8_BAR
#undef PG8_SCHED
}
}
#include <hip/hip_bf16.h>
#include <cmath>
namespace attn_body {
using bf16=__hip_bfloat16;
using bf16x8=__attribute__((ext_vector_type(8)))short;
using s16x4=__attribute__((ext_vector_type(4)))short;
using f32x16=__attribute__((ext_vector_type(16)))float;
using u32x4=__attribute__((ext_vector_type(4)))unsigned;
using f32x4_t=__attribute__((ext_vector_type(4)))float;
constexpr int BATCH=16,NHEAD=8,SEQ=4096,D=64,DM=NHEAD*D;
constexpr int NW=8,QBLK=32,QB=QBLK*NW,KVBLK=64,NQB=SEQ/QB;
constexpr int ATTN_PITCH=DM, ATTN_UNIT_ROWS=QB, OPITCH=1024;
__device__ __forceinline__ int crow(int r,int hi){return (r&3)+8*(r>>2)+4*hi;}
#define SBAR() __builtin_amdgcn_sched_barrier(0)
__device__ __forceinline__ void cmask(f32x16&p0,f32x16&p1,int jb,int qrel,int hi){
  const float NEG=-INFINITY; int kb=64*jb+4*hi;
  #pragma unroll
  for(int r=0;r<16;++r){int kv=kb+(r&3)+8*(r>>2); if(kv>qrel)p0[r]=NEG; if(kv+32>qrel)p1[r]=NEG;}
}

constexpr int NSLOT=3, SLOTB=8192;
constexpr int LDS_K=0, LDS_V=NSLOT*SLOTB, LDS_WS=2*NSLOT*SLOTB, LDS_OST=LDS_WS+NW*64*4, LDS_KB=LDS_OST+NW*4096, LDS_NXT=LDS_KB+SEQ*4, LDS_BYTES=LDS_NXT+16;
constexpr float C2=0.125f*1.4426950408889634f;
__device__ __forceinline__ void glds16(const void*gsrc,unsigned lds_dst){unsigned keep;
  asm volatile("s_mov_b32 %0, m0\n\ts_mov_b32 m0, %2\n\ts_nop 0\n\tglobal_load_lds_dwordx4 %1, off\n\ts_mov_b32 m0, %0":"=&s"(keep):"v"(gsrc),"s"(lds_dst):"memory");}
__device__ __forceinline__ float max3f(float a,float b,float c){float r;asm("v_max3_f32 %0, %1, %2, %3":"=v"(r):"v"(a),"v"(b),"v"(c));return r;}
__device__ __forceinline__ float max2f(float a,float b){float r;asm("v_max_f32_e32 %0, %1, %2":"=v"(r):"v"(a),"v"(b));return r;}
__device__ __forceinline__ float fadd_s(float a,float b){float r;asm("v_add_f32_e32 %0, %1, %2":"=v"(r):"v"(a),"v"(b));return r;}
__device__ __forceinline__ float fsub_s(float a,float b){float r;asm("v_sub_f32_e32 %0, %1, %2":"=v"(r):"v"(a),"v"(b));return r;}
typedef float f32x2_t __attribute__((ext_vector_type(2))); typedef __bf16 bf16x2_t __attribute__((ext_vector_type(2)));
__device__ __forceinline__ unsigned cvtpk_s(float lo,float hi){f32x2_t v={lo,hi};bf16x2_t b=__builtin_convertvector(v,bf16x2_t);return __builtin_bit_cast(unsigned,b);}
#define WAIT_BAR(N) asm volatile("s_waitcnt vmcnt(" #N ") lgkmcnt(0)\n\ts_barrier":::"memory")

__device__ __forceinline__ void qkt(f32x16&p0,f32x16&p1,const char*Kslot,const bf16x8*qr,int r32,int hi){
  const char*kb=Kslot+hi*1024+r32*16;
  #pragma unroll
  for(int d0=0;d0<4;++d0){
    const bf16x8 b0=*reinterpret_cast<const bf16x8*>(kb+d0*2048);
    const bf16x8 b1=*reinterpret_cast<const bf16x8*>(kb+d0*2048+512);
    {p0=__builtin_amdgcn_mfma_f32_32x32x16_bf16(b0,qr[d0],p0,0,0,0);p1=__builtin_amdgcn_mfma_f32_32x32x16_bf16(b1,qr[d0],p1,0,0,0);}}
}
typedef __attribute__((address_space(3))) const char* lds_cptr;
typedef short v4i16_t __attribute__((ext_vector_type(4)));
__device__ __forceinline__ void kload8(bf16x8*kf,lds_cptr kp){
  kf[0]=*(const __attribute__((address_space(3))) bf16x8*)(kp);      kf[1]=*(const __attribute__((address_space(3))) bf16x8*)(kp+512);
  kf[2]=*(const __attribute__((address_space(3))) bf16x8*)(kp+2048); kf[3]=*(const __attribute__((address_space(3))) bf16x8*)(kp+2560);
  kf[4]=*(const __attribute__((address_space(3))) bf16x8*)(kp+4096); kf[5]=*(const __attribute__((address_space(3))) bf16x8*)(kp+4608);
  kf[6]=*(const __attribute__((address_space(3))) bf16x8*)(kp+6144); kf[7]=*(const __attribute__((address_space(3))) bf16x8*)(kp+6656);
}
__device__ __forceinline__ void kload2(bf16x8*kf,lds_cptr kp,int j){ kf[2*j]=*(const __attribute__((address_space(3))) bf16x8*)(kp+j*2048); kf[2*j+1]=*(const __attribute__((address_space(3))) bf16x8*)(kp+j*2048+512); }
__device__ __forceinline__ s16x4 vtr(lds_cptr p){ return __builtin_bit_cast(s16x4,__builtin_amdgcn_ds_read_tr16_b64_v4i16((__attribute__((address_space(3))) v4i16_t*)p)); }
__device__ __forceinline__ float rowmax(const f32x16&p0,const f32x16&p1){
  float a=max3f(p0[0],p0[1],p1[0]),b=max3f(p0[2],p0[3],p1[1]);a=max3f(a,p1[2],p1[3]);
  #pragma unroll
  for(int r=4;r<16;r+=4){a=max3f(a,p0[r],p0[r+1]);b=max3f(b,p0[r+2],p0[r+3]);a=max3f(a,p1[r],p1[r+1]);b=max3f(b,p1[r+2],p1[r+3]);}
  const float m=max2f(a,b);
  auto rr=__builtin_amdgcn_permlane32_swap(__float_as_uint(m),__float_as_uint(m),false,false);
  return max2f(__uint_as_float(rr[0]),__uint_as_float(rr[1]));
}
__device__ __forceinline__ void pv(f32x16*o,int vb,bf16x8 pa0,bf16x8 pa1,bf16x8 pa2,bf16x8 pa3){
  #pragma unroll
  for(int d0=0;d0<2;++d0){s16x4 lo[4],hi[4];
    #pragma unroll
    for(int ks=0;ks<4;++ks){
      asm volatile("ds_read_b64_tr_b16 %0,%1 offset:%c2":"=&v"(lo[ks]):"v"(vb),"i"(d0*4096+ks*1024):"memory");
      asm volatile("ds_read_b64_tr_b16 %0,%1 offset:%c2":"=&v"(hi[ks]):"v"(vb),"i"(d0*4096+ks*1024+512):"memory");}
    asm volatile("s_waitcnt lgkmcnt(0)":::"memory");SBAR();
    #define PK(k) (bf16x8){lo[k][0],lo[k][1],lo[k][2],lo[k][3],hi[k][0],hi[k][1],hi[k][2],hi[k][3]}
    o[d0]=__builtin_amdgcn_mfma_f32_32x32x16_bf16(pa0,PK(0),o[d0],0,0,0);
    o[d0]=__builtin_amdgcn_mfma_f32_32x32x16_bf16(pa1,PK(1),o[d0],0,0,0);
    o[d0]=__builtin_amdgcn_mfma_f32_32x32x16_bf16(pa2,PK(2),o[d0],0,0,0);
    o[d0]=__builtin_amdgcn_mfma_f32_32x32x16_bf16(pa3,PK(3),o[d0],0,0,0);
    #undef PK
  }
}

#ifndef ATTN_STORE16
#define ATTN_STORE16(p,v) (*(u32x4*)(p)=(v))
#endif
template<int THRL> __device__ __forceinline__ void attn_unit(int b,int h,int qb,const bf16*Q,const bf16*__restrict__ K,const bf16*__restrict__ V,bf16*O,const float*__restrict__ KBG,float sbound,unsigned*qctr,int qbase,int nxoff,char*shm){
  int tid_l=threadIdx.x; asm volatile("":"+v"(tid_l));
  const int tid=tid_l,lane=tid&63,r32=lane&31,hi=lane>>5; const int wid=__builtin_amdgcn_readfirstlane(tid>>6);
  const long rowbase=(long)b*SEQ; const int q0=qb*QB;
  const bf16*Qw=Q+(rowbase+q0+wid*QBLK)*DM+h*D;
  const bf16*Kh=K+rowbase*DM+h*D,*Vh=V+rowbase*DM+h*D;
  const lds_cptr shm3=(lds_cptr)shm;
  const unsigned lds0=(unsigned)(uintptr_t)shm;
  float*wsf=(float*)(shm+LDS_WS)+wid*64;
  const bf16*ksrc_=Kh+(long)lane*DM+wid*8;
  const bf16*vsrc_=Vh+(long)(16*(wid&3)+(lane>>2))*DM+(wid>>2)*32+(lane&3)*8;
  const unsigned kdst=lds0+LDS_K+wid*1024, vdst=lds0+LDS_V+wid*1024;
  #define DMA_K(t,slot) glds16(ksrc+(long)(t)*KVBLK*DM,(unsigned)__builtin_amdgcn_readfirstlane(kdst+(slot)))
  #define DMA_V(t,slot) glds16(vsrc+(long)(t)*KVBLK*DM,(unsigned)__builtin_amdgcn_readfirstlane(vdst+(slot)))
  const int vb0=(int)(lds0+LDS_V)+((lane>>4)&1)*32+(lane&3)*8+(4*hi+((lane&15)>>2))*64;
  const char*Kbase=shm+LDS_K; bf16x8 kf[8];
  const lds_cptr kp0=shm3+LDS_K+hi*1024+r32*16; const lds_cptr vp0=shm3+LDS_V+((lane>>4)&1)*32+(lane&3)*8+(4*hi+((lane&15)>>2))*64;
  int NT=(q0+QB)/KVBLK;
  {
    const float*kg=KBG+((long)b*NHEAD+h)*SEQ; const float ref=kg[q0]; float*kbl=(float*)(shm+LDS_KB);
    for(int j=tid;j<q0+QB;j+=NW*64)kbl[j]=kg[j]-ref;
    if(tid==0){ const unsigned nx=__hip_atomic_fetch_add(qctr,1u,__ATOMIC_RELAXED,__HIP_MEMORY_SCOPE_AGENT); *(volatile unsigned*)(shm+LDS_NXT+nxoff)=nx+(unsigned)qbase; }
    asm volatile("s_waitcnt vmcnt(0) lgkmcnt(0)\n\ts_barrier":::"memory"); }
  int tskip; { const float*kbl=(const float*)(shm+LDS_KB); const bool dead=(lane<NT-4)&&(kbl[64*lane+63]+sbound<-140.f); tskip=__builtin_popcountll(__ballot(dead))&~1; }
  tskip=__builtin_amdgcn_readfirstlane(tskip); NT-=tskip;
  const bf16*ksrc=ksrc_+(long)tskip*KVBLK*DM; const bf16*vsrc=vsrc_+(long)tskip*KVBLK*DM;
  const __attribute__((address_space(3))) float*kbp0=(const __attribute__((address_space(3))) float*)(shm3+LDS_KB)+4*hi+64*tskip;
  DMA_K(0,0);DMA_V(0,0);DMA_K(1,SLOTB);
  bf16x8 qr[4];
  #pragma unroll
  for(int d0=0;d0<4;++d0)qr[d0]=*reinterpret_cast<const bf16x8*>(&Qw[(long)r32*DM+d0*16+hi*8]);
  float mhat=0.f,l_reg=0.f;f32x16 o[2];o[0]=f32x16{};o[1]=f32x16{};
  const int qrel=wid*QBLK+r32;
  #define CMASK(P0,P1,t) do{int jb_=(t)-(NT-4); if(jb_>=0)cmask(P0,P1,jb_,qrel,hi);}while(0)
  #define KBP(t,i) (kbp0+64*(t)+(((i)<4)?8*(i):32+8*((i)-4)))
  #define KINIT(P0,P1,t,MH) do{ _Pragma("unroll") for(int k_=0;k_<4;++k_){ const f32x4_t a_=*(const __attribute__((address_space(3))) f32x4_t*)KBP(t,k_); const f32x4_t b_=*(const __attribute__((address_space(3))) f32x4_t*)KBP(t,k_+4); \
      P0[4*k_]=a_[0]-(MH);P0[4*k_+1]=a_[1]-(MH);P0[4*k_+2]=a_[2]-(MH);P0[4*k_+3]=a_[3]-(MH); P1[4*k_]=b_[0]-(MH);P1[4*k_+1]=b_[1]-(MH);P1[4*k_+2]=b_[2]-(MH);P1[4*k_+3]=b_[3]-(MH); } }while(0)
  #define KLD(G,t,i,P) do{ if(G){ const f32x4_t a_=*(const __attribute__((address_space(3))) f32x4_t*)KBP((t)+1,i); P[4*((i)&3)]=a_[0]; P[4*((i)&3)+1]=a_[1]; P[4*((i)&3)+2]=a_[2]; P[4*((i)&3)+3]=a_[3]; } }while(0)
  #define KSUB(G,i,P) do{ if(G){ P[4*((i)&3)]-=mhat; P[4*((i)&3)+1]-=mhat; P[4*((i)&3)+2]-=mhat; P[4*((i)&3)+3]-=mhat; } }while(0)
  bool resc=false;
  #define START(P0,P1) do{ const float rm=rowmax(P0,P1); resc=false; \
    { const float dl=__builtin_fmaxf(rm,0.f); mhat=fadd_s(mhat,dl); \
      _Pragma("unroll") for(int r=0;r<16;++r){P0[r]=fsub_s(P0[r],dl);P1[r]=fsub_s(P1[r],dl);} \
      } \
    _Pragma("unroll") for(int r=0;r<16;++r)P0[r]=__builtin_amdgcn_exp2f(P0[r]); }while(0)
  #define RESC() do{ if(resc){ asm volatile("s_waitcnt lgkmcnt(0)":::"memory"); \
      _Pragma("unroll") for(int d_=0;d_<2;++d_) _Pragma("unroll") for(int r=0;r<16;++r)o[d_][r]*=wsf[crow(r,hi)]; } }while(0)
  int sl_prev=0,sl_cur=0,sl_next=SLOTB;
  #define ROT() do{sl_prev=sl_cur;sl_cur=sl_next;sl_next=(sl_next==(NSLOT-1)*SLOTB)?0:sl_next+SLOTB;}while(0)
  DMA_K(2,2*SLOTB);
  WAIT_BAR(3);
  f32x16 pA0,pA1,pB0,pB1;
  mhat=((const float*)(shm+LDS_KB))[q0+qrel];
  KINIT(pA0,pA1,0,mhat);
  qkt(pA0,pA1,Kbase,qr,r32,hi);asm volatile("s_nop 15\n\ts_nop 7":"+v"(pA0),"+v"(pA1));CMASK(pA0,pA1,0);
  START(pA0,pA1);
  KINIT(pB0,pB1,1,mhat);
  _Pragma("unroll") for(int r=0;r<16;++r)pA1[r]=__builtin_amdgcn_exp2f(pA1[r]);
  WAIT_BAR(0);
  DMA_K(3,0);DMA_V(1,SLOTB);
  ROT();
  kload8(kf,kp0+sl_cur);
  WAIT_BAR(2);
  s16x4 vlo[8],vhi[8]; u32x4 pw0,pw1,pw2,pw3;
  #define PKW(P,B) cvtpk_s(P[B],P[B+1])
  #define PAF(k) __builtin_bit_cast(bf16x8,pw##k)
  #define VFR(i) (bf16x8){vlo[i][0],vlo[i][1],vlo[i][2],vlo[i][3],vhi[i][0],vhi[i][1],vhi[i][2],vhi[i][3]}
  #define PIN(x) asm volatile("":"+v"(x))
  #define MX3(a,b,c) __builtin_fmaxf(__builtin_fmaxf((a),(b)),(c))
  #define GAPA(MF,A0,A1,A2,A3,W0,W1,PW) do{ MF; sacc+=A0; sacc+=A1; sacc+=A2; sacc+=A3; PIN(sacc); W0; W1; PIN(PW); SBAR(); }while(0)
  #define EX(v) __builtin_amdgcn_exp2f(v)
  #define GAPB(MF,X,B) do{ MF; X[B]=EX(X[B]); X[B+1]=EX(X[B+1]); X[B+2]=EX(X[B+2]); X[B+3]=EX(X[B+3]); PIN(X); SBAR(); }while(0)
  #define VRD(i) do{ vlo[i]=vtr(vp_+(((i)>>2)*4096+((i)&3)*1024)); vhi[i]=vtr(vp_+(((i)>>2)*4096+((i)&3)*1024+512)); }while(0)
  #define KRD(G,j) do{ if(G){ kload2(kf,kp0+sl_next,j); SBAR(); } }while(0)
  #define STEP(C0,C1,P0,P1,t,GK,GV,GL) do{ SBAR(); \
    const lds_cptr vp_=vp0+sl_prev; \
    VRD(0); SBAR(); float sacc=(P0[0]+P0[1]); \
    GAPA(C0=__builtin_amdgcn_mfma_f32_32x32x16_bf16(kf[0],qr[0],C0,0,0,0), P0[2],P0[3],P0[4],P0[5],     pw0[0]=PKW(P0,0), pw0[1]=PKW(P0,2), pw0); \
    VRD(4); SBAR(); GAPA(C1=__builtin_amdgcn_mfma_f32_32x32x16_bf16(kf[1],qr[0],C1,0,0,0), P0[6],P0[7],P0[8],P0[9],     pw0[2]=PKW(P0,4), pw0[3]=PKW(P0,6), pw0); \
    VRD(1); SBAR(); GAPA(C0=__builtin_amdgcn_mfma_f32_32x32x16_bf16(kf[2],qr[1],C0,0,0,0),   P0[10],P0[11],P0[12],P0[13], pw1[0]=PKW(P0,8), pw1[1]=PKW(P0,10), pw1); \
    VRD(5); SBAR(); GAPA(C1=__builtin_amdgcn_mfma_f32_32x32x16_bf16(kf[3],qr[1],C1,0,0,0),   P0[14],P0[15],P1[0],P1[1],   pw1[2]=PKW(P0,12),pw1[3]=PKW(P0,14), pw1); \
    VRD(2); SBAR(); GAPA(C0=__builtin_amdgcn_mfma_f32_32x32x16_bf16(kf[4],qr[2],C0,0,0,0),   P1[2],P1[3],P1[4],P1[5],     pw2[0]=PKW(P1,0), pw2[1]=PKW(P1,2), pw2); \
    VRD(6); SBAR(); GAPA(C1=__builtin_amdgcn_mfma_f32_32x32x16_bf16(kf[5],qr[2],C1,0,0,0),   P1[6],P1[7],P1[8],P1[9],     pw2[2]=PKW(P1,4), pw2[3]=PKW(P1,6), pw2); \
    VRD(3); SBAR(); GAPA(C0=__builtin_amdgcn_mfma_f32_32x32x16_bf16(kf[6],qr[3],C0,0,0,0),   P1[10],P1[11],P1[12],P1[13], pw3[0]=PKW(P1,8), pw3[1]=PKW(P1,10), pw3); \
    VRD(7); SBAR(); GAPA(C1=__builtin_amdgcn_mfma_f32_32x32x16_bf16(kf[7],qr[3],C1,0,0,0),   P1[14],P1[15],0.f,0.f,       pw3[2]=PKW(P1,12),pw3[3]=PKW(P1,14), pw3); \
    l_reg+=sacc; \
    if(GK){DMA_K((t)+3,sl_cur);} if(GV){DMA_V((t)+1,sl_next);} \
    CMASK(C0,C1,t); \
    { float a=MX3(C0[0],C0[1],C1[0]),b=MX3(C0[2],C0[3],C1[1]); a=MX3(a,C1[2],C1[3]); \
      _Pragma("unroll") for(int r=4;r<16;r+=4){a=MX3(a,C0[r],C0[r+1]);b=MX3(b,C0[r+2],C0[r+3]);a=MX3(a,C1[r],C1[r+1]);b=MX3(b,C1[r+2],C1[r+3]);} \
      float rm=__builtin_fmaxf(a,b); { auto rr=__builtin_amdgcn_permlane32_swap(__float_as_uint(rm),__float_as_uint(rm),false,false); rm=__builtin_fmaxf(__uint_as_float(rr[0]),__uint_as_float(rr[1])); } \
      resc=false; \
      if(__builtin_expect(__any(rm>(float)THRL),0)){ const float dl=__builtin_fmaxf(rm,0.f); mhat+=dl; \
        _Pragma("unroll") for(int r=0;r<16;++r){C0[r]-=dl;C1[r]-=dl;} \
        const float f=__builtin_amdgcn_exp2f(-dl); l_reg*=f; if(hi==0)wsf[r32]=f; resc=true; } } \
    SBAR(); \
    KLD(GL,t,0,P0); GAPB(o[0]=__builtin_amdgcn_mfma_f32_32x32x16_bf16(PAF(0),VFR(0),o[0],0,0,0), C0,0); \
    KLD(GL,t,1,P0); KSUB(GL,0,P0); GAPB(o[1]=__builtin_amdgcn_mfma_f32_32x32x16_bf16(PAF(0),VFR(4),o[1],0,0,0), C0,4); \
    KRD(GL,0); KLD(GL,t,2,P0); KSUB(GL,1,P0); GAPB(o[0]=__builtin_amdgcn_mfma_f32_32x32x16_bf16(PAF(1),VFR(1),o[0],0,0,0), C0,8); \
    KRD(GL,1); KLD(GL,t,3,P0); KSUB(GL,2,P0); GAPB(o[1]=__builtin_amdgcn_mfma_f32_32x32x16_bf16(PAF(1),VFR(5),o[1],0,0,0), C0,12); \
    KRD(GL,2); KLD(GL,t,4,P1); KSUB(GL,3,P0); GAPB(o[0]=__builtin_amdgcn_mfma_f32_32x32x16_bf16(PAF(2),VFR(2),o[0],0,0,0), C1,0); \
    KRD(GL,3); KLD(GL,t,5,P1); KSUB(GL,4,P1); GAPB(o[1]=__builtin_amdgcn_mfma_f32_32x32x16_bf16(PAF(2),VFR(6),o[1],0,0,0), C1,4); \
    KLD(GL,t,6,P1); KSUB(GL,5,P1); GAPB(o[0]=__builtin_amdgcn_mfma_f32_32x32x16_bf16(PAF(3),VFR(3),o[0],0,0,0), C1,8); \
    KLD(GL,t,7,P1); KSUB(GL,6,P1); GAPB(o[1]=__builtin_amdgcn_mfma_f32_32x32x16_bf16(PAF(3),VFR(7),o[1],0,0,0), C1,12); \
    KSUB(GL,7,P1); \
    }while(0)
  int t=1;
  #undef CMASK
  #define CMASK(P0,P1,t) do{}while(0)
  for(;t+5<NT;t+=2){
    STEP(pB0,pB1,pA0,pA1,t,true,true,true);     WAIT_BAR(2); RESC(); ROT();
    STEP(pA0,pA1,pB0,pB1,t+1,true,true,true);   WAIT_BAR(2); RESC(); ROT();
  }
  #undef CMASK
  #define CMASK(P0,P1,t) do{int jb_=(t)-(NT-4); if(jb_>=0)cmask(P0,P1,jb_,qrel,hi);}while(0)
  #define ENDW(tt) do{ if((tt)+3<NT){WAIT_BAR(2);} else if((tt)+2<NT){WAIT_BAR(1);} else {WAIT_BAR(0);} }while(0)
  for(;t+1<NT;t+=2){
    STEP(pB0,pB1,pA0,pA1,t,(t+3<NT),(t+1<NT),(t+1<NT));       ENDW(t);   RESC(); ROT();
    STEP(pA0,pA1,pB0,pB1,t+1,(t+4<NT),(t+2<NT),(t+2<NT));     ENDW(t+1); RESC(); ROT();
  }
  STEP(pB0,pB1,pA0,pA1,NT-1,false,false,false); RESC();
  { float sacc=pB0[0]+pB0[1]; _Pragma("unroll") for(int r=2;r<16;++r)sacc+=pB0[r]; _Pragma("unroll") for(int r=0;r<16;++r)sacc+=pB1[r]; l_reg+=sacc;
    pw0=(u32x4){PKW(pB0,0),PKW(pB0,2),PKW(pB0,4),PKW(pB0,6)};pw1=(u32x4){PKW(pB0,8),PKW(pB0,10),PKW(pB0,12),PKW(pB0,14)};pw2=(u32x4){PKW(pB1,0),PKW(pB1,2),PKW(pB1,4),PKW(pB1,6)};pw3=(u32x4){PKW(pB1,8),PKW(pB1,10),PKW(pB1,12),PKW(pB1,14)};
    SBAR(); pv(o,vb0+sl_cur,PAF(0),PAF(1),PAF(2),PAF(3)); }
  #undef PKW
  #undef PAF
  #undef VFR
  #undef PIN
  #undef MX3
  #undef GAPA
  #undef GAPB
  #undef EX
  #undef VRD
  #undef KRD
  #undef STEP
  #undef ENDW
  {auto rr=__builtin_amdgcn_permlane32_swap(__float_as_uint(l_reg),__float_as_uint(l_reg),false,false);l_reg=__uint_as_float(rr[0])+__uint_as_float(rr[1]);}
  if(hi==0)wsf[32+r32]=l_reg;asm volatile("s_waitcnt lgkmcnt(0)":::"memory");
  float rli[16];
  #pragma unroll
  for(int r=0;r<16;++r)rli[r]=__builtin_amdgcn_rcpf(wsf[32+crow(r,hi)]);
  bf16*Ow=O+(rowbase+q0+wid*QBLK)*OPITCH+h*D;
  { bf16*stg=(bf16*)(shm+LDS_OST)+wid*2048;
    #pragma unroll
    for(int r=0;r<16;++r){const int orow=crow(r,hi);
      #pragma unroll
      for(int d0=0;d0<2;++d0)stg[orow*64+d0*32+r32]=__float2bfloat16(o[d0][r]*rli[r]);}
    asm volatile("s_waitcnt lgkmcnt(0)":::"memory");
    #pragma unroll
    for(int i=0;i<4;++i){const int row=i*8+(lane>>3),ch=lane&7; const u32x4 v=*(const u32x4*)(stg+row*64+ch*8); ATTN_STORE16(Ow+(long)row*OPITCH+ch*8,v);} }
  asm volatile("s_waitcnt lgkmcnt(0)\n\ts_barrier":::"memory");
  #undef DMA_K
  #undef DMA_V
  #undef CMASK
  #undef KINIT
  #undef KLD
  #undef KSUB
  #undef KBP
  #undef START
  #undef RESC
  #undef ROT
}
constexpr int ATTN_LDS_BYTES=LDS_BYTES;
struct AttnTensors { const bf16* Q; const bf16* K; const bf16* V; bf16* O; const float* KB; };
template<int THRL=8> __device__ __forceinline__ void attn_phase(char*lds,const AttnTensors&T,float sbound,unsigned*qctr,int bx,int G){
  constexpr int NU=BATCH*NHEAD*NQB; int u=bx,nxoff=0;
  _Pragma("unroll 1") while(u<NU){ const int qb=NQB-1-u/(BATCH*NHEAD), bh=u%(BATCH*NHEAD);
    attn_unit<THRL>(bh/NHEAD,bh%NHEAD,qb,T.Q,T.K,T.V,T.O,T.KB,sbound,qctr,G,nxoff,lds);
    u=(int)*(volatile unsigned*)(lds+LDS_NXT+nxoff); u=__builtin_amdgcn_readfirstlane(u); nxoff^=4; }
}
#undef SBAR
#undef WAIT_BAR
}
namespace cg = cooperative_groups;
#define LAS __attribute__((address_space(3)))
typedef unsigned short bf16;
using pg8::f32x4; using pg8::u32x4; using pg8::Unit; using pg8::cvt_pk_bf16;
typedef unsigned u32x2 __attribute__((ext_vector_type(2)));

constexpr int NB = 16, SEQ = 4096, T = NB * SEQ, D = 1024, FF = 4096, INC = 5128, NIN = 5376, UP = 640, NLAYER = 2;
constexpr float EPS = 1e-6f, LOG2E = 1.4426950408889634f, C2Q = 0.125f * LOG2E;
enum { I_X = 0, I_MIXN, I_WIN, I_BF, I_QN, I_KN, I_ARE, I_AIM, I_LDT, I_BRE, I_BIM, I_CRE, I_CIM, I_SD, I_WGLU, I_PW, I_PS, I_WBA, I_WBS, I_WBP, I_BG, I_WOUT, I_MLPN, I_WUP, I_WDN, N_IN };

constexpr size_t MiB = 1u << 20;
constexpr size_t WL_STRIDE = 48 * MiB;
constexpr size_t WL_WIN = 0, WL_WA = 11 * MiB  , WL_WOUT = 13 * MiB, WL_WUP = 15 * MiB, WL_WDN = 23 * MiB,
                 WL_WGLU = 31 * MiB, WL_TZ = 32 * MiB, WL_MEND = 42 * MiB, WL_DL = 46 * MiB;
constexpr size_t WS_ACAT = 96 * MiB;
constexpr size_t WS_XB = 96 * MiB, WS_SSQ = 224 * MiB, WS_Q = 228 * MiB, WS_K = 292 * MiB, WS_V = 356 * MiB, WS_MERGED = WS_K, WS_U = 420 * MiB, WS_UPOOL = 460 * MiB,
                 WS_GATES = 492 * MiB, WS_FLOG = 876 * MiB, WS_KB = 878 * MiB, WS_S = 880 * MiB, WS_YPRE = 896 * MiB, WS_YSSM = 928 * MiB, WS_POOLED = 960 * MiB,
                 WS_DBG = 992 * MiB, WS_END = 1001 * MiB, WS_ACT = WS_U;
static_assert(WS_ACT + (size_t)T * FF * 2 <= WS_POOLED && WS_MERGED + (size_t)T * D * 2 <= WS_ACT, "act overlay");
constexpr int LDS_BYTES = 147456;

constexpr int N_PHASES_ = 1 + 9 * NLAYER;
struct Params { const float* in[N_IN]; float* out; unsigned char* ws; int ph_lo, ph_hi, dbg, pad; };

__device__ __forceinline__ u32x4 pack8(f32x4 a, f32x4 b) { u32x4 w; w.x = cvt_pk_bf16(a[0], a[1]); w.y = cvt_pk_bf16(a[2], a[3]); w.z = cvt_pk_bf16(b[0], b[1]); w.w = cvt_pk_bf16(b[2], b[3]); return w; }
__device__ __forceinline__ void unpack8(u32x4 w, f32x4& a, f32x4& b) {
    a[0] = __uint_as_float(w.x << 16); a[1] = __uint_as_float(w.x & 0xffff0000u); a[2] = __uint_as_float(w.y << 16); a[3] = __uint_as_float(w.y & 0xffff0000u);
    b[0] = __uint_as_float(w.z << 16); b[1] = __uint_as_float(w.z & 0xffff0000u); b[2] = __uint_as_float(w.w << 16); b[3] = __uint_as_float(w.w & 0xffff0000u); }
__device__ __forceinline__ float bf2f(bf16 v) { return __uint_as_float((unsigned)v << 16); }
__device__ __forceinline__ float dot4(f32x4 a) { return (a[0] * a[0] + a[1] * a[1]) + (a[2] * a[2] + a[3] * a[3]); }
__device__ __forceinline__ float row_rstd(const float* ssq, int row) {
    const f32x4* p = (const f32x4*)(ssq + (size_t)row * 16); const f32x4 a = p[0], b = p[1], c = p[2], d = p[3];
    const float s = ((a[0] + a[1]) + (a[2] + a[3])) + ((b[0] + b[1]) + (b[2] + b[3])) + ((c[0] + c[1]) + (c[2] + c[3])) + ((d[0] + d[1]) + (d[2] + d[3]));
    return __builtin_amdgcn_rsqf(s * (1.0f / D) + EPS); }
__device__ __forceinline__ float sigm(float x) { return __builtin_amdgcn_rcpf(1.0f + __expf(-x)); }
__device__ __forceinline__ f32x4 sigm4(f32x4 x) { f32x4 r; r[0] = sigm(x[0]); r[1] = sigm(x[1]); r[2] = sigm(x[2]); r[3] = sigm(x[3]); return r; }
__device__ __forceinline__ float gelu_t(float y) { const float z = 1.5957691216057308f * (y + 0.044715f * y * y * y); return y * __builtin_amdgcn_rcpf(1.0f + __expf(-z)); }
__device__ __forceinline__ f32x4 gelu4(f32x4 x) { f32x4 r; r[0] = gelu_t(x[0]); r[1] = gelu_t(x[1]); r[2] = gelu_t(x[2]); r[3] = gelu_t(x[3]); return r; }
__device__ __forceinline__ float logsig(float x) { return fminf(x, 0.f) - log1pf(__expf(-fabsf(x))); }

struct EpiIn {
    static constexpr bool PERM = true, AFTER_DRAIN = false, KEEP = false;
    bf16 *q, *k, *v, *U, *upool, *gates; float* flog; const float* ssq; const float *qg, *kg, *bgate, *bforget;
    __device__ __forceinline__ void operator()(const f32x4 (&acc)[2][2][4][2], const Unit& u, int wr, int wc, int fr, int fq) const {
        const int tile = u.pn, row0 = u.pm * 256 + wr * 64 + fr, cc0 = wc * 32 + 8 * fq;
        float rsv[2][4];
#pragma unroll
        for (int ai = 0; ai < 2; ++ai)
#pragma unroll
            for (int m = 0; m < 4; ++m) rsv[ai][m] = row_rstd(ssq, row0 + ai * 128 + m * 16);
        if (tile < 4) {
            const bool isq = tile < 2; const float* gp = (isq ? qg : kg) + 8 * fq; bf16* O = isq ? q : k; const int head = (tile & 1) * 4 + wc; const float sc = isq ? C2Q : 1.f;
            f32x4 g[2][2];
#pragma unroll
            for (int bj = 0; bj < 2; ++bj)
#pragma unroll
                for (int n = 0; n < 2; ++n) g[bj][n] = *(const f32x4*)(gp + 32 * bj + 4 * n);
#pragma unroll
            for (int ai = 0; ai < 2; ++ai)
#pragma unroll
                for (int m = 0; m < 4; ++m) { const int row = row0 + ai * 128 + m * 16; const float rs = rsv[ai][m];
                    f32x4 vv[2][2]; float ss = 0.f;
#pragma unroll
                    for (int bj = 0; bj < 2; ++bj)
#pragma unroll
                        for (int n = 0; n < 2; ++n) { vv[bj][n] = acc[ai][bj][m][n] * rs; ss += dot4(vv[bj][n]); }
                    ss += __shfl_xor(ss, 16); ss += __shfl_xor(ss, 32);
                    const float r = __builtin_amdgcn_rsqf(ss * (1.0f / 64.0f) + EPS) * sc;
#pragma unroll
                    for (int bj = 0; bj < 2; ++bj) *(u32x4*)(O + (size_t)row * 512 + head * 64 + 32 * bj + 8 * fq) = pack8(vv[bj][0] * r * g[bj][0], vv[bj][1] * r * g[bj][1]); __builtin_amdgcn_sched_barrier(0); }
        } else if (tile < 8) {
#pragma unroll
            for (int ai = 0; ai < 2; ++ai)
#pragma unroll
                for (int m = 0; m < 4; ++m) { const int row = row0 + ai * 128 + m * 16; const float rs = rsv[ai][m];
#pragma unroll
                    for (int bj = 0; bj < 2; ++bj) { const int cc = 128 * bj + cc0; bf16* dst;
                        if (tile < 6) dst = v + (size_t)row * 512 + (tile - 4) * 256 + cc;
                        else if (tile == 6) { const int g = cc >> 4, ci0 = cc & 15, b = row >> 12, s = row & 4095; dst = U + ((size_t)(g * 2048 + b * 128 + (s >> 5)) * UP + (s & 31) * 16 + ci0); }
                        else dst = upool + (size_t)row * 256 + cc;
                        *(u32x4*)dst = pack8(acc[ai][bj][m][0] * rs, acc[ai][bj][m][1] * rs); } __builtin_amdgcn_sched_barrier(0); }
        } else if (tile < 20) {
#pragma unroll
            for (int bj = 0; bj < 2; ++bj) { const int col = (tile - 8) * 256 + 128 * bj + cc0; const f32x4 b0 = *(const f32x4*)(bgate + col), b1 = *(const f32x4*)(bgate + col + 4);
#pragma unroll
                for (int ai = 0; ai < 2; ++ai)
#pragma unroll
                    for (int m = 0; m < 4; ++m) { const int row = row0 + ai * 128 + m * 16; const float rs = rsv[ai][m];
                        *(u32x4*)(gates + (size_t)row * 3072 + col) = pack8(sigm4(acc[ai][bj][m][0] * rs + b0), sigm4(acc[ai][bj][m][1] * rs + b1)); __builtin_amdgcn_sched_barrier(0); } }
        } else {
            if (wc == 0 && fq == 0) { const f32x4 b0 = *(const f32x4*)(bforget), b1 = *(const f32x4*)(bforget + 4);
#pragma unroll
                for (int ai = 0; ai < 2; ++ai)
#pragma unroll
                    for (int m = 0; m < 4; ++m) { const int row = row0 + ai * 128 + m * 16; const float rs = rsv[ai][m];
                        const f32x4 x0 = acc[ai][0][m][0] * rs + b0, x1 = acc[ai][0][m][1] * rs + b1; f32x4 o0, o1;
#pragma unroll
                        for (int e = 0; e < 4; ++e) { o0[e] = logsig(x0[e]); o1[e] = logsig(x1[e]); }
                        *(f32x4*)(flog + (size_t)row * 8) = o0; *(f32x4*)(flog + (size_t)row * 8 + 4) = o1; } }
        }
    }
};
struct EpiSend {
    static constexpr bool PERM = true, AFTER_DRAIN = false, KEEP = false;
    float* S;
    __device__ __forceinline__ void operator()(const f32x4 (&acc)[2][2][4][2], const Unit& u, int wr, int wc, int fr, int fq) const {
        const int row0 = u.pm * 256 + wr * 64 + fr, cc0 = wc * 32 + 8 * fq;
#pragma unroll
        for (int ai = 0; ai < 2; ++ai)
#pragma unroll
            for (int m = 0; m < 4; ++m) { float* p = S + (size_t)(row0 + ai * 128 + m * 16) * 128 + cc0; *(f32x4*)p = acc[ai][0][m][0]; *(f32x4*)(p + 4) = acc[ai][0][m][1]; }
    }
};
struct EpiSsmY {
    static constexpr bool PERM = true, AFTER_DRAIN = false, KEEP = false;
    const bf16* U; const float* sd; bf16* ypre;
    __device__ __forceinline__ void operator()(const f32x4 (&acc)[2][2][4][2], const Unit& u, int wr, int wc, int fr, int fq) const {
        const int g = u.pm >> 3, pnl = u.pn & 1, row0 = u.pm * 256 + wr * 64 + fr, cc0 = wc * 32 + 8 * fq;
        u32x4 uw[2][2][4];
#pragma unroll
        for (int bj = 0; bj < 2; ++bj)
#pragma unroll
            for (int ai = 0; ai < 2; ++ai)
#pragma unroll
                for (int m = 0; m < 4; ++m) uw[bj][ai][m] = *(const u32x4*)(U + (size_t)(row0 + ai * 128 + m * 16) * UP + pnl * 256 + 128 * bj + cc0);
#pragma unroll
        for (int bj = 0; bj < 2; ++bj) { const int colidx = pnl * 256 + 128 * bj + cc0, t = colidx >> 4, co0 = colidx & 15;
            const f32x4 d0 = *(const f32x4*)(sd + g * 16 + co0), d1 = *(const f32x4*)(sd + g * 16 + co0 + 4);
#pragma unroll
            for (int ai = 0; ai < 2; ++ai)
#pragma unroll
                for (int m = 0; m < 4; ++m) { const int grow = row0 + ai * 128 + m * 16, rl = grow & 2047, b = rl >> 7, c = rl & 127;
                    f32x4 ua, ub; unpack8(uw[bj][ai][m], ua, ub);
                    *(u32x4*)(ypre + (size_t)(b * 4096 + c * 32 + t) * 256 + g * 16 + co0) = pack8(gelu4(acc[ai][bj][m][0] + d0 * ua), gelu4(acc[ai][bj][m][1] + d1 * ub)); } }
    }
};
struct EpiGlu {
    static constexpr bool PERM = true, AFTER_DRAIN = false, KEEP = false;
    bf16* yssm;
    __device__ __forceinline__ void operator()(const f32x4 (&acc)[2][2][4][2], const Unit& u, int wr, int wc, int fr, int fq) const {
        const int row0 = u.pm * 256 + wr * 64 + fr, col = u.pn * 128 + wc * 32 + 8 * fq;
#pragma unroll
        for (int ai = 0; ai < 2; ++ai)
#pragma unroll
            for (int m = 0; m < 4; ++m) { const int row = row0 + ai * 128 + m * 16;
                *(u32x4*)(yssm + (size_t)row * 1024 + 512 + col) = pack8(acc[ai][0][m][0] * sigm4(acc[ai][1][m][0]), acc[ai][0][m][1] * sigm4(acc[ai][1][m][1])); __builtin_amdgcn_sched_barrier(0); }
    }
};
struct EpiGate3 {
    static constexpr bool PERM = true, AFTER_DRAIN = false, KEEP = true;
    const bf16* gates; bf16* merged;
    __device__ __forceinline__ bool keep(const Unit& u) const { return u.ko != 768; }
    __device__ __forceinline__ void operator()(f32x4 (&acc)[2][2][4][2], const Unit& u, int wr, int wc, int fr, int fq) const {
        const int row0 = u.pm * 256 + wr * 64 + fr, cc0 = wc * 32 + 8 * fq, gi = (u.ko == 0) ? 0 : (u.ko == 512) ? 1 : 2;
        const bf16* gp = gates + (size_t)row0 * 3072 + gi * 1024 + u.pn * 256 + cc0; bf16* mp = merged + (size_t)row0 * 1024 + u.pn * 256 + cc0;
#pragma unroll
        for (int ai = 0; ai < 2; ++ai) { u32x4 gw[4][2], hw[4][2];
#pragma unroll
            for (int m = 0; m < 4; ++m)
#pragma unroll
                for (int bj = 0; bj < 2; ++bj) { const bf16* p = gp + (size_t)(ai * 128 + m * 16) * 3072 + 128 * bj; gw[m][bj] = *(const u32x4*)p; if (gi != 2) hw[m][bj] = *(const u32x4*)(p + 1024); }
#pragma unroll
            for (int m = 0; m < 4; ++m)
#pragma unroll
                for (int bj = 0; bj < 2; ++bj) { f32x4 ga, gb; unpack8(gw[m][bj], ga, gb);
                    if (gi != 2) { f32x4 ha, hb; unpack8(hw[m][bj], ha, hb);
#pragma unroll
                        for (int e = 0; e < 4; ++e) { ga[e] *= __builtin_amdgcn_rcpf(fmaxf(ha[e], 1e-30f)); gb[e] *= __builtin_amdgcn_rcpf(fmaxf(hb[e], 1e-30f)); }
                        acc[ai][bj][m][0] *= ga; acc[ai][bj][m][1] *= gb; }
                    else *(u32x4*)(mp + (size_t)(ai * 128 + m * 16) * 1024 + 128 * bj) = pack8(acc[ai][bj][m][0] * ga, acc[ai][bj][m][1] * gb); } }
    }
};
struct TriOrder {
    pg8::StaticOrder S;
    __device__ __forceinline__ bool next(int i, Unit& u) const { const int ib = i / 3, gi = i - 3 * ib; if (!S.next(ib, u)) return false; u.ko = (gi == 0) ? 0 : (gi == 1) ? 512 : 768; u.nt = (gi == 0) ? 8 : 4; return true; }
    __device__ __forceinline__ void a_ready(const Unit&) const {}
    __device__ __forceinline__ void done(const Unit&) const {}
};
template <int MODE> struct EpiRes {
    static constexpr bool PERM = true, AFTER_DRAIN = false, KEEP = false;
    const float* xin; float* xout; bf16* xb; float* ssq; bool next;
    __device__ __forceinline__ void operator()(const f32x4 (&acc)[2][2][4][2], const Unit& u, int wr, int wc, int fr, int fq) const {
        const int row0 = u.pm * 256 + wr * 64 + fr, cc0 = wc * 32 + 8 * fq; const size_t off0 = (size_t)row0 * 1024 + u.pn * 256 + cc0;
#pragma unroll
        for (int ai = 0; ai < 2; ++ai) { f32x4 ra[4][2], rb[4][2];
#pragma unroll
            for (int m = 0; m < 4; ++m)
#pragma unroll
                for (int bj = 0; bj < 2; ++bj) { const size_t off = off0 + (size_t)(ai * 128 + m * 16) * 1024 + 128 * bj;
                    if (MODE == 0) { ra[m][bj] = *(const f32x4*)(xin + off); rb[m][bj] = *(const f32x4*)(xin + off + 4); } else unpack8(*(const u32x4*)(xb + off), ra[m][bj], rb[m][bj]); }
#pragma unroll
            for (int m = 0; m < 4; ++m) { const int row = row0 + ai * 128 + m * 16; float ss = 0.f;
#pragma unroll
                for (int bj = 0; bj < 2; ++bj) { const size_t off = off0 + (size_t)(ai * 128 + m * 16) * 1024 + 128 * bj;
                    const f32x4 a = ra[m][bj] + acc[ai][bj][m][0], b = rb[m][bj] + acc[ai][bj][m][1];
                    if (MODE == 1) { *(f32x4*)(xout + off) = a; *(f32x4*)(xout + off + 4) = b; }
                    if (MODE == 0 || next) { *(u32x4*)(xb + off) = pack8(a, b); ss += dot4(a) + dot4(b); } }
                if (MODE == 0 || next) { ss += __shfl_xor(ss, 16); ss += __shfl_xor(ss, 32); if (fq == 0) ssq[(size_t)row * 16 + u.pn * 4 + wc] = ss; } }
            __builtin_amdgcn_sched_barrier(0); }
    }
};
struct EpiUp {
    static constexpr bool PERM = true, AFTER_DRAIN = false, KEEP = false;
    bf16* act; const float* ssq;
    __device__ __forceinline__ void operator()(const f32x4 (&acc)[2][2][4][2], const Unit& u, int wr, int wc, int fr, int fq) const {
        const int row0 = u.pm * 256 + wr * 64 + fr, cc0 = wc * 32 + 8 * fq;
        float rsv[2][4];
#pragma unroll
        for (int ai = 0; ai < 2; ++ai)
#pragma unroll
            for (int m = 0; m < 4; ++m) rsv[ai][m] = row_rstd(ssq, row0 + ai * 128 + m * 16);
#pragma unroll
        for (int ai = 0; ai < 2; ++ai)
#pragma unroll
            for (int m = 0; m < 4; ++m) { const int row = row0 + ai * 128 + m * 16; const float rs = rsv[ai][m];
#pragma unroll
                for (int bj = 0; bj < 2; ++bj) { f32x4 a = acc[ai][bj][m][0] * rs, b = acc[ai][bj][m][1] * rs;
#pragma unroll
                    for (int e = 0; e < 4; ++e) { const float x0 = fmaxf(a[e], 0.f), x1 = fmaxf(b[e], 0.f); a[e] = x0 * x0; b[e] = x1 * x1; }
                    *(u32x4*)(act + (size_t)row * FF + u.pn * 256 + 128 * bj + cc0) = pack8(a, b); } __builtin_amdgcn_sched_barrier(0); }
    }
};
__device__ __forceinline__ void flog_panel(const bf16* xb, const bf16* wf, const float* ssq, const float* bforget, float* flog, int pm, int wave, int lane) {
    typedef short bf16x8_t __attribute__((ext_vector_type(8)));
    const int fr = lane & 15, fq = lane >> 4, r0 = pm * 256 + wave * 32;
    const bf16* a0 = xb + (size_t)(r0 + fr) * D + 8 * fq; const bf16* a1 = a0 + (size_t)16 * D; const bf16* bp = wf + (size_t)fr * D + 8 * fq;
    f32x4 c0 = {0.f, 0.f, 0.f, 0.f}, c1 = c0;
#pragma unroll 8
    for (int ks = 0; ks < D / 32; ++ks) { const bf16x8_t bv = *(const bf16x8_t*)(bp + 32 * ks), x0 = *(const bf16x8_t*)(a0 + 32 * ks), x1 = *(const bf16x8_t*)(a1 + 32 * ks);
        c0 = __builtin_amdgcn_mfma_f32_16x16x32_bf16(bv, x0, c0, 0, 0, 0); c1 = __builtin_amdgcn_mfma_f32_16x16x32_bf16(bv, x1, c1, 0, 0, 0); }
    if (fq < 2) { const f32x4 bb = *(const f32x4*)(bforget + 4 * fq);
        const float rs0 = row_rstd(ssq, r0 + fr), rs1 = row_rstd(ssq, r0 + 16 + fr); f32x4 o0, o1;
#pragma unroll
        for (int e = 0; e < 4; ++e) { o0[e] = logsig(c0[e] * rs0 + bb[e]); o1[e] = logsig(c1[e] * rs1 + bb[e]); }
        *(f32x4*)(flog + (size_t)(r0 + fr) * 8 + 4 * fq) = o0; *(f32x4*)(flog + (size_t)(r0 + 16 + fr) * 8 + 4 * fq) = o1; }
}
struct BatchOrder {
    int nG, nMg, nNg, G, c;
    __device__ __forceinline__ bool next(int i, Unit& u) const { const long L = (long)i * G + c; if (L >= (long)nG * nMg * nNg) return false;
        const int l = (int)L, per = nMg * nNg, g = l / per, r = l % per; u.pm = g * nMg + (r % nMg); u.pn = g * nNg + (r / nMg); return true; }
    __device__ __forceinline__ void a_ready(const Unit&) const {}
    __device__ __forceinline__ void done(const Unit&) const {}
};

#define LDS_WAIT() asm volatile("s_waitcnt lgkmcnt(0)" ::: "memory")
__device__ __forceinline__ float wave_sum(float v) {
#pragma unroll
    for (int o = 1; o < 64; o <<= 1) v += __shfl_xor(v, o);
    return v; }
__device__ __forceinline__ unsigned f2bf(float f) { unsigned u = __builtin_bit_cast(unsigned, f); return (u + 0x7fffu + ((u >> 16) & 1u)) >> 16; }
__device__ __forceinline__ unsigned pk2(float lo, float hi) { return f2bf(lo) | (f2bf(hi) << 16); }
__device__ __forceinline__ int dst_row(int mode, int n) {
    if (mode == 1) {
        if (n < 1024) { const int base = n & ~511, nn = n & 511, h = nn >> 6, d = nn & 63; return base + (h >> 2) * 256 + (d >> 5) * 128 + (h & 3) * 32 + (d & 31); }
        if (n < 1536) return n;
        if (n < 1544) return 5120 + (n - 1536);
        return n - 8; }
    if (mode == 2) { const int hb = n >> 8, nn = n & 255; return (nn >> 7) * 256 + hb * 128 + (nn & 127); }
    return n; }
__device__ __forceinline__ void tr_item(const float* W, int K, int N, bf16* WT, int ldt, int mode, const float* ksc, LAS float* scr, int item, int lane) {
    const int nblk = (N + 31) / 32, kb = item / nblk, nb = item % nblk, k0 = 64 * kb, n0 = 32 * nb; const int nn = n0 + (lane & 31); const bool ok = nn < N;
#pragma unroll 8
    for (int i = 0; i < 32; ++i) { const int kk = 2 * i + (lane >> 5); float w = ok ? W[(size_t)(k0 + kk) * N + nn] : 0.f; if (ksc) w *= ksc[k0 + kk]; scr[kk * 33 + (lane & 31)] = w; }
    LDS_WAIT(); asm volatile("" ::: "memory");
    const int c = lane & 7;
#pragma unroll
    for (int j = 0; j < 4; ++j) { const int n = (lane >> 3) + 8 * j; const LAS float* s = scr + (8 * c) * 33 + n;
        u32x4 o; o.x = pk2(s[0 * 33], s[1 * 33]); o.y = pk2(s[2 * 33], s[3 * 33]); o.z = pk2(s[4 * 33], s[5 * 33]); o.w = pk2(s[6 * 33], s[7 * 33]);
        if (n0 + n < N) *(u32x4*)(WT + (size_t)dst_row(mode, n0 + n) * ldt + k0 + 8 * c) = o; }
    LDS_WAIT(); asm volatile("" ::: "memory");
}
__device__ __forceinline__ void sincos_d(double x, double& s, double& c) {
    const double q = rint(x * 0.6366197723675814); const int n = (int)q;
    double r = fma(-q, 1.5707963267948966, x); r = fma(-q, 6.123233995736766e-17, r);
    const double r2 = r * r;
    const double sp = r * (1.0 + r2 * (-1.0 / 6 + r2 * (1.0 / 120 + r2 * (-1.0 / 5040 + r2 * (1.0 / 362880 + r2 * (-1.0 / 39916800 + r2 * (1.0 / 6227020800.0)))))));
    const double cp = 1.0 + r2 * (-0.5 + r2 * (1.0 / 24 + r2 * (-1.0 / 720 + r2 * (1.0 / 40320 + r2 * (-1.0 / 3628800 + r2 * (1.0 / 479001600 + r2 * (-1.0 / 87178291200.0)))))));
    const int k = n & 3; s = (k == 0) ? sp : (k == 1) ? cp : (k == 2) ? -sp : -cp; c = (k == 0) ? cp : (k == 1) ? -sp : (k == 2) ? -cp : sp; }
__device__ __forceinline__ double exp_small_d(double x) {
    double r = 1.0 / 479001600; r = r * x + 1.0 / 39916800; r = r * x + 1.0 / 3628800; r = r * x + 1.0 / 362880; r = r * x + 1.0 / 40320; r = r * x + 1.0 / 5040; r = r * x + 1.0 / 720;
    r = r * x + 1.0 / 120; r = r * x + 1.0 / 24; r = r * x + 1.0 / 6; r = r * x + 0.5; r = r * x + 1.0; r = r * x + 1.0; return r; }

__device__ __forceinline__ void ssm_gen(const Params& P, int l, int g, LAS unsigned char* lds, int tid) {
    LAS float* Ap = (LAS float*)lds;
    LAS float* Bb = Ap + 33 * 128;
    LAS float* Cc = Bb + 2048;
    LAS float* Kl = Cc + 2048;
    LAS float* Cf = Kl + 8192;
    const float* are = P.in[I_ARE] + (size_t)l * 1024 + g * 64; const float* aim = P.in[I_AIM] + (size_t)l * 1024 + g * 64;
    const float* bre = P.in[I_BRE] + (size_t)l * 16384 + g * 1024; const float* bim = P.in[I_BIM] + (size_t)l * 16384 + g * 1024;
    const float* cre = P.in[I_CRE] + (size_t)l * 16384 + g * 1024; const float* cim = P.in[I_CIM] + (size_t)l * 16384 + g * 1024;
    bf16* Tz = (bf16*)(P.ws + l * WL_STRIDE + WL_TZ) + (size_t)g * 512 * UP; bf16* Me = (bf16*)(P.ws + l * WL_STRIDE + WL_MEND) + (size_t)g * 256 * 512;
    float* DL = (float*)(P.ws + l * WL_STRIDE + WL_DL) + g * 128;
    if (tid < 64) { const int n = tid; const double dt = (double)expf(P.in[I_LDT][l * 16 + g]); const double ar = (double)are[n], ai = (double)aim[n];
        const double mag = exp_small_d(ar * dt); double sn, cs; sincos_d(ai * dt, sn, cs); const double abr = mag * cs, abi = mag * sn, den = ar * ar + ai * ai, nr = abr - 1.0, ni = abi;
        Cf[2 * n] = (float)((nr * ar + ni * ai) / den); Cf[2 * n + 1] = (float)((ni * ar - nr * ai) / den);
        double pr = 1.0, pi = 0.0;
        for (int k = 0; k <= 32; ++k) { Ap[(k * 64 + n) * 2] = (float)pr; Ap[(k * 64 + n) * 2 + 1] = (float)pi; const double t = pr * abr - pi * abi; pi = pr * abi + pi * abr; pr = t; }
        DL[2 * n] = Ap[(32 * 64 + n) * 2]; DL[2 * n + 1] = Ap[(32 * 64 + n) * 2 + 1]; }
    __syncthreads();
    for (int e = tid; e < 1024; e += 512) { const int n = e >> 4; const float cr = Cf[2 * n], ci = Cf[2 * n + 1], br = bre[e], bi = bim[e];
        Bb[2 * e] = cr * br - ci * bi; Bb[2 * e + 1] = cr * bi + ci * br; Cc[2 * e] = cre[e]; Cc[2 * e + 1] = cim[e]; }
    __syncthreads();
    for (int e = tid; e < 8192; e += 512) { const int lag = e >> 8, co = (e >> 4) & 15, ci = e & 15; float s = 0.f;
        for (int n = 0; n < 64; ++n) { const float cr = Cc[(co * 64 + n) * 2], cI = Cc[(co * 64 + n) * 2 + 1], ar = Ap[(lag * 64 + n) * 2], aI = Ap[(lag * 64 + n) * 2 + 1];
            const float car = cr * ar - cI * aI, cai = cr * aI + cI * ar; s += car * Bb[(n * 16 + ci) * 2] - cai * Bb[(n * 16 + ci) * 2 + 1]; }
        Kl[e] = s; }
    __syncthreads();
    for (int ch = tid; ch < 512 * 80; ch += 512) { const int row = ch / 80, cq = ch % 80, t = row >> 4, co = row & 15; float v[8];
        if (cq < 64) { const int j = cq >> 1, ci0 = (cq & 1) * 8;
#pragma unroll
            for (int i = 0; i < 8; ++i) v[i] = (j <= t) ? Kl[(t - j) * 256 + co * 16 + ci0 + i] : 0.f;
        } else { const int n0 = (cq - 64) * 8;
#pragma unroll
            for (int i = 0; i < 8; ++i) { const int nn = n0 + i, n = nn & 63; const float cr = Cc[(co * 64 + n) * 2], cI = Cc[(co * 64 + n) * 2 + 1], ar = Ap[((t + 1) * 64 + n) * 2], aI = Ap[((t + 1) * 64 + n) * 2 + 1];
                v[i] = (nn < 64) ? (cr * ar - cI * aI) : -(cr * aI + cI * ar); } }
        u32x4 o; o.x = pk2(v[0], v[1]); o.y = pk2(v[2], v[3]); o.z = pk2(v[4], v[5]); o.w = pk2(v[6], v[7]); *(u32x4*)(Tz + (size_t)row * UP + cq * 8) = o; }
    for (int ch = tid; ch < 256 * 64; ch += 512) { const int row = ch >> 6, cq = ch & 63, j = cq >> 1, ci0 = (cq & 1) * 8; float v[8];
#pragma unroll
        for (int i = 0; i < 8; ++i) { const int n = row & 63; const float ar = Ap[((31 - j) * 64 + n) * 2], aI = Ap[((31 - j) * 64 + n) * 2 + 1], br = Bb[(n * 16 + ci0 + i) * 2], bI = Bb[(n * 16 + ci0 + i) * 2 + 1];
            v[i] = (row < 64) ? (ar * br - aI * bI) : (row < 128) ? (ar * bI + aI * br) : 0.f; }
        u32x4 o; o.x = pk2(v[0], v[1]); o.y = pk2(v[2], v[3]); o.z = pk2(v[4], v[5]); o.w = pk2(v[6], v[7]); *(u32x4*)(Me + (size_t)row * 512 + cq * 8) = o; }
    __syncthreads();
}
__device__ __forceinline__ void wp_item(const Params& P, int l, int item, int lane) {
    const int kc = item >> 4, nb = item & 15, k0 = kc * 8, g = k0 >> 6, c0 = k0 & 63, n = nb * 64 + lane;
    const float* pw = P.in[I_PW] + (size_t)l * 16384 + g * 4096 + c0 * 64; const float* ps = P.in[I_PS] + l * 256 + g * 64; const float* wb = P.in[I_WBP] + (size_t)l * 262144 + (size_t)(g * 64) * 1024 + n;
    float a[8] = {0, 0, 0, 0, 0, 0, 0, 0};
    for (int d = 0; d < 64; ++d) { const float w = wb[(size_t)d * 1024] * ps[d];
#pragma unroll
        for (int i = 0; i < 8; ++i) a[i] += pw[i * 64 + d] * w; }
    u32x4 o; o.x = pk2(a[0], a[1]); o.y = pk2(a[2], a[3]); o.z = pk2(a[4], a[5]); o.w = pk2(a[6], a[7]);
    *(u32x4*)((bf16*)(P.ws + l * WL_STRIDE + WL_WA) + (size_t)n * 1024 + 768 + k0) = o;
}
__device__ __forceinline__ void prologue(const Params& P, LAS unsigned char* lds, int tid, int lane, int wave, int bx, int G) {
    for (int it = bx; it < NLAYER * 16; it += G) ssm_gen(P, it >> 4, it & 15, lds, tid);
    __syncthreads();
    LAS float* scr = (LAS float*)(lds + wave * 16384);
    const int gw = bx * 8 + wave, NGW = G * 8;
    constexpr int I_IN = 16 * 161, I_A = 8 * 32, I_S = 4 * 32, I_O = 16 * 32, I_U = 16 * 128, I_D = 64 * 32, I_G = 4 * 16, I_P = 512, I_Z = 31, PER = I_IN + I_A + I_S + I_O + I_U + I_D + I_G + I_P + I_Z;
    const int nssm = (G > 2 * NLAYER * 16) ? NLAYER * 16 : 0;
    for (int it = (bx - nssm) * 8 + wave; bx >= nssm && it < NLAYER * PER; it += (G - nssm) * 8) { const int l = it / PER; int r = it % PER; unsigned char* wl = P.ws + l * WL_STRIDE;
        if (r < I_IN) { tr_item(P.in[I_WIN] + (size_t)l * D * INC, D, INC, (bf16*)(wl + WL_WIN), D, 1, P.in[I_MIXN] + l * D, scr, r, lane); continue; } r -= I_IN;
        if (r < I_A) { tr_item(P.in[I_WBA] + (size_t)l * 512 * D, 512, D, (bf16*)(wl + WL_WA), 1024, 0, nullptr, scr, r, lane); continue; } r -= I_A;
        if (r < I_S) { tr_item(P.in[I_WBS] + (size_t)l * 256 * D, 256, D, (bf16*)(wl + WL_WA) + 512, 1024, 0, nullptr, scr, r, lane); continue; } r -= I_S;
        if (r < I_O) { tr_item(P.in[I_WOUT] + (size_t)l * D * D, D, D, (bf16*)(wl + WL_WOUT), D, 0, nullptr, scr, r, lane); continue; } r -= I_O;
        if (r < I_U) { tr_item(P.in[I_WUP] + (size_t)l * D * FF, D, FF, (bf16*)(wl + WL_WUP), D, 0, P.in[I_MLPN] + l * D, scr, r, lane); continue; } r -= I_U;
        if (r < I_D) { tr_item(P.in[I_WDN] + (size_t)l * FF * D, FF, D, (bf16*)(wl + WL_WDN), FF, 0, nullptr, scr, r, lane); continue; } r -= I_D;
        if (r < I_G) { tr_item(P.in[I_WGLU] + (size_t)l * 256 * 512, 256, 512, (bf16*)(wl + WL_WGLU), 256, 2, nullptr, scr, r, lane); continue; } r -= I_G;
        if (r < I_P) { wp_item(P, l, r, lane); continue; } r -= I_P;
        { u32x4* z = (u32x4*)((bf16*)(wl + WL_WIN) + (size_t)(5128 + 8 * r) * D) + lane; const u32x4 zero = {0u, 0u, 0u, 0u};
#pragma unroll
          for (int i = 0; i < 16; ++i) z[64 * i] = zero; }
    }
    const float* x = P.in[I_X]; bf16* xb = (bf16*)(P.ws + WS_XB); float* ssq = (float*)(P.ws + WS_SSQ);
    for (int m0 = gw * 4; m0 < T; m0 += NGW * 4) {
        f32x4 v[4][4]; float sq[4];
#pragma unroll
        for (int r = 0; r < 4; ++r) { const f32x4* xr = (const f32x4*)(x + (size_t)(m0 + r) * D) + lane;
#pragma unroll
            for (int j = 0; j < 4; ++j) v[r][j] = xr[64 * j]; }
#pragma unroll
        for (int r = 0; r < 4; ++r) { float s = 0.f;
#pragma unroll
            for (int j = 0; j < 4; ++j) s += dot4(v[r][j]);
            sq[r] = wave_sum(s); }
#pragma unroll
        for (int r = 0; r < 4; ++r) { u32x2* o = (u32x2*)(xb + (size_t)(m0 + r) * D) + lane;
#pragma unroll
            for (int j = 0; j < 4; ++j) { u32x2 w; w.x = cvt_pk_bf16(v[r][j][0], v[r][j][1]); w.y = cvt_pk_bf16(v[r][j][2], v[r][j][3]); o[64 * j] = w; }
            if (lane < 16) ssq[(size_t)(m0 + r) * 16 + lane] = (lane == 0) ? sq[r] : 0.f; } }
}
__device__ __forceinline__ void fcum_seq(const float* flog, float* kb, int sq, LAS unsigned char* lds, int tid, int lane, int wave) {
    const int b = sq >> 3, h = sq & 7; LAS float* wt = (LAS float*)lds;
    float v[8]; float run = 0.f;
#pragma unroll
    for (int i = 0; i < 8; ++i) { run += flog[((size_t)b * SEQ + tid * 8 + i) * 8 + h]; v[i] = run; }
    float inc = run;
#pragma unroll
    for (int o = 1; o < 64; o <<= 1) { const float t = __shfl_up(inc, o); if (lane >= o) inc += t; }
    if (lane == 63) wt[wave] = inc;
    __syncthreads();
    float off = inc - run;
    for (int w = 0; w < wave; ++w) off += wt[w];
#pragma unroll
    for (int i = 0; i < 8; ++i) kb[(size_t)sq * SEQ + tid * 8 + i] = -LOG2E * (off + v[i]);
    __syncthreads();
}
template <int W> __device__ __forceinline__ void pool_item(const bf16* up, bf16* acat, int tok, int ch0) {
    const int s = tok & (SEQ - 1); f32x4 sa = {0.f, 0.f, 0.f, 0.f}, sb = sa, ca = sa, cb = sa; u32x4 r[W];
#pragma unroll
    for (int j = 0; j < W; ++j) r[j] = (j <= s) ? *(const u32x4*)(up + (size_t)(tok - ((j <= s) ? j : 0)) * 256 + ch0) : (u32x4){0u, 0u, 0u, 0u};
#pragma unroll
    for (int j = 0; j < W; ++j) { f32x4 a, b; unpack8(r[j], a, b); if (j == 0) { ca = a; cb = b; } sa += a; sb += b; }
    const float inv = 1.0f / (float)((s + 1 < W) ? s + 1 : W);
    *(u32x4*)(acat + (size_t)tok * 1024 + 768 + ch0) = pack8(sa * inv - ca, sb * inv - cb);
}
__device__ __forceinline__ void pool_pass(const bf16* up, bf16* acat, int gwave, int nwaves, int lane) {
    for (int wi = gwave; wi < (T / 8) * 4; wi += nwaves) { const int g = wi & 3, tok = (wi >> 2) * 8 + (lane >> 3), ch0 = g * 64 + (lane & 7) * 8;
        if (g == 0) pool_item<2>(up, acat, tok, ch0); else if (g == 1) pool_item<4>(up, acat, tok, ch0); else if (g == 2) pool_item<8>(up, acat, tok, ch0); else pool_item<16>(up, acat, tok, ch0); }
}
__device__ __forceinline__ void state_scan(const float* S, const float* DL, bf16* U, int gid) {
    const int g = gid >> 10, b = (gid >> 6) & 15, n = gid & 63; const float dr = DL[g * 128 + 2 * n], di = DL[g * 128 + 2 * n + 1];
    float xr = 0.f, xi = 0.f; const size_t r0 = (size_t)g * 2048 + b * 128;
#pragma unroll 8
    for (int c = 0; c < 128; ++c) { const float sr = S[(r0 + c) * 128 + n], si = S[(r0 + c) * 128 + 64 + n];
        U[(r0 + c) * UP + 512 + n] = (bf16)f2bf(xr); U[(r0 + c) * UP + 576 + n] = (bf16)f2bf(xi);
        const float t = dr * xr - di * xi + sr; xi = dr * xi + di * xr + si; xr = t; }
}

#define XB_TMO      128
#define XB_XCNT(j)  (256  + 64 * (j))
#define XB_XSUB(j)  (1280 + 64 * (j))
#define XB_XGEN(j)  (2304 + 64 * (j))
#define XB_TOP      3328
#define XB_TOPGEN   3392
#define XCD_BAR_WORDS 3456
#define XB_SPIN_CAP (1u << 18)

__device__ __forceinline__ unsigned xb_ld(unsigned* p)              { return __hip_atomic_load(p, __ATOMIC_RELAXED, __HIP_MEMORY_SCOPE_AGENT); }
__device__ __forceinline__ unsigned xb_add(unsigned* p, unsigned v) { return __hip_atomic_fetch_add(p, v, __ATOMIC_RELAXED, __HIP_MEMORY_SCOPE_AGENT); }
__device__ __forceinline__ unsigned xb_xcc_id() { return (unsigned)__builtin_amdgcn_s_getreg((3 << 11) | 20) & 0xFu; }
#define XB_SPIN(cond, bar) do { unsigned _sp = 0; while (cond) { __builtin_amdgcn_s_sleep(1); \
    if ((++_sp & 255u) == 0u) { if (xb_ld(&(bar)[XB_TMO])) break; if (_sp > XB_SPIN_CAP) { atomicAdd(&(bar)[XB_TMO], 1u); break; } } } } while (0)

struct XcdBarrier {
    unsigned* bar; unsigned x;
    volatile LAS unsigned* st;
};

__device__ __forceinline__ XcdBarrier xcd_barrier_post(unsigned* bar, volatile LAS unsigned* st) {
    XcdBarrier b; b.bar = bar; b.x = xb_xcc_id(); b.st = st;
    if (threadIdx.x == 0) (void)xb_add(&bar[XB_XCNT(b.x)], 1u);
    return b;
}
__device__ __forceinline__ void xcd_barrier_complete(unsigned* bar, unsigned x, unsigned& nloc, unsigned& nx) {
    const unsigned G = gridDim.x * gridDim.y * gridDim.z;
    unsigned sum, cnt, mine, sp = 0u;
    for (;;) {
        sum = 0u; cnt = 0u; mine = 0u;
#pragma unroll
        for (unsigned j = 0; j < 16; ++j) { const unsigned c = xb_ld(&bar[XB_XCNT(j)]); sum += c; cnt += (c > 0u) ? 1u : 0u; mine = (j == x) ? c : mine; }
        if (sum == G) break;
        __builtin_amdgcn_s_sleep(1);
        if ((++sp & 255u) == 0u) { if (xb_ld(&bar[XB_TMO])) break; if (sp > XB_SPIN_CAP) { atomicAdd(&bar[XB_TMO], 1u); break; } }
    }
    nloc = mine > 0u ? mine : 1u; nx = cnt > 0u ? cnt : 1u;
}

__device__ __forceinline__ void xcd_barrier(const XcdBarrier& b) {
    asm volatile("s_waitcnt vmcnt(0)" ::: "memory");
    __syncthreads();
    if (threadIdx.x == 0) {
        unsigned* bar = b.bar;
        __builtin_amdgcn_s_waitcnt(0);
        unsigned nloc = b.st[0], nx = b.st[1];
        if (nloc == 0u) { xcd_barrier_complete(bar, b.x, nloc, nx); b.st[0] = nloc; b.st[1] = nx; }
        const unsigned old = xb_add(&bar[XB_XSUB(b.x)], 1u);
        const unsigned gen = old / nloc;
        if (old + 1u == (gen + 1u) * nloc) {
            __builtin_amdgcn_fence(__ATOMIC_RELEASE, "agent");
            asm volatile("s_waitcnt vmcnt(0)" ::: "memory");
            const unsigned og = xb_add(&bar[XB_TOP], 1u);
            const unsigned tg = og / nx;
            if (og + 1u == (tg + 1u) * nx) xb_add(&bar[XB_TOPGEN], 1u);
            else XB_SPIN(xb_ld(&bar[XB_TOPGEN]) == tg, bar);
            __builtin_amdgcn_fence(__ATOMIC_ACQUIRE, "agent");
            xb_add(&bar[XB_XGEN(b.x)], 1u);
            asm volatile("s_waitcnt vmcnt(0)" ::: "memory");
        } else {
            XB_SPIN(xb_ld(&bar[XB_XGEN(b.x)]) == gen, bar);
            __builtin_amdgcn_fence(__ATOMIC_ACQUIRE, "agent");
            asm volatile("s_waitcnt vmcnt(0)" ::: "memory");
        }
    }
    __syncthreads();
}

constexpr size_t WS_BAR = 1000 * MiB;
#define GB_CNT(g) (4096 + 64 * (g))
__device__ __forceinline__ void group_barrier(unsigned* bar, volatile LAS unsigned* st, unsigned grp, unsigned nloc) {
    asm volatile("s_waitcnt vmcnt(0)" ::: "memory");
    __syncthreads();
    if (threadIdx.x == 0) {
        const unsigned k = st[2] + 1u; st[2] = k;
        __builtin_amdgcn_fence(__ATOMIC_RELEASE, "agent");
        asm volatile("s_waitcnt vmcnt(0)" ::: "memory");
        (void)xb_add(&bar[GB_CNT(grp)], 1u);
        const unsigned target = k * nloc;
        XB_SPIN(xb_ld(&bar[GB_CNT(grp)]) < target, bar);
        __builtin_amdgcn_fence(__ATOMIC_ACQUIRE, "agent");
        asm volatile("s_waitcnt vmcnt(0)" ::: "memory");
    }
    __syncthreads();
}
constexpr int LDS_BARST = 131072 + 1024;
#ifndef PHM
#define PHM 0x3ff
#endif
#ifndef PROBE
#define PROBE 0
#endif
typedef const __attribute__((address_space(4))) Params* KArgP;
__global__ void __launch_bounds__(512, 2) fwd_kernel(Params P) {
    extern __shared__ __attribute__((aligned(16))) unsigned char lds_raw[];
    cg::grid_group grid = cg::this_grid();
    LAS unsigned char* lds = (LAS unsigned char*)lds_raw;
    const int ph_lo = P.ph_lo, ph_hi = P.ph_hi;
    if (threadIdx.x < 4) ((volatile LAS unsigned*)(lds + LDS_BARST))[threadIdx.x] = 0u;
    __syncthreads();
#define PH_BEGIN() int tid = threadIdx.x; asm volatile("" : "+v"(tid)); const int lane = tid & 63, wave = __builtin_amdgcn_readfirstlane(tid >> 6); (void)lane; (void)wave; \
    KArgP pk = (KArgP)__builtin_amdgcn_kernarg_segment_ptr(); asm volatile("" : "+s"(pk)); unsigned char* const ws = pk->ws; unsigned char* const wl = ws + l * WL_STRIDE; (void)wl; \
    const int G = gridDim.x, bx = blockIdx.x; (void)G; (void)bx
#define RUN(k) (ph_lo <= (k) && (k) < ph_hi)
#define EN(j) ((PHM >> (j)) & 1)
#ifndef REP
#define REP 0
#endif
#define REPL(j) _Pragma("unroll 1") for (int rep_ = (((REP) >> (j)) & 1) ? 0 : 1; rep_ < 2; ++rep_)
#define STAMP(i) do { if (PROBE && blockIdx.x == 0 && threadIdx.x == 0) { KArgP pq = (KArgP)__builtin_amdgcn_kernarg_segment_ptr(); asm volatile("" : "+s"(pq)); ((unsigned long long*)(pq->ws + WS_DBG))[i] = __builtin_amdgcn_s_memrealtime(); } } while (0)
#define SEAM(k) do { if (RUN(k) && RUN((k) + 1)) { if ((k) == 0) { grid.sync(); KArgP pb = (KArgP)__builtin_amdgcn_kernarg_segment_ptr(); asm volatile("" : "+s"(pb)); (void)xcd_barrier_post((unsigned*)(pb->ws + WS_BAR), (volatile LAS unsigned*)(lds + LDS_BARST)); } \
        else { KArgP pb = (KArgP)__builtin_amdgcn_kernarg_segment_ptr(); asm volatile("" : "+s"(pb)); XcdBarrier xb_; xb_.bar = (unsigned*)(pb->ws + WS_BAR); xb_.x = xb_xcc_id(); xb_.st = (volatile LAS unsigned*)(lds + LDS_BARST); xcd_barrier(xb_); } } STAMP((k) + 1); } while (0)
#define WSP(T_, off) ((T_*)(ws + (off)))
#ifndef LOCAL_SEAMS
#define LOCAL_SEAMS 0
#endif
#define SEAM_L(k) do { if (LOCAL_SEAMS && (gridDim.x % 8u) == 0u) { if (RUN(k) && RUN((k) + 1)) { KArgP pb = (KArgP)__builtin_amdgcn_kernarg_segment_ptr(); asm volatile("" : "+s"(pb)); \
        group_barrier((unsigned*)(pb->ws + WS_BAR), (volatile LAS unsigned*)(lds + LDS_BARST), blockIdx.x % 8u, gridDim.x / 8u); } STAMP((k) + 1); } else SEAM(k); } while (0)
    STAMP(0);
#ifdef EXTRA_SYNC
    if (ph_hi - ph_lo > 1) { _Pragma("unroll 1") for (int i_ = 0; i_ < EXTRA_SYNC; ++i_) grid.sync(); }
#endif
    if (RUN(0) && EN(0)) { const int l = 0; PH_BEGIN(); if (bx == 0) { for (int i = tid; i < 8192 + 256; i += 512) ((unsigned*)(ws + WS_BAR))[i] = 0u;   } const Params& Pc = *(const Params*)pk; prologue(Pc, lds, tid, lane, wave, bx, G); }
    SEAM(0);
#pragma unroll 1
    for (int l = 0; l < NLAYER; ++l) {
        const int p0 = 1 + 9 * l;
        if (RUN(p0) && EN(1)) REPL(1) {
            PH_BEGIN();
            pg8::Gemm g{WSP(bf16, WS_XB), (const bf16*)(wl + WL_WIN), T, 5120, D, D, D}; pg8::StaticOrder S; S.init(T, 5120, G, bx);
            EpiIn E{WSP(bf16, WS_Q), WSP(bf16, WS_K), WSP(bf16, WS_V), WSP(bf16, WS_U), WSP(bf16, WS_UPOOL), WSP(bf16, WS_GATES), WSP(float, WS_FLOG), WSP(float, WS_SSQ),
                    pk->in[I_QN] + l * 64, pk->in[I_KN] + l * 64, pk->in[I_BG] + l * 3072, pk->in[I_BF] + l * 8};
            pg8::gemm_phase<EpiIn, pg8::StaticOrder, true, true>(lds, g, S, E);
            for (int pm = bx; pm < T / 256; pm += G) flog_panel(WSP(bf16, WS_XB), (const bf16*)(wl + WL_WIN) + (size_t)5120 * D, WSP(float, WS_SSQ), pk->in[I_BF] + l * 8, WSP(float, WS_FLOG), pm, wave, lane); }
        SEAM(p0);
        if (RUN(p0 + 1) && EN(2)) REPL(2) {
            PH_BEGIN();
            for (int sq = bx; sq < NB * 8; sq += G) fcum_seq(WSP(float, WS_FLOG), WSP(float, WS_KB), sq, lds, tid, lane, wave);
            pool_pass(WSP(bf16, WS_UPOOL), WSP(bf16, WS_ACAT), bx * 8 + wave, G * 8, lane);
            __syncthreads();
            pg8::Gemm g{WSP(bf16, WS_U), (const bf16*)(wl + WL_MEND), 16 * 2048, 16 * 256, 512, UP, 512}; BatchOrder S{16, 8, 1, G, bx};
            EpiSend E{WSP(float, WS_S)};
            pg8::gemm_phase<EpiSend, BatchOrder, true, true>(lds, g, S, E); }
        SEAM(p0 + 1);
        if (RUN(p0 + 2) && EN(3)) {
            { PH_BEGIN();
              for (int gid = bx * 512 + tid; gid < 16384; gid += G * 512) state_scan(WSP(float, WS_S), (const float*)(wl + WL_DL), WSP(bf16, WS_U), gid);
              __syncthreads(); }
            { PH_BEGIN();
              float sb; { const float qa = fabsf(pk->in[I_QN][l * 64 + lane]), ka = fabsf(pk->in[I_KN][l * 64 + lane]); float qm = qa, km = ka;
#pragma unroll
                  for (int o = 1; o < 64; o <<= 1) { qm = fmaxf(qm, __shfl_xor(qm, o)); km = fmaxf(km, __shfl_xor(km, o)); }
                  sb = __uint_as_float(__builtin_amdgcn_readfirstlane(__float_as_uint(64.0f * C2Q * qm * km * 1.02f + 1.0f))); }
              const attn_body::AttnTensors AT{WSP(const attn_body::bf16, WS_Q), WSP(const attn_body::bf16, WS_K), WSP(const attn_body::bf16, WS_V), WSP(attn_body::bf16, WS_ACAT), WSP(const float, WS_KB)};
              attn_body::attn_phase<8>((char*)lds_raw, AT, sb, (unsigned*)(ws + WS_BAR) + 8192 + 64 * l, bx, G); } }
        SEAM(p0 + 2);
        if (RUN(p0 + 3) && EN(4)) REPL(4) {
            PH_BEGIN();
            pg8::Gemm g{WSP(bf16, WS_U), (const bf16*)(wl + WL_TZ), 16 * 2048, 16 * 512, UP, UP, UP}; BatchOrder S{16, 8, 2, G, bx};
            EpiSsmY E{WSP(bf16, WS_U), pk->in[I_SD] + l * 256, WSP(bf16, WS_YPRE)};
            pg8::gemm_phase<EpiSsmY, BatchOrder, true, true>(lds, g, S, E); }
        SEAM(p0 + 3);
        if (RUN(p0 + 4) && EN(5)) REPL(5) {
            PH_BEGIN();
            pg8::Gemm g{WSP(bf16, WS_YPRE), (const bf16*)(wl + WL_WGLU), T, 512, 256, 256, 256}; pg8::StaticOrder S; S.init(T, 512, G, bx);
            EpiGlu E{WSP(bf16, WS_ACAT)};
            pg8::gemm_phase<EpiGlu, pg8::StaticOrder, true, true>(lds, g, S, E); }
        SEAM_L(p0 + 4);
        if (RUN(p0 + 5) && EN(6)) REPL(6) {
            PH_BEGIN(); TriOrder S; S.S.init(T, D, G, bx);
            pg8::Gemm g{WSP(bf16, WS_ACAT), (const bf16*)(wl + WL_WA), T, D, 512, 1024, 1024}; EpiGate3 E{WSP(bf16, WS_GATES), WSP(bf16, WS_MERGED)};
            pg8::gemm_phase<EpiGate3, TriOrder, true, true>(lds, g, S, E); }
        SEAM_L(p0 + 5);
        if (RUN(p0 + 6) && EN(7)) REPL(7) {
            PH_BEGIN();
            pg8::Gemm g{WSP(bf16, WS_MERGED), (const bf16*)(wl + WL_WOUT), T, D, D, D, D}; pg8::StaticOrder S; S.init(T, D, G, bx);
            EpiRes<0> E{(l == 0) ? pk->in[I_X] : (const float*)pk->out, nullptr, WSP(bf16, WS_XB), WSP(float, WS_SSQ), true};
            pg8::gemm_phase<EpiRes<0>, pg8::StaticOrder, true, true>(lds, g, S, E); }
        SEAM_L(p0 + 6);
        if (RUN(p0 + 7) && EN(8)) REPL(8) {
            PH_BEGIN();
            pg8::Gemm g{WSP(bf16, WS_XB), (const bf16*)(wl + WL_WUP), T, FF, D, D, D}; pg8::StaticOrder S; S.init(T, FF, G, bx);
            EpiUp E{WSP(bf16, WS_ACT), WSP(float, WS_SSQ)};
            pg8::gemm_phase<EpiUp, pg8::StaticOrder, true, true>(lds, g, S, E); }
        SEAM_L(p0 + 7);
        if (RUN(p0 + 8) && EN(9)) REPL(9) {
            PH_BEGIN();
            pg8::Gemm g{WSP(bf16, WS_ACT), (const bf16*)(wl + WL_WDN), T, D, FF, FF, FF}; pg8::StaticOrder S; S.init(T, D, G, bx);
            EpiRes<1> E{nullptr, pk->out, WSP(bf16, WS_XB), WSP(float, WS_SSQ), l + 1 < NLAYER};
            pg8::gemm_phase<EpiRes<1>, pg8::StaticOrder, true, true>(lds, g, S, E); }
        SEAM(p0 + 8);
    }
#if PROBE
    grid.sync(); STAMP(N_PHASES_);
    if (blockIdx.x == 0) { KArgP pq = (KArgP)__builtin_amdgcn_kernarg_segment_ptr(); const unsigned long long* ts = (const unsigned long long*)(pq->ws + WS_DBG); float* out = pq->out;
        if (threadIdx.x == 0) out[0] = (float)(ts[PROBE_A1] - ts[PROBE_A0]) * 0.0025f; }
#endif
#undef RUN
#undef SEAM
}
constexpr int N_PHASES = 1 + 9 * NLAYER;

#ifndef MK_PER_PHASE
#define MK_PER_PHASE 0
#endif
extern "C" void kernel_launch(void* const* d_in, const int* in_sizes, int n_in, void* d_out, int out_size, void* d_ws, size_t ws_size, hipStream_t stream) {
    static int grid = 0;
    if (grid == 0) {
        if (n_in != N_IN || in_sizes[0] != T * D || out_size != T * D || ws_size < WS_END) { fprintf(stderr, "kernel_launch: unexpected shapes (n_in %d, in0 %d, out %d, ws %zu)\n", n_in, n_in > 0 ? in_sizes[0] : -1, out_size, ws_size); grid = -1; return; }
        int dev = 0, cus = 0, per_cu = 0;
        if (hipGetDevice(&dev) != hipSuccess || hipDeviceGetAttribute(&cus, hipDeviceAttributeMultiprocessorCount, dev) != hipSuccess) { grid = -1; return; }
        if (hipFuncSetAttribute((const void*)fwd_kernel, hipFuncAttributeMaxDynamicSharedMemorySize, LDS_BYTES) != hipSuccess) { fprintf(stderr, "kernel_launch: hipFuncSetAttribute failed\n"); grid = -1; return; }
        if (hipOccupancyMaxActiveBlocksPerMultiprocessor(&per_cu, (const void*)fwd_kernel, 512, LDS_BYTES) != hipSuccess || per_cu < 1) { fprintf(stderr, "kernel_launch: occupancy query says %d\n", per_cu); per_cu = 1; }
        (void)hipGetLastError();
        grid = cus;
    }
    if (grid < 0) return;
    Params p{};
    for (int i = 0; i < N_IN; ++i) p.in[i] = (const float*)d_in[i];
    p.out = (float*)d_out; p.ws = (unsigned char*)d_ws; p.dbg = 0; p.pad = 0;
#if MK_PER_PHASE
    for (int k = 0; k < N_PHASES; ++k) { p.ph_lo = k; p.ph_hi = k + 1; hipLaunchKernelGGL(fwd_kernel, dim3(grid), dim3(512), LDS_BYTES, stream, p); }
#else
    p.ph_lo = 0; p.ph_hi = N_PHASES;
    void* args[] = {&p};
    const hipError_t e = hipLaunchCooperativeKernel((const void*)fwd_kernel, dim3(grid), dim3(512), args, LDS_BYTES, stream);
    if (e != hipSuccess) fprintf(stderr, "kernel_launch: cooperative launch failed: %s (grid %d)\n", hipGetErrorString(e), grid);
#endif
}
```

```cpp
#include <hip/hip_runtime.h>
#include <hip/hip_cooperative_groups.h>
#include <cstdio>
#include <cstdint>
namespace pg8 {
#define PG8_LAS __attribute__((address_space(3)))
typedef unsigned short bf16_t;
typedef short bf16x8 __attribute__((ext_vector_type(8)));
typedef float f32x4 __attribute__((ext_vector_type(4)));
typedef unsigned u32x4 __attribute__((ext_vector_type(4)));
constexpr int BM = 256, BK = 64, HALF = 128, HTB = HALF * BK * 2  , STAGE_BYTES = 8 * HTB, NXCD = 8, WGM = 8;

__host__ __device__ __forceinline__ int lds_byte(int r, int c) { const int st = (r >> 4) * 2 + (c >> 5), rr = r & 15, cc = c & 31, ob = rr * 64 + cc * 2; return st * 1024 + (ob ^ (((ob >> 9) & 1) << 5)); }
__host__ __device__ __forceinline__ void stage_rc(int b, int& R, int& C) { const int st = b / 1024, sb = b % 1024, swz = sb ^ (((sb >> 9) & 1) << 5); R = (st >> 1) * 16 + swz / 64; C = (st & 1) * 32 + (swz % 64) / 2; }
__host__ __device__ __forceinline__ int perm32(int rho) { const int n = rho >> 4, i = rho & 15; return 8 * (i >> 2) + 4 * n + (i & 3); }

struct Unit { int pm, pn, ko = 0, nt = 0; };
struct Gemm { const bf16_t* A; const bf16_t* Bt; int M, N, K, lda, ldb; };

struct StaticOrder {
    int nM, nN, nwg, G, c;
    __host__ __device__ void init(int M, int N, int G_, int c_) { nM = M / BM; nN = N / BM; nwg = nM * nN; G = G_; c = c_; }
    __host__ __device__ bool next(int i, Unit& u) const {
        const long L = (long)i * G + c; if (L >= nwg) return false;
        int wgid = (int)L; { const int q = nwg / NXCD, r = nwg % NXCD, xcd = wgid % NXCD, off = wgid / NXCD; wgid = (xcd < r ? xcd * (q + 1) : r * (q + 1) + (xcd - r) * q) + off; }
        const int nig = WGM * nN, gid = wgid / nig, fm = gid * WGM, gsz = (nM - fm) < WGM ? (nM - fm) : WGM;
        u.pm = fm + ((wgid % nig) % gsz); u.pn = (wgid % nig) / gsz; return true;
    }
    __device__ __forceinline__ void a_ready(const Unit&) const {}
    __device__ __forceinline__ void done(const Unit&) const {}
};

typedef float f32x2c_t __attribute__((ext_vector_type(2))); typedef __bf16 bf16x2c_t __attribute__((ext_vector_type(2)));
__device__ __forceinline__ unsigned cvt_pk_bf16(float lo, float hi) { const f32x2c_t v = {lo, hi}; const bf16x2c_t b = __builtin_convertvector(v, bf16x2c_t); return __builtin_bit_cast(unsigned, b); }
typedef float f32x2 __attribute__((ext_vector_type(2)));
__device__ __forceinline__ f32x2 gelu_pk(f32x2 v) {
    const f32x2 av = __builtin_elementwise_abs(v), d = av * 0.2316418882f + 1.0f;
    f32x2 t; t.x = __builtin_amdgcn_rcpf(d.x); t.y = __builtin_amdgcn_rcpf(d.y);
    f32x2 q = t * 0.5307027145f + (-0.7265760135f); q = q * t + 0.7107068705f; q = q * t + (-0.142248368f); q = q * t + 0.127414796f; q = q * t;
    const f32x2 s = (v * v) * (-0.72134752044f);
    f32x2 e; e.x = __builtin_amdgcn_exp2f(s.x); e.y = __builtin_amdgcn_exp2f(s.y);
    const f32x2 m = v * (q * e), r = v - m;
    f32x2 o; o.x = v.x < 0.f ? m.x : r.x; o.y = v.y < 0.f ? m.y : r.y; return o;
}

template <int ACT  > struct EpiBf16 {
    static constexpr bool PERM = true, AFTER_DRAIN = false, KEEP = false; static_assert(ACT == 0 || ACT == 1, "EpiBf16: ACT is 0 (none) or 1 (gelu_pk)");
    bf16_t* O; int ldc; const float* bias; int split_cols; size_t split_stride; float scale0;
    __device__ __forceinline__ void operator()(const f32x4 (&acc)[2][2][4][2], const Unit& u, int wr, int wc, int fr, int fq) const {
        const int row0 = u.pm * BM + wr * 64 + fr; int colt = u.pn * BM; bf16_t* base = O;
        float sc = 1.f; if (split_cols) { const int t = colt / split_cols; base += (size_t)t * split_stride; colt -= t * split_cols; if (t == 0) sc = scale0; }
        const int col0 = colt + wc * 32 + 8 * fq, bcol0 = u.pn * BM + wc * 32 + 8 * fq;
        f32x4 bv[2][2];
#pragma unroll
        for (int bj = 0; bj < 2; ++bj)
#pragma unroll
            for (int n = 0; n < 2; ++n) bv[bj][n] = bias ? *(const f32x4*)(bias + bcol0 + bj * HALF + 4 * n) : (f32x4){0.f, 0.f, 0.f, 0.f};
#pragma unroll
        for (int ai = 0; ai < 2; ++ai)
#pragma unroll
            for (int m = 0; m < 4; ++m) { bf16_t* rowp = base + (size_t)(row0 + ai * HALF + m * 16) * ldc + col0;
#pragma unroll
                for (int bj = 0; bj < 2; ++bj) { f32x4 v0 = acc[ai][bj][m][0] + bv[bj][0], v1 = acc[ai][bj][m][1] + bv[bj][1];
                    if (ACT == 1) { f32x2 a = gelu_pk((f32x2){v0[0], v0[1]}), b = gelu_pk((f32x2){v0[2], v0[3]}), c = gelu_pk((f32x2){v1[0], v1[1]}), d = gelu_pk((f32x2){v1[2], v1[3]});
                        v0 = (f32x4){a.x, a.y, b.x, b.y}; v1 = (f32x4){c.x, c.y, d.x, d.y}; }
                    v0 = v0 * sc; v1 = v1 * sc; u32x4 w; w.x = cvt_pk_bf16(v0[0], v0[1]); w.y = cvt_pk_bf16(v0[2], v0[3]); w.z = cvt_pk_bf16(v1[0], v1[1]); w.w = cvt_pk_bf16(v1[2], v1[3]);
                    *(u32x4*)(rowp + bj * HALF) = w; } }
    }
};


template <class Epi, class Sched, bool ALIGN_EPI = false, bool SP2 = false>
__device__ __forceinline__ void gemm_phase(PG8_LAS unsigned char* lds, const Gemm g, const Sched& S, const Epi& E) {
    int tid_l = threadIdx.x; asm volatile("" : "+v"(tid_l));
    const int tid = tid_l, wid = __builtin_amdgcn_readfirstlane(tid >> 6), lane = tid & 63, wr = wid >> 2, wc = wid & 3, fr = lane & 15, fq = lane >> 4;
    const int K = g.K, nt = K / BK;
    unsigned voffA[2], voffB[2];
#pragma unroll
    for (int i = 0; i < 2; ++i) { int R, C; stage_rc(tid * 16 + i * 8192, R, C); const int Rb = Epi::PERM ? ((R & ~31) + perm32(R & 31)) : R;
        voffA[i] = (unsigned)(R * g.lda + C) * 2u; voffB[i] = (unsigned)(Rb * g.ldb + C) * 2u; }
    const size_t kstep = (size_t)(BK * 2);
    const size_t hstepA = (size_t)HALF * g.lda * 2, hstepB = (size_t)HALF * g.ldb * 2;
    const size_t tstepA = 2 * hstepA, tstepB = 2 * hstepB;
    const unsigned ldsw = (unsigned)wid * 1024u;
    const int aoff = lds_byte(wr * 64 + fr, fq * 8), boff = lds_byte(wc * 32 + fr, fq * 8);
#define PG8_SA(b, h) (((b) * 2 + (h)) * HTB)
#define PG8_SB(b, h) ((4 + (b) * 2 + (h)) * HTB)
#define PG8_STAGE(bufoff, gbase, voff) do { _Pragma("unroll") for (int _i = 0; _i < 2; ++_i) \
        __builtin_amdgcn_global_load_lds((const unsigned*)((const char*)(gbase) + (voff)[_i]), (PG8_LAS unsigned*)(lds + (bufoff) + ldsw + _i * 8192), 16, 0, 0); } while (0)
#define PG8_LDA(dst, b, h) do { _Pragma("unroll") for (int m = 0; m < 4; ++m) _Pragma("unroll") for (int k = 0; k < 2; ++k) dst[m][k] = *(const PG8_LAS bf16x8*)(lds + PG8_SA(b, h) + aoff + m * 2048 + k * 1024); } while (0)
#define PG8_LDB(dst, b, h) do { _Pragma("unroll") for (int n = 0; n < 2; ++n) _Pragma("unroll") for (int k = 0; k < 2; ++k) dst[n][k] = *(const PG8_LAS bf16x8*)(lds + PG8_SB(b, h) + boff + n * 2048 + k * 1024); } while (0)
#define PG8_MMA(ai, bj, At, Bt) do { __builtin_amdgcn_s_setprio(1); _Pragma("unroll") for (int m = 0; m < 4; ++m) _Pragma("unroll") for (int n = 0; n < 2; ++n) _Pragma("unroll") for (int k = 0; k < 2; ++k) \
        acc[ai][bj][m][n] = __builtin_amdgcn_mfma_f32_16x16x32_bf16(Bt[n][k], At[m][k], acc[ai][bj][m][n], 0, 0, 0); __builtin_amdgcn_s_setprio(0); } while (0)
#define PG8_WAIT_V(n) asm volatile("s_waitcnt vmcnt(" #n ")" ::: "memory")
#define PG8_WAIT_L(n) asm volatile("s_waitcnt lgkmcnt(" #n ")" ::: "memory")
#define PG8_BAR __builtin_amdgcn_s_barrier()
#define PG8_SCHED __builtin_amdgcn_sched_barrier(0)
    Unit cur, nxt; int ui = 0;
    if (!S.next(0, cur)) return;
    f32x4 acc[2][2][4][2];
#pragma unroll
    for (int a = 0; a < 2; ++a)
#pragma unroll
        for (int b = 0; b < 2; ++b)
#pragma unroll
            for (int m = 0; m < 4; ++m)
#pragma unroll
                for (int n = 0; n < 2; ++n) acc[a][b][m][n] = (f32x4){0.f, 0.f, 0.f, 0.f};
    bf16x8 At[4][2], B0[2][2], B1[2][2];
    const char* cA = (const char*)g.A + (size_t)cur.pm * tstepA + (size_t)cur.ko * 2; const char* cB = (const char*)g.Bt + (size_t)cur.pn * tstepB + (size_t)cur.ko * 2;
    S.a_ready(cur);
    if constexpr (SP2) {
        PG8_STAGE(PG8_SB(0, 0), cB, voffB); PG8_STAGE(PG8_SB(0, 1), cB + hstepB, voffB); PG8_STAGE(PG8_SA(0, 0), cA, voffA); PG8_STAGE(PG8_SA(0, 1), cA + hstepA, voffA);
        if (wr == 1) PG8_BAR;
        PG8_WAIT_V(2); PG8_BAR;
        PG8_STAGE(PG8_SB(1, 0), cB + kstep, voffB); PG8_STAGE(PG8_SA(1, 0), cA + kstep, voffA); PG8_STAGE(PG8_SB(1, 1), cB + hstepB + kstep, voffB);
        PG8_WAIT_V(6); PG8_BAR;
    } else {
        PG8_STAGE(PG8_SB(0, 0), cB, voffB); PG8_STAGE(PG8_SA(0, 0), cA, voffA); PG8_STAGE(PG8_SB(0, 1), cB + hstepB, voffB); PG8_STAGE(PG8_SA(0, 1), cA + hstepA, voffA);
        if (wr == 1) PG8_BAR;
        PG8_WAIT_V(4); PG8_BAR;
        PG8_STAGE(PG8_SB(1, 0), cB + kstep, voffB); PG8_STAGE(PG8_SA(1, 0), cA + kstep, voffA); PG8_STAGE(PG8_SB(1, 1), cB + hstepB + kstep, voffB);
        PG8_WAIT_V(6); PG8_BAR;
    }
    for (;;) {
        const bool has_next = S.next(ui + 1, nxt);
        const char* nA = has_next ? (const char*)g.A + (size_t)nxt.pm * tstepA + (size_t)nxt.ko * 2 : cA; const char* nB = has_next ? (const char*)g.Bt + (size_t)nxt.pn * tstepB + (size_t)nxt.ko * 2 : cB;
        const int ntu = cur.nt ? cur.nt : nt;
#pragma unroll 1
        for (int t = 0; t < ntu; t += 2) {
            const bool last = (t == ntu - 2);
            const char* a1 = cA + (size_t)(t + 1) * kstep;
            const char* a2 = last ? nA : cA + (size_t)(t + 2) * kstep; const char* b2 = last ? nB : cB + (size_t)(t + 2) * kstep;
            const char* a3 = a2 + kstep; const char* b3 = b2 + kstep;
            if (last && has_next) S.a_ready(nxt);
            if constexpr (SP2) {
            PG8_LDB(B0, 0, 0); PG8_LDB(B1, 0, 1); PG8_SCHED; PG8_LDA(At, 0, 0); PG8_STAGE(PG8_SA(1, 1), a1 + hstepA, voffA);
            PG8_WAIT_V(8); PG8_WAIT_L(0); PG8_BAR; PG8_MMA(0, 0, At, B0); PG8_MMA(0, 1, At, B1); PG8_BAR; PG8_SCHED;
            PG8_LDA(At, 0, 1); PG8_STAGE(PG8_SB(0, 0), b2, voffB); PG8_STAGE(PG8_SB(0, 1), b2 + hstepB, voffB); PG8_STAGE(PG8_SA(0, 0), a2, voffA);
            PG8_WAIT_V(8); PG8_WAIT_L(0); PG8_BAR; PG8_MMA(1, 0, At, B0); PG8_MMA(1, 1, At, B1); PG8_BAR; PG8_SCHED;
            PG8_LDB(B0, 1, 0); PG8_LDB(B1, 1, 1); PG8_SCHED; PG8_LDA(At, 1, 0); PG8_STAGE(PG8_SA(0, 1), a2 + hstepA, voffA);
            PG8_WAIT_V(8); PG8_WAIT_L(0); PG8_BAR; PG8_MMA(0, 0, At, B0); PG8_MMA(0, 1, At, B1); PG8_BAR; PG8_SCHED;
            PG8_LDA(At, 1, 1); PG8_STAGE(PG8_SB(1, 0), b3, voffB); PG8_STAGE(PG8_SB(1, 1), b3 + hstepB, voffB); PG8_STAGE(PG8_SA(1, 0), a3, voffA);
            PG8_WAIT_V(8); PG8_WAIT_L(0); PG8_BAR; PG8_MMA(1, 0, At, B0); PG8_MMA(1, 1, At, B1); PG8_BAR; PG8_SCHED;
            } else {
            PG8_LDB(B0, 0, 0); PG8_SCHED; PG8_LDA(At, 0, 0); PG8_STAGE(PG8_SA(1, 1), a1 + hstepA, voffA);
            PG8_WAIT_L(8); PG8_BAR; PG8_WAIT_L(0); PG8_MMA(0, 0, At, B0); PG8_BAR; PG8_SCHED;
            PG8_LDB(B1, 0, 1); PG8_STAGE(PG8_SB(0, 0), b2, voffB);
            PG8_BAR; PG8_WAIT_L(0); PG8_MMA(0, 1, At, B1); PG8_BAR;
            PG8_LDA(At, 0, 1); PG8_STAGE(PG8_SA(0, 0), a2, voffA);
            PG8_BAR; PG8_WAIT_L(0); PG8_MMA(1, 0, At, B0); PG8_BAR; PG8_SCHED;
            PG8_STAGE(PG8_SB(0, 1), b2 + hstepB, voffB);
            PG8_WAIT_V(6); PG8_BAR; PG8_MMA(1, 1, At, B1); PG8_BAR;
            PG8_LDB(B0, 1, 0); PG8_SCHED; PG8_LDA(At, 1, 0); PG8_STAGE(PG8_SA(0, 1), a2 + hstepA, voffA);
            PG8_WAIT_L(8); PG8_BAR; PG8_WAIT_L(0); PG8_MMA(0, 0, At, B0); PG8_BAR; PG8_SCHED;
            PG8_LDB(B1, 1, 1); PG8_STAGE(PG8_SB(1, 0), b3, voffB);
            PG8_BAR; PG8_WAIT_L(0); PG8_MMA(0, 1, At, B1); PG8_BAR;
            PG8_LDA(At, 1, 1); PG8_STAGE(PG8_SA(1, 0), a3, voffA);
            PG8_BAR; PG8_WAIT_L(0); PG8_MMA(1, 0, At, B0); PG8_BAR; PG8_SCHED;
            PG8_STAGE(PG8_SB(1, 1), b3 + hstepB, voffB);
            PG8_WAIT_V(6); PG8_BAR; PG8_MMA(1, 1, At, B1); PG8_BAR;
            }
        }
        if constexpr (ALIGN_EPI) { if (wr == 0) PG8_BAR; }
        if constexpr (!Epi::AFTER_DRAIN) { E(acc, cur, wr, wc, fr, fq); S.done(cur); }
        if (!has_next) break;
        bool keep_acc = false; if constexpr (Epi::KEEP) keep_acc = E.keep(cur);
        if (!keep_acc) {
#pragma unroll
        for (int a = 0; a < 2; ++a)
#pragma unroll
            for (int b = 0; b < 2; ++b)
#pragma unroll
                for (int m = 0; m < 4; ++m)
#pragma unroll
                    for (int n = 0; n < 2; ++n) acc[a][b][m][n] = (f32x4){0.f, 0.f, 0.f, 0.f};
        }
        cur = nxt; cA = nA; cB = nB; ++ui;
        if constexpr (ALIGN_EPI) { if (wr == 1) PG8_BAR; }
    }
    PG8_WAIT_V(0);
    if constexpr (!ALIGN_EPI) { if (wr == 0) PG8_BAR; }
    PG8_BAR;
    if constexpr (Epi::AFTER_DRAIN) { E.fused(acc, cur, wr, wc, fr, fq, lds, wid, lane); S.done(cur); }
#undef PG8_SA
#undef PG8_SB
#undef PG8_STAGE
#undef PG8_LDA
#undef PG8_LDB
#undef PG8_MMA
#undef PG8_WAIT_V
#undef PG8_WAIT_L
#undef PG8_BAR
#undef PG8_SCHED
}
}
#include <hip/hip_bf16.h>
#include <cmath>
namespace attn_body {
using bf16=__hip_bfloat16;
using bf16x8=__attribute__((ext_vector_type(8)))short;
using s16x4=__attribute__((ext_vector_type(4)))short;
using f32x16=__attribute__((ext_vector_type(16)))float;
using u32x4=__attribute__((ext_vector_type(4)))unsigned;
using f32x4_t=__attribute__((ext_vector_type(4)))float;
constexpr int BATCH=16,NHEAD=8,SEQ=4096,D=64,DM=NHEAD*D;
constexpr int NW=8,QBLK=32,QB=QBLK*NW,KVBLK=64,NQB=SEQ/QB;
constexpr int ATTN_PITCH=DM, ATTN_UNIT_ROWS=QB, OPITCH=1024;
__device__ __forceinline__ int crow(int r,int hi){return (r&3)+8*(r>>2)+4*hi;}
#define SBAR() __builtin_amdgcn_sched_barrier(0)
__device__ __forceinline__ void cmask(f32x16&p0,f32x16&p1,int jb,int qrel,int hi){
  const float NEG=-INFINITY; int kb=64*jb+4*hi;
  #pragma unroll
  for(int r=0;r<16;++r){int kv=kb+(r&3)+8*(r>>2); if(kv>qrel)p0[r]=NEG; if(kv+32>qrel)p1[r]=NEG;}
}

constexpr int NSLOT=3, SLOTB=8192;
constexpr int LDS_K=0, LDS_V=NSLOT*SLOTB, LDS_WS=2*NSLOT*SLOTB, LDS_OST=LDS_WS+NW*64*4, LDS_KB=LDS_OST+NW*4096, LDS_NXT=LDS_KB+SEQ*4, LDS_BYTES=LDS_NXT+16;
constexpr float C2=0.125f*1.4426950408889634f;
__device__ __forceinline__ void glds16(const void*gsrc,unsigned lds_dst){unsigned keep;
  asm volatile("s_mov_b32 %0, m0\n\ts_mov_b32 m0, %2\n\ts_nop 0\n\tglobal_load_lds_dwordx4 %1, off\n\ts_mov_b32 m0, %0":"=&s"(keep):"v"(gsrc),"s"(lds_dst):"memory");}
__device__ __forceinline__ float max3f(float a,float b,float c){float r;asm("v_max3_f32 %0, %1, %2, %3":"=v"(r):"v"(a),"v"(b),"v"(c));return r;}
__device__ __forceinline__ float max2f(float a,float b){float r;asm("v_max_f32_e32 %0, %1, %2":"=v"(r):"v"(a),"v"(b));return r;}
__device__ __forceinline__ float fadd_s(float a,float b){float r;asm("v_add_f32_e32 %0, %1, %2":"=v"(r):"v"(a),"v"(b));return r;}
__device__ __forceinline__ float fsub_s(float a,float b){float r;asm("v_sub_f32_e32 %0, %1, %2":"=v"(r):"v"(a),"v"(b));return r;}
typedef float f32x2_t __attribute__((ext_vector_type(2))); typedef __bf16 bf16x2_t __attribute__((ext_vector_type(2)));
__device__ __forceinline__ unsigned cvtpk_s(float lo,float hi){f32x2_t v={lo,hi};bf16x2_t b=__builtin_convertvector(v,bf16x2_t);return __builtin_bit_cast(unsigned,b);}
#define WAIT_BAR(N) asm volatile("s_waitcnt vmcnt(" #N ") lgkmcnt(0)\n\ts_barrier":::"memory")

__device__ __forceinline__ void qkt(f32x16&p0,f32x16&p1,const char*Kslot,const bf16x8*qr,int r32,int hi){
  const char*kb=Kslot+hi*1024+r32*16;
  #pragma unroll
  for(int d0=0;d0<4;++d0){
    const bf16x8 b0=*reinterpret_cast<const bf16x8*>(kb+d0*2048);
    const bf16x8 b1=*reinterpret_cast<const bf16x8*>(kb+d0*2048+512);
    {p0=__builtin_amdgcn_mfma_f32_32x32x16_bf16(b0,qr[d0],p0,0,0,0);p1=__builtin_amdgcn_mfma_f32_32x32x16_bf16(b1,qr[d0],p1,0,0,0);}}
}
typedef __attribute__((address_space(3))) const char* lds_cptr;
typedef short v4i16_t __attribute__((ext_vector_type(4)));
__device__ __forceinline__ void kload8(bf16x8*kf,lds_cptr kp){
  kf[0]=*(const __attribute__((address_space(3))) bf16x8*)(kp);      kf[1]=*(const __attribute__((address_space(3))) bf16x8*)(kp+512);
  kf[2]=*(const __attribute__((address_space(3))) bf16x8*)(kp+2048); kf[3]=*(const __attribute__((address_space(3))) bf16x8*)(kp+2560);
  kf[4]=*(const __attribute__((address_space(3))) bf16x8*)(kp+4096); kf[5]=*(const __attribute__((address_space(3))) bf16x8*)(kp+4608);
  kf[6]=*(const __attribute__((address_space(3))) bf16x8*)(kp+6144); kf[7]=*(const __attribute__((address_space(3))) bf16x8*)(kp+6656);
}
__device__ __forceinline__ void kload2(bf16x8*kf,lds_cptr kp,int j){ kf[2*j]=*(const __attribute__((address_space(3))) bf16x8*)(kp+j*2048); kf[2*j+1]=*(const __attribute__((address_space(3))) bf16x8*)(kp+j*2048+512); }
__device__ __forceinline__ s16x4 vtr(lds_cptr p){ return __builtin_bit_cast(s16x4,__builtin_amdgcn_ds_read_tr16_b64_v4i16((__attribute__((address_space(3))) v4i16_t*)p)); }
__device__ __forceinline__ float rowmax(const f32x16&p0,const f32x16&p1){
  float a=max3f(p0[0],p0[1],p1[0]),b=max3f(p0[2],p0[3],p1[1]);a=max3f(a,p1[2],p1[3]);
  #pragma unroll
  for(int r=4;r<16;r+=4){a=max3f(a,p0[r],p0[r+1]);b=max3f(b,p0[r+2],p0[r+3]);a=max3f(a,p1[r],p1[r+1]);b=max3f(b,p1[r+2],p1[r+3]);}
  const float m=max2f(a,b);
  auto rr=__builtin_amdgcn_permlane32_swap(__float_as_uint(m),__float_as_uint(m),false,false);
  return max2f(__uint_as_float(rr[0]),__uint_as_float(rr[1]));
}
__device__ __forceinline__ void pv(f32x16*o,int vb,bf16x8 pa0,bf16x8 pa1,bf16x8 pa2,bf16x8 pa3){
  #pragma unroll
  for(int d0=0;d0<2;++d0){s16x4 lo[4],hi[4];
    #pragma unroll
    for(int ks=0;ks<4;++ks){
      asm volatile("ds_read_b64_tr_b16 %0,%1 offset:%c2":"=&v"(lo[ks]):"v"(vb),"i"(d0*4096+ks*1024):"memory");
      asm volatile("ds_read_b64_tr_b16 %0,%1 offset:%c2":"=&v"(hi[ks]):"v"(vb),"i"(d0*4096+ks*1024+512):"memory");}
    asm volatile("s_waitcnt lgkmcnt(0)":::"memory");SBAR();
    #define PK(k) (bf16x8){lo[k][0],lo[k][1],lo[k][2],lo[k][3],hi[k][0],hi[k][1],hi[k][2],hi[k][3]}
    o[d0]=__builtin_amdgcn_mfma_f32_32x32x16_bf16(pa0,PK(0),o[d0],0,0,0);
    o[d0]=__builtin_amdgcn_mfma_f32_32x32x16_bf16(pa1,PK(1),o[d0],0,0,0);
    o[d0]=__builtin_amdgcn_mfma_f32_32x32x16_bf16(pa2,PK(2),o[d0],0,0,0);
    o[d0]=__builtin_amdgcn_mfma_f32_32x32x16_bf16(pa3,PK(3),o[d0],0,0,0);
    #undef PK
  }
}

#ifndef ATTN_STORE16
#define ATTN_STORE16(p,v) (*(u32x4*)(p)=(v))
#endif
template<int THRL> __device__ __forceinline__ void attn_unit(int b,int h,int qb,const bf16*Q,const bf16*__restrict__ K,const bf16*__restrict__ V,bf16*O,const float*__restrict__ KBG,float sbound,unsigned*qctr,int qbase,int nxoff,char*shm){
  int tid_l=threadIdx.x; asm volatile("":"+v"(tid_l));
  const int tid=tid_l,lane=tid&63,r32=lane&31,hi=lane>>5; const int wid=__builtin_amdgcn_readfirstlane(tid>>6);
  const long rowbase=(long)b*SEQ; const int q0=qb*QB;
  const bf16*Qw=Q+(rowbase+q0+wid*QBLK)*DM+h*D;
  const bf16*Kh=K+rowbase*DM+h*D,*Vh=V+rowbase*DM+h*D;
  const lds_cptr shm3=(lds_cptr)shm;
  const unsigned lds0=(unsigned)(uintptr_t)shm;
  float*wsf=(float*)(shm+LDS_WS)+wid*64;
  const bf16*ksrc_=Kh+(long)lane*DM+wid*8;
  const bf16*vsrc_=Vh+(long)(16*(wid&3)+(lane>>2))*DM+(wid>>2)*32+(lane&3)*8;
  const unsigned kdst=lds0+LDS_K+wid*1024, vdst=lds0+LDS_V+wid*1024;
  #define DMA_K(t,slot) glds16(ksrc+(long)(t)*KVBLK*DM,(unsigned)__builtin_amdgcn_readfirstlane(kdst+(slot)))
  #define DMA_V(t,slot) glds16(vsrc+(long)(t)*KVBLK*DM,(unsigned)__builtin_amdgcn_readfirstlane(vdst+(slot)))
  const int vb0=(int)(lds0+LDS_V)+((lane>>4)&1)*32+(lane&3)*8+(4*hi+((lane&15)>>2))*64;
  const char*Kbase=shm+LDS_K; bf16x8 kf[8];
  const lds_cptr kp0=shm3+LDS_K+hi*1024+r32*16; const lds_cptr vp0=shm3+LDS_V+((lane>>4)&1)*32+(lane&3)*8+(4*hi+((lane&15)>>2))*64;
  int NT=(q0+QB)/KVBLK;
  {
    const float*kg=KBG+((long)b*NHEAD+h)*SEQ; const float ref=kg[q0]; float*kbl=(float*)(shm+LDS_KB);
    for(int j=tid;j<q0+QB;j+=NW*64)kbl[j]=kg[j]-ref;
    asm volatile("s_waitcnt vmcnt(0) lgkmcnt(0)\n\ts_barrier":::"memory"); }
  int tskip; { const float*kbl=(const float*)(shm+LDS_KB); const bool dead=(lane<NT-4)&&(kbl[64*lane+63]+sbound<-140.f); tskip=__builtin_popcountll(__ballot(dead))&~1; }
  tskip=__builtin_amdgcn_readfirstlane(tskip); NT-=tskip;
  const bf16*ksrc=ksrc_+(long)tskip*KVBLK*DM; const bf16*vsrc=vsrc_+(long)tskip*KVBLK*DM;
  const __attribute__((address_space(3))) float*kbp0=(const __attribute__((address_space(3))) float*)(shm3+LDS_KB)+4*hi+64*tskip;
  unsigned nx_=0u; if(tid==0)nx_=__hip_atomic_fetch_add(qctr,1u,__ATOMIC_RELAXED,__HIP_MEMORY_SCOPE_AGENT);
  DMA_K(0,0);DMA_V(0,0);DMA_K(1,SLOTB);
  bf16x8 qr[4];
  #pragma unroll
  for(int d0=0;d0<4;++d0)qr[d0]=*reinterpret_cast<const bf16x8*>(&Qw[(long)r32*DM+d0*16+hi*8]);
  float mhat=0.f,l_reg=0.f;f32x16 o[2];o[0]=f32x16{};o[1]=f32x16{};
  const int qrel=wid*QBLK+r32;
  #define CMASK(P0,P1,t) do{int jb_=(t)-(NT-4); if(jb_>=0)cmask(P0,P1,jb_,qrel,hi);}while(0)
  #define KBP(t,i) (kbp0+64*(t)+(((i)<4)?8*(i):32+8*((i)-4)))
  #define KINIT(P0,P1,t,MH) do{ _Pragma("unroll") for(int k_=0;k_<4;++k_){ const f32x4_t a_=*(const __attribute__((address_space(3))) f32x4_t*)KBP(t,k_); const f32x4_t b_=*(const __attribute__((address_space(3))) f32x4_t*)KBP(t,k_+4); \
      P0[4*k_]=a_[0]-(MH);P0[4*k_+1]=a_[1]-(MH);P0[4*k_+2]=a_[2]-(MH);P0[4*k_+3]=a_[3]-(MH); P1[4*k_]=b_[0]-(MH);P1[4*k_+1]=b_[1]-(MH);P1[4*k_+2]=b_[2]-(MH);P1[4*k_+3]=b_[3]-(MH); } }while(0)
  #define KLD(G,t,i,P) do{ if(G){ const f32x4_t a_=*(const __attribute__((address_space(3))) f32x4_t*)KBP((t)+1,i); P[4*((i)&3)]=a_[0]; P[4*((i)&3)+1]=a_[1]; P[4*((i)&3)+2]=a_[2]; P[4*((i)&3)+3]=a_[3]; } }while(0)
  #define KSUB(G,i,P) do{ if(G){ P[4*((i)&3)]-=mhat; P[4*((i)&3)+1]-=mhat; P[4*((i)&3)+2]-=mhat; P[4*((i)&3)+3]-=mhat; } }while(0)
  bool resc=false;
  #define START(P0,P1) do{ const float rm=rowmax(P0,P1); resc=false; \
    { const float dl=__builtin_fmaxf(rm,0.f); mhat=fadd_s(mhat,dl); \
      _Pragma("unroll") for(int r=0;r<16;++r){P0[r]=fsub_s(P0[r],dl);P1[r]=fsub_s(P1[r],dl);} \
      } \
    _Pragma("unroll") for(int r=0;r<16;++r)P0[r]=__builtin_amdgcn_exp2f(P0[r]); }while(0)
  #define RESC() do{ if(resc){ asm volatile("s_waitcnt lgkmcnt(0)":::"memory"); \
      _Pragma("unroll") for(int d_=0;d_<2;++d_) _Pragma("unroll") for(int r=0;r<16;++r)o[d_][r]*=wsf[crow(r,hi)]; } }while(0)
  int sl_prev=0,sl_cur=0,sl_next=SLOTB;
  #define ROT() do{sl_prev=sl_cur;sl_cur=sl_next;sl_next=(sl_next==(NSLOT-1)*SLOTB)?0:sl_next+SLOTB;}while(0)
  DMA_K(2,2*SLOTB);
  WAIT_BAR(3);
  f32x16 pA0,pA1,pB0,pB1;
  mhat=((const float*)(shm+LDS_KB))[q0+qrel];
  KINIT(pA0,pA1,0,mhat);
  qkt(pA0,pA1,Kbase,qr,r32,hi);asm volatile("s_nop 15\n\ts_nop 7":"+v"(pA0),"+v"(pA1));CMASK(pA0,pA1,0);
  START(pA0,pA1);
  KINIT(pB0,pB1,1,mhat);
  _Pragma("unroll") for(int r=0;r<16;++r)pA1[r]=__builtin_amdgcn_exp2f(pA1[r]);
  WAIT_BAR(0);
  DMA_K(3,0);DMA_V(1,SLOTB);
  ROT();
  kload8(kf,kp0+sl_cur);
  WAIT_BAR(2);
  s16x4 vlo[8],vhi[8]; u32x4 pw0,pw1,pw2,pw3;
  #define PKW(P,B) cvtpk_s(P[B],P[B+1])
  #define PAF(k) __builtin_bit_cast(bf16x8,pw##k)
  #define VFR(i) (bf16x8){vlo[i][0],vlo[i][1],vlo[i][2],vlo[i][3],vhi[i][0],vhi[i][1],vhi[i][2],vhi[i][3]}
  #define PIN(x) asm volatile("":"+v"(x))
  #define MX3(a,b,c) __builtin_fmaxf(__builtin_fmaxf((a),(b)),(c))
  #define GAPA(MF,A0,A1,A2,A3,W0,W1,PW) do{ MF; sacc+=A0; sacc+=A1; sacc+=A2; sacc+=A3; PIN(sacc); W0; W1; PIN(PW); SBAR(); }while(0)
  #define EX(v) __builtin_amdgcn_exp2f(v)
  #define GAPB(MF,X,B) do{ MF; X[B]=EX(X[B]); X[B+1]=EX(X[B+1]); X[B+2]=EX(X[B+2]); X[B+3]=EX(X[B+3]); PIN(X); SBAR(); }while(0)
  #define VRD(i) do{ vlo[i]=vtr(vp_+(((i)>>2)*4096+((i)&3)*1024)); vhi[i]=vtr(vp_+(((i)>>2)*4096+((i)&3)*1024+512)); }while(0)
  #define KRD(G,j) do{ if(G){ kload2(kf,kp0+sl_next,j); SBAR(); } }while(0)
  #define STEP(C0,C1,P0,P1,t,GK,GV,GL) do{ SBAR(); \
    const lds_cptr vp_=vp0+sl_prev; \
    VRD(0); SBAR(); float sacc=(P0[0]+P0[1]); \
    GAPA(C0=__builtin_amdgcn_mfma_f32_32x32x16_bf16(kf[0],qr[0],C0,0,0,0), P0[2],P0[3],P0[4],P0[5],     pw0[0]=PKW(P0,0), pw0[1]=PKW(P0,2), pw0); \
    VRD(4); SBAR(); GAPA(C1=__builtin_amdgcn_mfma_f32_32x32x16_bf16(kf[1],qr[0],C1,0,0,0), P0[6],P0[7],P0[8],P0[9],     pw0[2]=PKW(P0,4), pw0[3]=PKW(P0,6), pw0); \
    VRD(1); SBAR(); GAPA(C0=__builtin_amdgcn_mfma_f32_32x32x16_bf16(kf[2],qr[1],C0,0,0,0),   P0[10],P0[11],P0[12],P0[13], pw1[0]=PKW(P0,8), pw1[1]=PKW(P0,10), pw1); \
    VRD(5); SBAR(); GAPA(C1=__builtin_amdgcn_mfma_f32_32x32x16_bf16(kf[3],qr[1],C1,0,0,0),   P0[14],P0[15],P1[0],P1[1],   pw1[2]=PKW(P0,12),pw1[3]=PKW(P0,14), pw1); \
    VRD(2); SBAR(); GAPA(C0=__builtin_amdgcn_mfma_f32_32x32x16_bf16(kf[4],qr[2],C0,0,0,0),   P1[2],P1[3],P1[4],P1[5],     pw2[0]=PKW(P1,0), pw2[1]=PKW(P1,2), pw2); \
    VRD(6); SBAR(); GAPA(C1=__builtin_amdgcn_mfma_f32_32x32x16_bf16(kf[5],qr[2],C1,0,0,0),   P1[6],P1[7],P1[8],P1[9],     pw2[2]=PKW(P1,4), pw2[3]=PKW(P1,6), pw2); \
    VRD(3); SBAR(); GAPA(C0=__builtin_amdgcn_mfma_f32_32x32x16_bf16(kf[6],qr[3],C0,0,0,0),   P1[10],P1[11],P1[12],P1[13], pw3[0]=PKW(P1,8), pw3[1]=PKW(P1,10), pw3); \
    VRD(7); SBAR(); GAPA(C1=__builtin_amdgcn_mfma_f32_32x32x16_bf16(kf[7],qr[3],C1,0,0,0),   P1[14],P1[15],0.f,0.f,       pw3[2]=PKW(P1,12),pw3[3]=PKW(P1,14), pw3); \
    l_reg+=sacc; \
    if(GK){DMA_K((t)+3,sl_cur);} if(GV){DMA_V((t)+1,sl_next);} \
    CMASK(C0,C1,t); \
    { float a=MX3(C0[0],C0[1],C1[0]),b=MX3(C0[2],C0[3],C1[1]); a=MX3(a,C1[2],C1[3]); \
      _Pragma("unroll") for(int r=4;r<16;r+=4){a=MX3(a,C0[r],C0[r+1]);b=MX3(b,C0[r+2],C0[r+3]);a=MX3(a,C1[r],C1[r+1]);b=MX3(b,C1[r+2],C1[r+3]);} \
      float rm=__builtin_fmaxf(a,b); { auto rr=__builtin_amdgcn_permlane32_swap(__float_as_uint(rm),__float_as_uint(rm),false,false); rm=__builtin_fmaxf(__uint_as_float(rr[0]),__uint_as_float(rr[1])); } \
      resc=false; \
      if(__builtin_expect(__any(rm>(float)THRL),0)){ const float dl=__builtin_fmaxf(rm,0.f); mhat+=dl; \
        _Pragma("unroll") for(int r=0;r<16;++r){C0[r]-=dl;C1[r]-=dl;} \
        const float f=__builtin_amdgcn_exp2f(-dl); l_reg*=f; if(hi==0)wsf[r32]=f; resc=true; } } \
    SBAR(); \
    KLD(GL,t,0,P0); GAPB(o[0]=__builtin_amdgcn_mfma_f32_32x32x16_bf16(PAF(0),VFR(0),o[0],0,0,0), C0,0); \
    KLD(GL,t,1,P0); KSUB(GL,0,P0); GAPB(o[1]=__builtin_amdgcn_mfma_f32_32x32x16_bf16(PAF(0),VFR(4),o[1],0,0,0), C0,4); \
    KRD(GL,0); KLD(GL,t,2,P0); KSUB(GL,1,P0); GAPB(o[0]=__builtin_amdgcn_mfma_f32_32x32x16_bf16(PAF(1),VFR(1),o[0],0,0,0), C0,8); \
    KRD(GL,1); KLD(GL,t,3,P0); KSUB(GL,2,P0); GAPB(o[1]=__builtin_amdgcn_mfma_f32_32x32x16_bf16(PAF(1),VFR(5),o[1],0,0,0), C0,12); \
    KRD(GL,2); KLD(GL,t,4,P1); KSUB(GL,3,P0); GAPB(o[0]=__builtin_amdgcn_mfma_f32_32x32x16_bf16(PAF(2),VFR(2),o[0],0,0,0), C1,0); \
    KRD(GL,3); KLD(GL,t,5,P1); KSUB(GL,4,P1); GAPB(o[1]=__builtin_amdgcn_mfma_f32_32x32x16_bf16(PAF(2),VFR(6),o[1],0,0,0), C1,4); \
    KLD(GL,t,6,P1); KSUB(GL,5,P1); GAPB(o[0]=__builtin_amdgcn_mfma_f32_32x32x16_bf16(PAF(3),VFR(3),o[0],0,0,0), C1,8); \
    KLD(GL,t,7,P1); KSUB(GL,6,P1); GAPB(o[1]=__builtin_amdgcn_mfma_f32_32x32x16_bf16(PAF(3),VFR(7),o[1],0,0,0), C1,12); \
    KSUB(GL,7,P1); \
    }while(0)
  int t=1;
  #undef CMASK
  #define CMASK(P0,P1,t) do{}while(0)
  for(;t+5<NT;t+=2){
    STEP(pB0,pB1,pA0,pA1,t,true,true,true);     WAIT_BAR(2); RESC(); ROT();
    STEP(pA0,pA1,pB0,pB1,t+1,true,true,true);   WAIT_BAR(2); RESC(); ROT();
  }
  #undef CMASK
  #define CMASK(P0,P1,t) do{int jb_=(t)-(NT-4); if(jb_>=0)cmask(P0,P1,jb_,qrel,hi);}while(0)
  #define ENDW(tt) do{ if((tt)+3<NT){WAIT_BAR(2);} else if((tt)+2<NT){WAIT_BAR(1);} else {WAIT_BAR(0);} }while(0)
  for(;t+1<NT;t+=2){
    STEP(pB0,pB1,pA0,pA1,t,(t+3<NT),(t+1<NT),(t+1<NT));       ENDW(t);   RESC(); ROT();
    STEP(pA0,pA1,pB0,pB1,t+1,(t+4<NT),(t+2<NT),(t+2<NT));     ENDW(t+1); RESC(); ROT();
  }
  STEP(pB0,pB1,pA0,pA1,NT-1,false,false,false); RESC();
  { float sacc=pB0[0]+pB0[1]; _Pragma("unroll") for(int r=2;r<16;++r)sacc+=pB0[r]; _Pragma("unroll") for(int r=0;r<16;++r)sacc+=pB1[r]; l_reg+=sacc;
    pw0=(u32x4){PKW(pB0,0),PKW(pB0,2),PKW(pB0,4),PKW(pB0,6)};pw1=(u32x4){PKW(pB0,8),PKW(pB0,10),PKW(pB0,12),PKW(pB0,14)};pw2=(u32x4){PKW(pB1,0),PKW(pB1,2),PKW(pB1,4),PKW(pB1,6)};pw3=(u32x4){PKW(pB1,8),PKW(pB1,10),PKW(pB1,12),PKW(pB1,14)};
    SBAR(); pv(o,vb0+sl_cur,PAF(0),PAF(1),PAF(2),PAF(3)); }
  #undef PKW
  #undef PAF
  #undef VFR
  #undef PIN
  #undef MX3
  #undef GAPA
  #undef GAPB
  #undef EX
  #undef VRD
  #undef KRD
  #undef STEP
  #undef ENDW
  if(tid==0)*(volatile unsigned*)(shm+LDS_NXT+nxoff)=nx_+(unsigned)qbase;
  {auto rr=__builtin_amdgcn_permlane32_swap(__float_as_uint(l_reg),__float_as_uint(l_reg),false,false);l_reg=__uint_as_float(rr[0])+__uint_as_float(rr[1]);}
  if(hi==0)wsf[32+r32]=l_reg;asm volatile("s_waitcnt lgkmcnt(0)":::"memory");
  float rli[16];
  #pragma unroll
  for(int r=0;r<16;++r)rli[r]=__builtin_amdgcn_rcpf(wsf[32+crow(r,hi)]);
  bf16*Ow=O+(rowbase+q0+wid*QBLK)*OPITCH+h*D;
  { bf16*stg=(bf16*)(shm+LDS_OST)+wid*2048;
    #pragma unroll
    for(int r=0;r<16;++r){const int orow=crow(r,hi);
      #pragma unroll
      for(int d0=0;d0<2;++d0)stg[orow*64+d0*32+r32]=__float2bfloat16(o[d0][r]*rli[r]);}
    asm volatile("s_waitcnt lgkmcnt(0)":::"memory");
    #pragma unroll
    for(int i=0;i<4;++i){const int row=i*8+(lane>>3),ch=lane&7; const u32x4 v=*(const u32x4*)(stg+row*64+ch*8); ATTN_STORE16(Ow+(long)row*OPITCH+ch*8,v);} }
  asm volatile("s_waitcnt lgkmcnt(0)\n\ts_barrier":::"memory");
  #undef DMA_K
  #undef DMA_V
  #undef CMASK
  #undef KINIT
  #undef KLD
  #undef KSUB
  #undef KBP
  #undef START
  #undef RESC
  #undef ROT
}
constexpr int ATTN_LDS_BYTES=LDS_BYTES;
struct AttnTensors { const bf16* Q; const bf16* K; const bf16* V; bf16* O; const float* KB; };
template<int THRL=8> __device__ __forceinline__ void attn_phase(char*lds,const AttnTensors&T,float sbound,unsigned*qctr,int bx,int G){
  constexpr int NU=BATCH*NHEAD*NQB; int u=bx,nxoff=0;
  _Pragma("unroll 1") while(u<NU){ const int qb=NQB-1-u/(BATCH*NHEAD), bh=u%(BATCH*NHEAD);
    attn_unit<THRL>(bh/NHEAD,bh%NHEAD,qb,T.Q,T.K,T.V,T.O,T.KB,sbound,qctr,G,nxoff,lds);
    u=(int)*(volatile unsigned*)(lds+LDS_NXT+nxoff); u=__builtin_amdgcn_readfirstlane(u); nxoff^=4; }
}
#undef SBAR
#undef WAIT_BAR
}
namespace cg = cooperative_groups;
#define LAS __attribute__((address_space(3)))
typedef unsigned short bf16;
using pg8::f32x4; using pg8::u32x4; using pg8::Unit; using pg8::cvt_pk_bf16;
typedef unsigned u32x2 __attribute__((ext_vector_type(2)));

constexpr int NB = 16, SEQ = 4096, T = NB * SEQ, D = 1024, FF = 4096, INC = 5128, NIN = 5376, UP = 640, NLAYER = 2;
constexpr float EPS = 1e-6f, LOG2E = 1.4426950408889634f, C2Q = 0.125f * LOG2E;
enum { I_X = 0, I_MIXN, I_WIN, I_BF, I_QN, I_KN, I_ARE, I_AIM, I_LDT, I_BRE, I_BIM, I_CRE, I_CIM, I_SD, I_WGLU, I_PW, I_PS, I_WBA, I_WBS, I_WBP, I_BG, I_WOUT, I_MLPN, I_WUP, I_WDN, N_IN };

constexpr size_t MiB = 1u << 20;
constexpr size_t WL_STRIDE = 48 * MiB;
constexpr size_t WL_WIN = 0, WL_WA = 11 * MiB  , WL_WOUT = 13 * MiB, WL_WUP = 15 * MiB, WL_WDN = 23 * MiB,
                 WL_WGLU = 31 * MiB, WL_TZ = 32 * MiB, WL_MEND = 42 * MiB, WL_DL = 46 * MiB;
constexpr size_t WS_ACAT = 96 * MiB;
constexpr size_t WS_XB = 96 * MiB, WS_SSQ = 224 * MiB, WS_Q = 228 * MiB, WS_K = 292 * MiB, WS_V = 356 * MiB, WS_MERGED = WS_K, WS_U = 420 * MiB, WS_UPOOL = 460 * MiB,
                 WS_GATES = 492 * MiB, WS_FLOG = 876 * MiB, WS_KB = 878 * MiB, WS_S = 880 * MiB, WS_YPRE = 896 * MiB, WS_YSSM = 928 * MiB, WS_POOLED = 960 * MiB,
                 WS_DBG = 992 * MiB, WS_END = 1001 * MiB, WS_ACT = WS_U;
static_assert(WS_ACT + (size_t)T * FF * 2 <= WS_POOLED && WS_MERGED + (size_t)T * D * 2 <= WS_ACT, "act overlay");
constexpr int LDS_BYTES = 147456;

constexpr int N_PHASES_ = 1 + 9 * NLAYER;
struct Params { const float* in[N_IN]; float* out; unsigned char* ws; int ph_lo, ph_hi, dbg, pad; };

__device__ __forceinline__ u32x4 pack8(f32x4 a, f32x4 b) { u32x4 w; w.x = cvt_pk_bf16(a[0], a[1]); w.y = cvt_pk_bf16(a[2], a[3]); w.z = cvt_pk_bf16(b[0], b[1]); w.w = cvt_pk_bf16(b[2], b[3]); return w; }
__device__ __forceinline__ void unpack8(u32x4 w, f32x4& a, f32x4& b) {
    a[0] = __uint_as_float(w.x << 16); a[1] = __uint_as_float(w.x & 0xffff0000u); a[2] = __uint_as_float(w.y << 16); a[3] = __uint_as_float(w.y & 0xffff0000u);
    b[0] = __uint_as_float(w.z << 16); b[1] = __uint_as_float(w.z & 0xffff0000u); b[2] = __uint_as_float(w.w << 16); b[3] = __uint_as_float(w.w & 0xffff0000u); }
__device__ __forceinline__ float bf2f(bf16 v) { return __uint_as_float((unsigned)v << 16); }
__device__ __forceinline__ float dot4(f32x4 a) { return (a[0] * a[0] + a[1] * a[1]) + (a[2] * a[2] + a[3] * a[3]); }
__device__ __forceinline__ float row_rstd(const float* ssq, int row) {
    const f32x4* p = (const f32x4*)(ssq + (size_t)row * 16); const f32x4 a = p[0], b = p[1], c = p[2], d = p[3];
    const float s = ((a[0] + a[1]) + (a[2] + a[3])) + ((b[0] + b[1]) + (b[2] + b[3])) + ((c[0] + c[1]) + (c[2] + c[3])) + ((d[0] + d[1]) + (d[2] + d[3]));
    return __builtin_amdgcn_rsqf(s * (1.0f / D) + EPS); }
__device__ __forceinline__ float sigm(float x) { return __builtin_amdgcn_rcpf(1.0f + __expf(-x)); }
__device__ __forceinline__ f32x4 sigm4(f32x4 x) { f32x4 r; r[0] = sigm(x[0]); r[1] = sigm(x[1]); r[2] = sigm(x[2]); r[3] = sigm(x[3]); return r; }
__device__ __forceinline__ float gelu_t(float y) { const float z = 1.5957691216057308f * (y + 0.044715f * y * y * y); return y * __builtin_amdgcn_rcpf(1.0f + __expf(-z)); }
__device__ __forceinline__ f32x4 gelu4(f32x4 x) { f32x4 r; r[0] = gelu_t(x[0]); r[1] = gelu_t(x[1]); r[2] = gelu_t(x[2]); r[3] = gelu_t(x[3]); return r; }
__device__ __forceinline__ float logsig(float x) { return fminf(x, 0.f) - log1pf(__expf(-fabsf(x))); }

struct EpiIn {
    static constexpr bool PERM = true, AFTER_DRAIN = false, KEEP = false;
    bf16 *q, *k, *v, *U, *upool, *gates; float* flog; const float* ssq; const float *qg, *kg, *bgate, *bforget;
    __device__ __forceinline__ void operator()(const f32x4 (&acc)[2][2][4][2], const Unit& u, int wr, int wc, int fr, int fq) const {
        const int tile = u.pn, row0 = u.pm * 256 + wr * 64 + fr, cc0 = wc * 32 + 8 * fq;
        float rsv[2][4];
#pragma unroll
        for (int ai = 0; ai < 2; ++ai)
#pragma unroll
            for (int m = 0; m < 4; ++m) rsv[ai][m] = row_rstd(ssq, row0 + ai * 128 + m * 16);
        if (tile < 4) {
            const bool isq = tile < 2; const float* gp = (isq ? qg : kg) + 8 * fq; bf16* O = isq ? q : k; const int head = (tile & 1) * 4 + wc; const float sc = isq ? C2Q : 1.f;
            f32x4 g[2][2];
#pragma unroll
            for (int bj = 0; bj < 2; ++bj)
#pragma unroll
                for (int n = 0; n < 2; ++n) g[bj][n] = *(const f32x4*)(gp + 32 * bj + 4 * n);
#pragma unroll
            for (int ai = 0; ai < 2; ++ai)
#pragma unroll
                for (int m = 0; m < 4; ++m) { const int row = row0 + ai * 128 + m * 16; const float rs = rsv[ai][m];
                    f32x4 vv[2][2]; float ss = 0.f;
#pragma unroll
                    for (int bj = 0; bj < 2; ++bj)
#pragma unroll
                        for (int n = 0; n < 2; ++n) { vv[bj][n] = acc[ai][bj][m][n] * rs; ss += dot4(vv[bj][n]); }
                    ss += __shfl_xor(ss, 16); ss += __shfl_xor(ss, 32);
                    const float r = __builtin_amdgcn_rsqf(ss * (1.0f / 64.0f) + EPS) * sc;
#pragma unroll
                    for (int bj = 0; bj < 2; ++bj) *(u32x4*)(O + (size_t)row * 512 + head * 64 + 32 * bj + 8 * fq) = pack8(vv[bj][0] * r * g[bj][0], vv[bj][1] * r * g[bj][1]); __builtin_amdgcn_sched_barrier(0); }
        } else if (tile < 8) {
#pragma unroll
            for (int ai = 0; ai < 2; ++ai)
#pragma unroll
                for (int m = 0; m < 4; ++m) { const int row = row0 + ai * 128 + m * 16; const float rs = rsv[ai][m];
#pragma unroll
                    for (int bj = 0; bj < 2; ++bj) { const int cc = 128 * bj + cc0; bf16* dst;
                        if (tile < 6) dst = v + (size_t)row * 512 + (tile - 4) * 256 + cc;
                        else if (tile == 6) { const int g = cc >> 4, ci0 = cc & 15, b = row >> 12, s = row & 4095; dst = U + ((size_t)(g * 2048 + b * 128 + (s >> 5)) * UP + (s & 31) * 16 + ci0); }
                        else dst = upool + (size_t)row * 256 + cc;
                        *(u32x4*)dst = pack8(acc[ai][bj][m][0] * rs, acc[ai][bj][m][1] * rs); } __builtin_amdgcn_sched_barrier(0); }
        } else if (tile < 20) {
#pragma unroll
            for (int bj = 0; bj < 2; ++bj) { const int col = (tile - 8) * 256 + 128 * bj + cc0; const f32x4 b0 = *(const f32x4*)(bgate + col), b1 = *(const f32x4*)(bgate + col + 4);
#pragma unroll
                for (int ai = 0; ai < 2; ++ai)
#pragma unroll
                    for (int m = 0; m < 4; ++m) { const int row = row0 + ai * 128 + m * 16; const float rs = rsv[ai][m];
                        *(u32x4*)(gates + (size_t)row * 3072 + col) = pack8(sigm4(acc[ai][bj][m][0] * rs + b0), sigm4(acc[ai][bj][m][1] * rs + b1)); __builtin_amdgcn_sched_barrier(0); } }
        } else {
            if (wc == 0 && fq == 0) { const f32x4 b0 = *(const f32x4*)(bforget), b1 = *(const f32x4*)(bforget + 4);
#pragma unroll
                for (int ai = 0; ai < 2; ++ai)
#pragma unroll
                    for (int m = 0; m < 4; ++m) { const int row = row0 + ai * 128 + m * 16; const float rs = rsv[ai][m];
                        const f32x4 x0 = acc[ai][0][m][0] * rs + b0, x1 = acc[ai][0][m][1] * rs + b1; f32x4 o0, o1;
#pragma unroll
                        for (int e = 0; e < 4; ++e) { o0[e] = logsig(x0[e]); o1[e] = logsig(x1[e]); }
                        *(f32x4*)(flog + (size_t)row * 8) = o0; *(f32x4*)(flog + (size_t)row * 8 + 4) = o1; } }
        }
    }
};
struct EpiSend {
    static constexpr bool PERM = true, AFTER_DRAIN = false, KEEP = false;
    float* S;
    __device__ __forceinline__ void operator()(const f32x4 (&acc)[2][2][4][2], const Unit& u, int wr, int wc, int fr, int fq) const {
        const int row0 = u.pm * 256 + wr * 64 + fr, cc0 = wc * 32 + 8 * fq;
#pragma unroll
        for (int ai = 0; ai < 2; ++ai)
#pragma unroll
            for (int m = 0; m < 4; ++m) { float* p = S + (size_t)(row0 + ai * 128 + m * 16) * 128 + cc0; *(f32x4*)p = acc[ai][0][m][0]; *(f32x4*)(p + 4) = acc[ai][0][m][1]; }
    }
};
struct EpiSsmY {
    static constexpr bool PERM = true, AFTER_DRAIN = false, KEEP = false;
    const bf16* U; const float* sd; bf16* ypre;
    __device__ __forceinline__ void operator()(const f32x4 (&acc)[2][2][4][2], const Unit& u, int wr, int wc, int fr, int fq) const {
        const int g = u.pm >> 3, pnl = u.pn & 1, row0 = u.pm * 256 + wr * 64 + fr, cc0 = wc * 32 + 8 * fq;
        u32x4 uw[2][2][4];
#pragma unroll
        for (int bj = 0; bj < 2; ++bj)
#pragma unroll
            for (int ai = 0; ai < 2; ++ai)
#pragma unroll
                for (int m = 0; m < 4; ++m) uw[bj][ai][m] = *(const u32x4*)(U + (size_t)(row0 + ai * 128 + m * 16) * UP + pnl * 256 + 128 * bj + cc0);
#pragma unroll
        for (int bj = 0; bj < 2; ++bj) { const int colidx = pnl * 256 + 128 * bj + cc0, t = colidx >> 4, co0 = colidx & 15;
            const f32x4 d0 = *(const f32x4*)(sd + g * 16 + co0), d1 = *(const f32x4*)(sd + g * 16 + co0 + 4);
#pragma unroll
            for (int ai = 0; ai < 2; ++ai)
#pragma unroll
                for (int m = 0; m < 4; ++m) { const int grow = row0 + ai * 128 + m * 16, rl = grow & 2047, b = rl >> 7, c = rl & 127;
                    f32x4 ua, ub; unpack8(uw[bj][ai][m], ua, ub);
                    *(u32x4*)(ypre + (size_t)(b * 4096 + c * 32 + t) * 256 + g * 16 + co0) = pack8(gelu4(acc[ai][bj][m][0] + d0 * ua), gelu4(acc[ai][bj][m][1] + d1 * ub)); } }
    }
};
struct EpiGlu {
    static constexpr bool PERM = true, AFTER_DRAIN = false, KEEP = false;
    bf16* yssm;
    __device__ __forceinline__ void operator()(const f32x4 (&acc)[2][2][4][2], const Unit& u, int wr, int wc, int fr, int fq) const {
        const int row0 = u.pm * 256 + wr * 64 + fr, col = u.pn * 128 + wc * 32 + 8 * fq;
#pragma unroll
        for (int ai = 0; ai < 2; ++ai)
#pragma unroll
            for (int m = 0; m < 4; ++m) { const int row = row0 + ai * 128 + m * 16;
                *(u32x4*)(yssm + (size_t)row * 1024 + 512 + col) = pack8(acc[ai][0][m][0] * sigm4(acc[ai][1][m][0]), acc[ai][0][m][1] * sigm4(acc[ai][1][m][1])); __builtin_amdgcn_sched_barrier(0); }
    }
};
struct EpiGate3 {
    static constexpr bool PERM = true, AFTER_DRAIN = false, KEEP = true;
    const bf16* gates; bf16* merged;
    __device__ __forceinline__ bool keep(const Unit& u) const { return u.ko != 768; }
    __device__ __forceinline__ void operator()(f32x4 (&acc)[2][2][4][2], const Unit& u, int wr, int wc, int fr, int fq) const {
        const int row0 = u.pm * 256 + wr * 64 + fr, cc0 = wc * 32 + 8 * fq, gi = (u.ko == 0) ? 0 : (u.ko == 512) ? 1 : 2;
        const bf16* gp = gates + (size_t)row0 * 3072 + gi * 1024 + u.pn * 256 + cc0; bf16* mp = merged + (size_t)row0 * 1024 + u.pn * 256 + cc0;
#pragma unroll
        for (int ai = 0; ai < 2; ++ai) { u32x4 gw[4][2], hw[4][2];
#pragma unroll
            for (int m = 0; m < 4; ++m)
#pragma unroll
                for (int bj = 0; bj < 2; ++bj) { const bf16* p = gp + (size_t)(ai * 128 + m * 16) * 3072 + 128 * bj; gw[m][bj] = *(const u32x4*)p; if (gi != 2) hw[m][bj] = *(const u32x4*)(p + 1024); }
#pragma unroll
            for (int m = 0; m < 4; ++m)
#pragma unroll
                for (int bj = 0; bj < 2; ++bj) { f32x4 ga, gb; unpack8(gw[m][bj], ga, gb);
                    if (gi != 2) { f32x4 ha, hb; unpack8(hw[m][bj], ha, hb);
#pragma unroll
                        for (int e = 0; e < 4; ++e) { ga[e] *= __builtin_amdgcn_rcpf(fmaxf(ha[e], 1e-30f)); gb[e] *= __builtin_amdgcn_rcpf(fmaxf(hb[e], 1e-30f)); }
                        acc[ai][bj][m][0] *= ga; acc[ai][bj][m][1] *= gb; }
                    else *(u32x4*)(mp + (size_t)(ai * 128 + m * 16) * 1024 + 128 * bj) = pack8(acc[ai][bj][m][0] * ga, acc[ai][bj][m][1] * gb); } }
    }
};
struct TriOrder {
    pg8::StaticOrder S;
    __device__ __forceinline__ bool next(int i, Unit& u) const { const int ib = i / 3, gi = i - 3 * ib; if (!S.next(ib, u)) return false; u.ko = (gi == 0) ? 0 : (gi == 1) ? 512 : 768; u.nt = (gi == 0) ? 8 : 4; return true; }
    __device__ __forceinline__ void a_ready(const Unit&) const {}
    __device__ __forceinline__ void done(const Unit&) const {}
};
template <int MODE> struct EpiRes {
    static constexpr bool PERM = true, AFTER_DRAIN = false, KEEP = false;
    const float* xin; float* xout; bf16* xb; float* ssq; bool next;
    __device__ __forceinline__ void operator()(const f32x4 (&acc)[2][2][4][2], const Unit& u, int wr, int wc, int fr, int fq) const {
        const int row0 = u.pm * 256 + wr * 64 + fr, cc0 = wc * 32 + 8 * fq; const size_t off0 = (size_t)row0 * 1024 + u.pn * 256 + cc0;
#pragma unroll
        for (int ai = 0; ai < 2; ++ai) { f32x4 ra[4][2], rb[4][2];
#pragma unroll
            for (int m = 0; m < 4; ++m)
#pragma unroll
                for (int bj = 0; bj < 2; ++bj) { const size_t off = off0 + (size_t)(ai * 128 + m * 16) * 1024 + 128 * bj;
                    if (MODE == 0) { ra[m][bj] = *(const f32x4*)(xin + off); rb[m][bj] = *(const f32x4*)(xin + off + 4); } else unpack8(*(const u32x4*)(xb + off), ra[m][bj], rb[m][bj]); }
#pragma unroll
            for (int m = 0; m < 4; ++m) { const int row = row0 + ai * 128 + m * 16; float ss = 0.f;
#pragma unroll
                for (int bj = 0; bj < 2; ++bj) { const size_t off = off0 + (size_t)(ai * 128 + m * 16) * 1024 + 128 * bj;
                    const f32x4 a = ra[m][bj] + acc[ai][bj][m][0], b = rb[m][bj] + acc[ai][bj][m][1];
                    if (MODE == 1) { *(f32x4*)(xout + off) = a; *(f32x4*)(xout + off + 4) = b; }
                    if (MODE == 0 || next) { *(u32x4*)(xb + off) = pack8(a, b); ss += dot4(a) + dot4(b); } }
                if (MODE == 0 || next) { ss += __shfl_xor(ss, 16); ss += __shfl_xor(ss, 32); if (fq == 0) ssq[(size_t)row * 16 + u.pn * 4 + wc] = ss; } }
            __builtin_amdgcn_sched_barrier(0); }
    }
};
struct EpiUp {
    static constexpr bool PERM = true, AFTER_DRAIN = false, KEEP = false;
    bf16* act; const float* ssq;
    __device__ __forceinline__ void operator()(const f32x4 (&acc)[2][2][4][2], const Unit& u, int wr, int wc, int fr, int fq) const {
        const int row0 = u.pm * 256 + wr * 64 + fr, cc0 = wc * 32 + 8 * fq;
        float rsv[2][4];
#pragma unroll
        for (int ai = 0; ai < 2; ++ai)
#pragma unroll
            for (int m = 0; m < 4; ++m) rsv[ai][m] = row_rstd(ssq, row0 + ai * 128 + m * 16);
#pragma unroll
        for (int ai = 0; ai < 2; ++ai)
#pragma unroll
            for (int m = 0; m < 4; ++m) { const int row = row0 + ai * 128 + m * 16; const float rs = rsv[ai][m];
#pragma unroll
                for (int bj = 0; bj < 2; ++bj) { f32x4 a = acc[ai][bj][m][0] * rs, b = acc[ai][bj][m][1] * rs;
#pragma unroll
                    for (int e = 0; e < 4; ++e) { const float x0 = fmaxf(a[e], 0.f), x1 = fmaxf(b[e], 0.f); a[e] = x0 * x0; b[e] = x1 * x1; }
                    *(u32x4*)(act + (size_t)row * FF + u.pn * 256 + 128 * bj + cc0) = pack8(a, b); } __builtin_amdgcn_sched_barrier(0); }
    }
};
__device__ __forceinline__ void flog_panel(const bf16* xb, const bf16* wf, const float* ssq, const float* bforget, float* flog, int pm, int wave, int lane) {
    typedef short bf16x8_t __attribute__((ext_vector_type(8)));
    const int fr = lane & 15, fq = lane >> 4, r0 = pm * 256 + wave * 32;
    const bf16* a0 = xb + (size_t)(r0 + fr) * D + 8 * fq; const bf16* a1 = a0 + (size_t)16 * D; const bf16* bp = wf + (size_t)fr * D + 8 * fq;
    f32x4 c0 = {0.f, 0.f, 0.f, 0.f}, c1 = c0;
#pragma unroll 8
    for (int ks = 0; ks < D / 32; ++ks) { const bf16x8_t bv = *(const bf16x8_t*)(bp + 32 * ks), x0 = *(const bf16x8_t*)(a0 + 32 * ks), x1 = *(const bf16x8_t*)(a1 + 32 * ks);
        c0 = __builtin_amdgcn_mfma_f32_16x16x32_bf16(bv, x0, c0, 0, 0, 0); c1 = __builtin_amdgcn_mfma_f32_16x16x32_bf16(bv, x1, c1, 0, 0, 0); }
    if (fq < 2) { const f32x4 bb = *(const f32x4*)(bforget + 4 * fq);
        const float rs0 = row_rstd(ssq, r0 + fr), rs1 = row_rstd(ssq, r0 + 16 + fr); f32x4 o0, o1;
#pragma unroll
        for (int e = 0; e < 4; ++e) { o0[e] = logsig(c0[e] * rs0 + bb[e]); o1[e] = logsig(c1[e] * rs1 + bb[e]); }
        *(f32x4*)(flog + (size_t)(r0 + fr) * 8 + 4 * fq) = o0; *(f32x4*)(flog + (size_t)(r0 + 16 + fr) * 8 + 4 * fq) = o1; }
}
struct BatchOrder {
    int nG, nMg, nNg, G, c;
    __device__ __forceinline__ bool next(int i, Unit& u) const { const long L = (long)i * G + c; if (L >= (long)nG * nMg * nNg) return false;
        const int l = (int)L, per = nMg * nNg, g = l / per, r = l % per; u.pm = g * nMg + (r % nMg); u.pn = g * nNg + (r / nMg); return true; }
    __device__ __forceinline__ void a_ready(const Unit&) const {}
    __device__ __forceinline__ void done(const Unit&) const {}
};

#define LDS_WAIT() asm volatile("s_waitcnt lgkmcnt(0)" ::: "memory")
__device__ __forceinline__ float wave_sum(float v) {
#pragma unroll
    for (int o = 1; o < 64; o <<= 1) v += __shfl_xor(v, o);
    return v; }
__device__ __forceinline__ unsigned f2bf(float f) { unsigned u = __builtin_bit_cast(unsigned, f); return (u + 0x7fffu + ((u >> 16) & 1u)) >> 16; }
__device__ __forceinline__ unsigned pk2(float lo, float hi) { return f2bf(lo) | (f2bf(hi) << 16); }
__device__ __forceinline__ int dst_row(int mode, int n) {
    if (mode == 1) {
        if (n < 1024) { const int base = n & ~511, nn = n & 511, h = nn >> 6, d = nn & 63; return base + (h >> 2) * 256 + (d >> 5) * 128 + (h & 3) * 32 + (d & 31); }
        if (n < 1536) return n;
        if (n < 1544) return 5120 + (n - 1536);
        return n - 8; }
    if (mode == 2) { const int hb = n >> 8, nn = n & 255; return (nn >> 7) * 256 + hb * 128 + (nn & 127); }
    return n; }
__device__ __forceinline__ void tr_item(const float* W, int K, int N, bf16* WT, int ldt, int mode, const float* ksc, LAS float* scr, int item, int lane) {
    const int nblk = (N + 31) / 32, kb = item / nblk, nb = item % nblk, k0 = 64 * kb, n0 = 32 * nb; const int nn = n0 + (lane & 31); const bool ok = nn < N;
#pragma unroll 8
    for (int i = 0; i < 32; ++i) { const int kk = 2 * i + (lane >> 5); float w = ok ? W[(size_t)(k0 + kk) * N + nn] : 0.f; if (ksc) w *= ksc[k0 + kk]; scr[kk * 33 + (lane & 31)] = w; }
    LDS_WAIT(); asm volatile("" ::: "memory");
    const int c = lane & 7;
#pragma unroll
    for (int j = 0; j < 4; ++j) { const int n = (lane >> 3) + 8 * j; const LAS float* s = scr + (8 * c) * 33 + n;
        u32x4 o; o.x = pk2(s[0 * 33], s[1 * 33]); o.y = pk2(s[2 * 33], s[3 * 33]); o.z = pk2(s[4 * 33], s[5 * 33]); o.w = pk2(s[6 * 33], s[7 * 33]);
        if (n0 + n < N) *(u32x4*)(WT + (size_t)dst_row(mode, n0 + n) * ldt + k0 + 8 * c) = o; }
    LDS_WAIT(); asm volatile("" ::: "memory");
}
__device__ __forceinline__ void sincos_d(double x, double& s, double& c) {
    const double q = rint(x * 0.6366197723675814); const int n = (int)q;
    double r = fma(-q, 1.5707963267948966, x); r = fma(-q, 6.123233995736766e-17, r);
    const double r2 = r * r;
    const double sp = r * (1.0 + r2 * (-1.0 / 6 + r2 * (1.0 / 120 + r2 * (-1.0 / 5040 + r2 * (1.0 / 362880 + r2 * (-1.0 / 39916800 + r2 * (1.0 / 6227020800.0)))))));
    const double cp = 1.0 + r2 * (-0.5 + r2 * (1.0 / 24 + r2 * (-1.0 / 720 + r2 * (1.0 / 40320 + r2 * (-1.0 / 3628800 + r2 * (1.0 / 479001600 + r2 * (-1.0 / 87178291200.0)))))));
    const int k = n & 3; s = (k == 0) ? sp : (k == 1) ? cp : (k == 2) ? -sp : -cp; c = (k == 0) ? cp : (k == 1) ? -sp : (k == 2) ? -cp : sp; }
__device__ __forceinline__ double exp_small_d(double x) {
    double r = 1.0 / 479001600; r = r * x + 1.0 / 39916800; r = r * x + 1.0 / 3628800; r = r * x + 1.0 / 362880; r = r * x + 1.0 / 40320; r = r * x + 1.0 / 5040; r = r * x + 1.0 / 720;
    r = r * x + 1.0 / 120; r = r * x + 1.0 / 24; r = r * x + 1.0 / 6; r = r * x + 0.5; r = r * x + 1.0; r = r * x + 1.0; return r; }

__device__ __forceinline__ void ssm_gen(const Params& P, int l, int g, LAS unsigned char* lds, int tid) {
    LAS float* Ap = (LAS float*)lds;
    LAS float* Bb = Ap + 33 * 128;
    LAS float* Cc = Bb + 2048;
    LAS float* Kl = Cc + 2048;
    LAS float* Cf = Kl + 8192;
    const float* are = P.in[I_ARE] + (size_t)l * 1024 + g * 64; const float* aim = P.in[I_AIM] + (size_t)l * 1024 + g * 64;
    const float* bre = P.in[I_BRE] + (size_t)l * 16384 + g * 1024; const float* bim = P.in[I_BIM] + (size_t)l * 16384 + g * 1024;
    const float* cre = P.in[I_CRE] + (size_t)l * 16384 + g * 1024; const float* cim = P.in[I_CIM] + (size_t)l * 16384 + g * 1024;
    bf16* Tz = (bf16*)(P.ws + l * WL_STRIDE + WL_TZ) + (size_t)g * 512 * UP; bf16* Me = (bf16*)(P.ws + l * WL_STRIDE + WL_MEND) + (size_t)g * 256 * 512;
    float* DL = (float*)(P.ws + l * WL_STRIDE + WL_DL) + g * 128;
    if (tid < 64) { const int n = tid; const double dt = (double)expf(P.in[I_LDT][l * 16 + g]); const double ar = (double)are[n], ai = (double)aim[n];
        const double mag = exp_small_d(ar * dt); double sn, cs; sincos_d(ai * dt, sn, cs); const double abr = mag * cs, abi = mag * sn, den = ar * ar + ai * ai, nr = abr - 1.0, ni = abi;
        Cf[2 * n] = (float)((nr * ar + ni * ai) / den); Cf[2 * n + 1] = (float)((ni * ar - nr * ai) / den);
        double pr = 1.0, pi = 0.0;
        for (int k = 0; k <= 32; ++k) { Ap[(k * 64 + n) * 2] = (float)pr; Ap[(k * 64 + n) * 2 + 1] = (float)pi; const double t = pr * abr - pi * abi; pi = pr * abi + pi * abr; pr = t; }
        DL[2 * n] = Ap[(32 * 64 + n) * 2]; DL[2 * n + 1] = Ap[(32 * 64 + n) * 2 + 1]; }
    __syncthreads();
    for (int e = tid; e < 1024; e += 512) { const int n = e >> 4; const float cr = Cf[2 * n], ci = Cf[2 * n + 1], br = bre[e], bi = bim[e];
        Bb[2 * e] = cr * br - ci * bi; Bb[2 * e + 1] = cr * bi + ci * br; Cc[2 * e] = cre[e]; Cc[2 * e + 1] = cim[e]; }
    __syncthreads();
    for (int e = tid; e < 8192; e += 512) { const int lag = e >> 8, co = (e >> 4) & 15, ci = e & 15; float s = 0.f;
        for (int n = 0; n < 64; ++n) { const float cr = Cc[(co * 64 + n) * 2], cI = Cc[(co * 64 + n) * 2 + 1], ar = Ap[(lag * 64 + n) * 2], aI = Ap[(lag * 64 + n) * 2 + 1];
            const float car = cr * ar - cI * aI, cai = cr * aI + cI * ar; s += car * Bb[(n * 16 + ci) * 2] - cai * Bb[(n * 16 + ci) * 2 + 1]; }
        Kl[e] = s; }
    __syncthreads();
    for (int ch = tid; ch < 512 * 80; ch += 512) { const int row = ch / 80, cq = ch % 80, t = row >> 4, co = row & 15; float v[8];
        if (cq < 64) { const int j = cq >> 1, ci0 = (cq & 1) * 8;
#pragma unroll
            for (int i = 0; i < 8; ++i) v[i] = (j <= t) ? Kl[(t - j) * 256 + co * 16 + ci0 + i] : 0.f;
        } else { const int n0 = (cq - 64) * 8;
#pragma unroll
            for (int i = 0; i < 8; ++i) { const int nn = n0 + i, n = nn & 63; const float cr = Cc[(co * 64 + n) * 2], cI = Cc[(co * 64 + n) * 2 + 1], ar = Ap[((t + 1) * 64 + n) * 2], aI = Ap[((t + 1) * 64 + n) * 2 + 1];
                v[i] = (nn < 64) ? (cr * ar - cI * aI) : -(cr * aI + cI * ar); } }
        u32x4 o; o.x = pk2(v[0], v[1]); o.y = pk2(v[2], v[3]); o.z = pk2(v[4], v[5]); o.w = pk2(v[6], v[7]); *(u32x4*)(Tz + (size_t)row * UP + cq * 8) = o; }
    for (int ch = tid; ch < 256 * 64; ch += 512) { const int row = ch >> 6, cq = ch & 63, j = cq >> 1, ci0 = (cq & 1) * 8; float v[8];
#pragma unroll
        for (int i = 0; i < 8; ++i) { const int n = row & 63; const float ar = Ap[((31 - j) * 64 + n) * 2], aI = Ap[((31 - j) * 64 + n) * 2 + 1], br = Bb[(n * 16 + ci0 + i) * 2], bI = Bb[(n * 16 + ci0 + i) * 2 + 1];
            v[i] = (row < 64) ? (ar * br - aI * bI) : (row < 128) ? (ar * bI + aI * br) : 0.f; }
        u32x4 o; o.x = pk2(v[0], v[1]); o.y = pk2(v[2], v[3]); o.z = pk2(v[4], v[5]); o.w = pk2(v[6], v[7]); *(u32x4*)(Me + (size_t)row * 512 + cq * 8) = o; }
    __syncthreads();
}
__device__ __forceinline__ void wp_item(const Params& P, int l, int item, int lane) {
    const int kc = item >> 4, nb = item & 15, k0 = kc * 8, g = k0 >> 6, c0 = k0 & 63, n = nb * 64 + lane;
    const float* pw = P.in[I_PW] + (size_t)l * 16384 + g * 4096 + c0 * 64; const float* ps = P.in[I_PS] + l * 256 + g * 64; const float* wb = P.in[I_WBP] + (size_t)l * 262144 + (size_t)(g * 64) * 1024 + n;
    float a[8] = {0, 0, 0, 0, 0, 0, 0, 0};
    for (int d = 0; d < 64; ++d) { const float w = wb[(size_t)d * 1024] * ps[d];
#pragma unroll
        for (int i = 0; i < 8; ++i) a[i] += pw[i * 64 + d] * w; }
    u32x4 o; o.x = pk2(a[0], a[1]); o.y = pk2(a[2], a[3]); o.z = pk2(a[4], a[5]); o.w = pk2(a[6], a[7]);
    *(u32x4*)((bf16*)(P.ws + l * WL_STRIDE + WL_WA) + (size_t)n * 1024 + 768 + k0) = o;
}
__device__ __forceinline__ void prologue(const Params& P, LAS unsigned char* lds, int tid, int lane, int wave, int bx, int G) {
    for (int it = bx; it < NLAYER * 16; it += G) ssm_gen(P, it >> 4, it & 15, lds, tid);
    __syncthreads();
    LAS float* scr = (LAS float*)(lds + wave * 16384);
    const int gw = bx * 8 + wave, NGW = G * 8;
    constexpr int I_IN = 16 * 161, I_A = 8 * 32, I_S = 4 * 32, I_O = 16 * 32, I_U = 16 * 128, I_D = 64 * 32, I_G = 4 * 16, I_P = 512, I_Z = 31, PER = I_IN + I_A + I_S + I_O + I_U + I_D + I_G + I_P + I_Z;
    const int nssm = (G > 2 * NLAYER * 16) ? NLAYER * 16 : 0;
    for (int it = (bx - nssm) * 8 + wave; bx >= nssm && it < NLAYER * PER; it += (G - nssm) * 8) { const int l = it / PER; int r = it % PER; unsigned char* wl = P.ws + l * WL_STRIDE;
        if (r < I_IN) { tr_item(P.in[I_WIN] + (size_t)l * D * INC, D, INC, (bf16*)(wl + WL_WIN), D, 1, P.in[I_MIXN] + l * D, scr, r, lane); continue; } r -= I_IN;
        if (r < I_A) { tr_item(P.in[I_WBA] + (size_t)l * 512 * D, 512, D, (bf16*)(wl + WL_WA), 1024, 0, nullptr, scr, r, lane); continue; } r -= I_A;
        if (r < I_S) { tr_item(P.in[I_WBS] + (size_t)l * 256 * D, 256, D, (bf16*)(wl + WL_WA) + 512, 1024, 0, nullptr, scr, r, lane); continue; } r -= I_S;
        if (r < I_O) { tr_item(P.in[I_WOUT] + (size_t)l * D * D, D, D, (bf16*)(wl + WL_WOUT), D, 0, nullptr, scr, r, lane); continue; } r -= I_O;
        if (r < I_U) { tr_item(P.in[I_WUP] + (size_t)l * D * FF, D, FF, (bf16*)(wl + WL_WUP), D, 0, P.in[I_MLPN] + l * D, scr, r, lane); continue; } r -= I_U;
        if (r < I_D) { tr_item(P.in[I_WDN] + (size_t)l * FF * D, FF, D, (bf16*)(wl + WL_WDN), FF, 0, nullptr, scr, r, lane); continue; } r -= I_D;
        if (r < I_G) { tr_item(P.in[I_WGLU] + (size_t)l * 256 * 512, 256, 512, (bf16*)(wl + WL_WGLU), 256, 2, nullptr, scr, r, lane); continue; } r -= I_G;
        if (r < I_P) { wp_item(P, l, r, lane); continue; } r -= I_P;
        { u32x4* z = (u32x4*)((bf16*)(wl + WL_WIN) + (size_t)(5128 + 8 * r) * D) + lane; const u32x4 zero = {0u, 0u, 0u, 0u};
#pragma unroll
          for (int i = 0; i < 16; ++i) z[64 * i] = zero; }
    }
    const float* x = P.in[I_X]; bf16* xb = (bf16*)(P.ws + WS_XB); float* ssq = (float*)(P.ws + WS_SSQ);
    for (int m0 = gw * 4; m0 < T; m0 += NGW * 4) {
        f32x4 v[4][4]; float sq[4];
#pragma unroll
        for (int r = 0; r < 4; ++r) { const f32x4* xr = (const f32x4*)(x + (size_t)(m0 + r) * D) + lane;
#pragma unroll
            for (int j = 0; j < 4; ++j) v[r][j] = xr[64 * j]; }
#pragma unroll
        for (int r = 0; r < 4; ++r) { float s = 0.f;
#pragma unroll
            for (int j = 0; j < 4; ++j) s += dot4(v[r][j]);
            sq[r] = wave_sum(s); }
#pragma unroll
        for (int r = 0; r < 4; ++r) { u32x2* o = (u32x2*)(xb + (size_t)(m0 + r) * D) + lane;
#pragma unroll
            for (int j = 0; j < 4; ++j) { u32x2 w; w.x = cvt_pk_bf16(v[r][j][0], v[r][j][1]); w.y = cvt_pk_bf16(v[r][j][2], v[r][j][3]); o[64 * j] = w; }
            if (lane < 16) ssq[(size_t)(m0 + r) * 16 + lane] = (lane == 0) ? sq[r] : 0.f; } }
}
__device__ __forceinline__ void fcum_seq(const float* flog, float* kb, int sq, LAS unsigned char* lds, int tid, int lane, int wave) {
    const int b = sq >> 3, h = sq & 7; LAS float* wt = (LAS float*)lds;
    float v[8]; float run = 0.f;
#pragma unroll
    for (int i = 0; i < 8; ++i) { run += flog[((size_t)b * SEQ + tid * 8 + i) * 8 + h]; v[i] = run; }
    float inc = run;
#pragma unroll
    for (int o = 1; o < 64; o <<= 1) { const float t = __shfl_up(inc, o); if (lane >= o) inc += t; }
    if (lane == 63) wt[wave] = inc;
    __syncthreads();
    float off = inc - run;
    for (int w = 0; w < wave; ++w) off += wt[w];
#pragma unroll
    for (int i = 0; i < 8; ++i) kb[(size_t)sq * SEQ + tid * 8 + i] = -LOG2E * (off + v[i]);
    __syncthreads();
}
template <int W> __device__ __forceinline__ void pool_item(const bf16* up, bf16* acat, int tok, int ch0) {
    const int s = tok & (SEQ - 1); f32x4 sa = {0.f, 0.f, 0.f, 0.f}, sb = sa, ca = sa, cb = sa; u32x4 r[W];
#pragma unroll
    for (int j = 0; j < W; ++j) r[j] = (j <= s) ? *(const u32x4*)(up + (size_t)(tok - ((j <= s) ? j : 0)) * 256 + ch0) : (u32x4){0u, 0u, 0u, 0u};
#pragma unroll
    for (int j = 0; j < W; ++j) { f32x4 a, b; unpack8(r[j], a, b); if (j == 0) { ca = a; cb = b; } sa += a; sb += b; }
    const float inv = 1.0f / (float)((s + 1 < W) ? s + 1 : W);
    *(u32x4*)(acat + (size_t)tok * 1024 + 768 + ch0) = pack8(sa * inv - ca, sb * inv - cb);
}
__device__ __forceinline__ void pool_pass(const bf16* up, bf16* acat, int gwave, int nwaves, int lane) {
    for (int wi = gwave; wi < (T / 8) * 4; wi += nwaves) { const int g = wi & 3, tok = (wi >> 2) * 8 + (lane >> 3), ch0 = g * 64 + (lane & 7) * 8;
        if (g == 0) pool_item<2>(up, acat, tok, ch0); else if (g == 1) pool_item<4>(up, acat, tok, ch0); else if (g == 2) pool_item<8>(up, acat, tok, ch0); else pool_item<16>(up, acat, tok, ch0); }
}
__device__ __forceinline__ void state_scan(const float* S, const float* DL, bf16* U, int gid) {
    const int g = gid >> 10, b = (gid >> 6) & 15, n = gid & 63; const float dr = DL[g * 128 + 2 * n], di = DL[g * 128 + 2 * n + 1];
    float xr = 0.f, xi = 0.f; const size_t r0 = (size_t)g * 2048 + b * 128;
#pragma unroll 8
    for (int c = 0; c < 128; ++c) { const float sr = S[(r0 + c) * 128 + n], si = S[(r0 + c) * 128 + 64 + n];
        U[(r0 + c) * UP + 512 + n] = (bf16)f2bf(xr); U[(r0 + c) * UP + 576 + n] = (bf16)f2bf(xi);
        const float t = dr * xr - di * xi + sr; xi = dr * xi + di * xr + si; xr = t; }
}

#define XB_TMO      128
#define XB_XCNT(j)  (256  + 64 * (j))
#define XB_XSUB(j)  (1280 + 64 * (j))
#define XB_XGEN(j)  (2304 + 64 * (j))
#define XB_TOP      3328
#define XB_TOPGEN   3392
#define XCD_BAR_WORDS 3456
#define XB_SPIN_CAP (1u << 18)

__device__ __forceinline__ unsigned xb_ld(unsigned* p)              { return __hip_atomic_load(p, __ATOMIC_RELAXED, __HIP_MEMORY_SCOPE_AGENT); }
__device__ __forceinline__ unsigned xb_add(unsigned* p, unsigned v) { return __hip_atomic_fetch_add(p, v, __ATOMIC_RELAXED, __HIP_MEMORY_SCOPE_AGENT); }
__device__ __forceinline__ unsigned xb_xcc_id() { return (unsigned)__builtin_amdgcn_s_getreg((3 << 11) | 20) & 0xFu; }
#define XB_SPIN(cond, bar) do { unsigned _sp = 0; while (cond) { __builtin_amdgcn_s_sleep(1); \
    if ((++_sp & 255u) == 0u) { if (xb_ld(&(bar)[XB_TMO])) break; if (_sp > XB_SPIN_CAP) { atomicAdd(&(bar)[XB_TMO], 1u); break; } } } } while (0)

struct XcdBarrier {
    unsigned* bar; unsigned x;
    volatile LAS unsigned* st;
};

__device__ __forceinline__ XcdBarrier xcd_barrier_post(unsigned* bar, volatile LAS unsigned* st) {
    XcdBarrier b; b.bar = bar; b.x = xb_xcc_id(); b.st = st;
    if (threadIdx.x == 0) (void)xb_add(&bar[XB_XCNT(b.x)], 1u);
    return b;
}
__device__ __forceinline__ void xcd_barrier_complete(unsigned* bar, unsigned x, unsigned& nloc, unsigned& nx) {
    const unsigned G = gridDim.x * gridDim.y * gridDim.z;
    unsigned sum, cnt, mine, sp = 0u;
    for (;;) {
        sum = 0u; cnt = 0u; mine = 0u;
#pragma unroll
        for (unsigned j = 0; j < 16; ++j) { const unsigned c = xb_ld(&bar[XB_XCNT(j)]); sum += c; cnt += (c > 0u) ? 1u : 0u; mine = (j == x) ? c : mine; }
        if (sum == G) break;
        __builtin_amdgcn_s_sleep(1);
        if ((++sp & 255u) == 0u) { if (xb_ld(&bar[XB_TMO])) break; if (sp > XB_SPIN_CAP) { atomicAdd(&bar[XB_TMO], 1u); break; } }
    }
    nloc = mine > 0u ? mine : 1u; nx = cnt > 0u ? cnt : 1u;
}

__device__ __forceinline__ void xcd_barrier(const XcdBarrier& b) {
    asm volatile("s_waitcnt vmcnt(0)" ::: "memory");
    __syncthreads();
    if (threadIdx.x == 0) {
        unsigned* bar = b.bar;
        __builtin_amdgcn_s_waitcnt(0);
        unsigned nloc = b.st[0], nx = b.st[1];
        if (nloc == 0u) { xcd_barrier_complete(bar, b.x, nloc, nx); b.st[0] = nloc; b.st[1] = nx; }
        const unsigned old = xb_add(&bar[XB_XSUB(b.x)], 1u);
        const unsigned gen = old / nloc;
        if (old + 1u == (gen + 1u) * nloc) {
            __builtin_amdgcn_fence(__ATOMIC_RELEASE, "agent");
            asm volatile("s_waitcnt vmcnt(0)" ::: "memory");
            const unsigned og = xb_add(&bar[XB_TOP], 1u);
            const unsigned tg = og / nx;
            if (og + 1u == (tg + 1u) * nx) xb_add(&bar[XB_TOPGEN], 1u);
            else XB_SPIN(xb_ld(&bar[XB_TOPGEN]) == tg, bar);
            __builtin_amdgcn_fence(__ATOMIC_ACQUIRE, "agent");
            xb_add(&bar[XB_XGEN(b.x)], 1u);
            asm volatile("s_waitcnt vmcnt(0)" ::: "memory");
        } else {
            XB_SPIN(xb_ld(&bar[XB_XGEN(b.x)]) == gen, bar);
            __builtin_amdgcn_fence(__ATOMIC_ACQUIRE, "agent");
            asm volatile("s_waitcnt vmcnt(0)" ::: "memory");
        }
    }
    __syncthreads();
}

constexpr size_t WS_BAR = 1000 * MiB;
#define GB_CNT(g) (4096 + 64 * (g))
__device__ __forceinline__ void group_barrier(unsigned* bar, volatile LAS unsigned* st, unsigned grp, unsigned nloc) {
    asm volatile("s_waitcnt vmcnt(0)" ::: "memory");
    __syncthreads();
    if (threadIdx.x == 0) {
        const unsigned k = st[2] + 1u; st[2] = k;
        __builtin_amdgcn_fence(__ATOMIC_RELEASE, "agent");
        asm volatile("s_waitcnt vmcnt(0)" ::: "memory");
        (void)xb_add(&bar[GB_CNT(grp)], 1u);
        const unsigned target = k * nloc;
        XB_SPIN(xb_ld(&bar[GB_CNT(grp)]) < target, bar);
        __builtin_amdgcn_fence(__ATOMIC_ACQUIRE, "agent");
        asm volatile("s_waitcnt vmcnt(0)" ::: "memory");
    }
    __syncthreads();
}
constexpr int LDS_BARST = 131072 + 1024;
#ifndef PHM
#define PHM 0x3ff
#endif
#ifndef PROBE
#define PROBE 0
#endif
typedef const __attribute__((address_space(4))) Params* KArgP;
__global__ void __launch_bounds__(512, 2) fwd_kernel(Params P) {
    extern __shared__ __attribute__((aligned(16))) unsigned char lds_raw[];
    cg::grid_group grid = cg::this_grid();
    LAS unsigned char* lds = (LAS unsigned char*)lds_raw;
    const int ph_lo = P.ph_lo, ph_hi = P.ph_hi;
    if (threadIdx.x < 4) ((volatile LAS unsigned*)(lds + LDS_BARST))[threadIdx.x] = 0u;
    __syncthreads();
#define PH_BEGIN() int tid = threadIdx.x; asm volatile("" : "+v"(tid)); const int lane = tid & 63, wave = __builtin_amdgcn_readfirstlane(tid >> 6); (void)lane; (void)wave; \
    KArgP pk = (KArgP)__builtin_amdgcn_kernarg_segment_ptr(); asm volatile("" : "+s"(pk)); unsigned char* const ws = pk->ws; unsigned char* const wl = ws + l * WL_STRIDE; (void)wl; \
    const int G = gridDim.x, bx = blockIdx.x; (void)G; (void)bx
#define RUN(k) (ph_lo <= (k) && (k) < ph_hi)
#define EN(j) ((PHM >> (j)) & 1)
#ifndef REP
#define REP 0
#endif
#define REPL(j) _Pragma("unroll 1") for (int rep_ = (((REP) >> (j)) & 1) ? 0 : 1; rep_ < 2; ++rep_)
#define STAMP(i) do { if (PROBE && blockIdx.x == 0 && threadIdx.x == 0) { KArgP pq = (KArgP)__builtin_amdgcn_kernarg_segment_ptr(); asm volatile("" : "+s"(pq)); ((unsigned long long*)(pq->ws + WS_DBG))[i] = __builtin_amdgcn_s_memrealtime(); } } while (0)
#define SEAM(k) do { if (RUN(k) && RUN((k) + 1)) { if ((k) == 0) { grid.sync(); KArgP pb = (KArgP)__builtin_amdgcn_kernarg_segment_ptr(); asm volatile("" : "+s"(pb)); (void)xcd_barrier_post((unsigned*)(pb->ws + WS_BAR), (volatile LAS unsigned*)(lds + LDS_BARST)); } \
        else { KArgP pb = (KArgP)__builtin_amdgcn_kernarg_segment_ptr(); asm volatile("" : "+s"(pb)); XcdBarrier xb_; xb_.bar = (unsigned*)(pb->ws + WS_BAR); xb_.x = xb_xcc_id(); xb_.st = (volatile LAS unsigned*)(lds + LDS_BARST); xcd_barrier(xb_); } } STAMP((k) + 1); } while (0)
#define WSP(T_, off) ((T_*)(ws + (off)))
#ifndef LOCAL_SEAMS
#define LOCAL_SEAMS 0
#endif
#define SEAM_L(k) do { if (LOCAL_SEAMS && (gridDim.x % 8u) == 0u) { if (RUN(k) && RUN((k) + 1)) { KArgP pb = (KArgP)__builtin_amdgcn_kernarg_segment_ptr(); asm volatile("" : "+s"(pb)); \
        group_barrier((unsigned*)(pb->ws + WS_BAR), (volatile LAS unsigned*)(lds + LDS_BARST), blockIdx.x % 8u, gridDim.x / 8u); } STAMP((k) + 1); } else SEAM(k); } while (0)
    STAMP(0);
#ifdef EXTRA_SYNC
    if (ph_hi - ph_lo > 1) { _Pragma("unroll 1") for (int i_ = 0; i_ < EXTRA_SYNC; ++i_) grid.sync(); }
#endif
    if (RUN(0) && EN(0)) { const int l = 0; PH_BEGIN(); if (bx == 0) { for (int i = tid; i < 8192 + 256; i += 512) ((unsigned*)(ws + WS_BAR))[i] = 0u;   } const Params& Pc = *(const Params*)pk; prologue(Pc, lds, tid, lane, wave, bx, G); }
    SEAM(0);
#pragma unroll 1
    for (int l = 0; l < NLAYER; ++l) {
        const int p0 = 1 + 9 * l;
        if (RUN(p0) && EN(1)) REPL(1) {
            PH_BEGIN();
            pg8::Gemm g{WSP(bf16, WS_XB), (const bf16*)(wl + WL_WIN), T, 5120, D, D, D}; pg8::StaticOrder S; S.init(T, 5120, G, bx);
            EpiIn E{WSP(bf16, WS_Q), WSP(bf16, WS_K), WSP(bf16, WS_V), WSP(bf16, WS_U), WSP(bf16, WS_UPOOL), WSP(bf16, WS_GATES), WSP(float, WS_FLOG), WSP(float, WS_SSQ),
                    pk->in[I_QN] + l * 64, pk->in[I_KN] + l * 64, pk->in[I_BG] + l * 3072, pk->in[I_BF] + l * 8};
            pg8::gemm_phase<EpiIn, pg8::StaticOrder, true, true>(lds, g, S, E);
            for (int pm = bx; pm < T / 256; pm += G) flog_panel(WSP(bf16, WS_XB), (const bf16*)(wl + WL_WIN) + (size_t)5120 * D, WSP(float, WS_SSQ), pk->in[I_BF] + l * 8, WSP(float, WS_FLOG), pm, wave, lane); }
        SEAM(p0);
        if (RUN(p0 + 1) && EN(2)) REPL(2) {
            PH_BEGIN();
            for (int sq = bx; sq < NB * 8; sq += G) fcum_seq(WSP(float, WS_FLOG), WSP(float, WS_KB), sq, lds, tid, lane, wave);
            pool_pass(WSP(bf16, WS_UPOOL), WSP(bf16, WS_ACAT), bx * 8 + wave, G * 8, lane);
            __syncthreads();
            pg8::Gemm g{WSP(bf16, WS_U), (const bf16*)(wl + WL_MEND), 16 * 2048, 16 * 256, 512, UP, 512}; BatchOrder S{16, 8, 1, G, bx};
            EpiSend E{WSP(float, WS_S)};
            pg8::gemm_phase<EpiSend, BatchOrder, true, true>(lds, g, S, E); }
        SEAM(p0 + 1);
        if (RUN(p0 + 2) && EN(3)) {
            { PH_BEGIN();
              for (int gid = bx * 512 + tid; gid < 16384; gid += G * 512) state_scan(WSP(float, WS_S), (const float*)(wl + WL_DL), WSP(bf16, WS_U), gid);
              __syncthreads(); }
            { PH_BEGIN();
              float sb; { const float qa = fabsf(pk->in[I_QN][l * 64 + lane]), ka = fabsf(pk->in[I_KN][l * 64 + lane]); float qm = qa, km = ka;
#pragma unroll
                  for (int o = 1; o < 64; o <<= 1) { qm = fmaxf(qm, __shfl_xor(qm, o)); km = fmaxf(km, __shfl_xor(km, o)); }
                  sb = __uint_as_float(__builtin_amdgcn_readfirstlane(__float_as_uint(64.0f * C2Q * qm * km * 1.02f + 1.0f))); }
              const attn_body::AttnTensors AT{WSP(const attn_body::bf16, WS_Q), WSP(const attn_body::bf16, WS_K), WSP(const attn_body::bf16, WS_V), WSP(attn_body::bf16, WS_ACAT), WSP(const float, WS_KB)};
              attn_body::attn_phase<8>((char*)lds_raw, AT, sb, (unsigned*)(ws + WS_BAR) + 8192 + 64 * l, bx, G); } }
        SEAM(p0 + 2);
        if (RUN(p0 + 3) && EN(4)) REPL(4) {
            PH_BEGIN();
            pg8::Gemm g{WSP(bf16, WS_U), (const bf16*)(wl + WL_TZ), 16 * 2048, 16 * 512, UP, UP, UP}; BatchOrder S{16, 8, 2, G, bx};
            EpiSsmY E{WSP(bf16, WS_U), pk->in[I_SD] + l * 256, WSP(bf16, WS_YPRE)};
            pg8::gemm_phase<EpiSsmY, BatchOrder, true, true>(lds, g, S, E); }
        SEAM(p0 + 3);
        if (RUN(p0 + 4) && EN(5)) REPL(5) {
            PH_BEGIN();
            pg8::Gemm g{WSP(bf16, WS_YPRE), (const bf16*)(wl + WL_WGLU), T, 512, 256, 256, 256}; pg8::StaticOrder S; S.init(T, 512, G, bx);
            EpiGlu E{WSP(bf16, WS_ACAT)};
            pg8::gemm_phase<EpiGlu, pg8::StaticOrder, true, true>(lds, g, S, E); }
        SEAM_L(p0 + 4);
        if (RUN(p0 + 5) && EN(6)) REPL(6) {
            PH_BEGIN(); TriOrder S; S.S.init(T, D, G, bx);
            pg8::Gemm g{WSP(bf16, WS_ACAT), (const bf16*)(wl + WL_WA), T, D, 512, 1024, 1024}; EpiGate3 E{WSP(bf16, WS_GATES), WSP(bf16, WS_MERGED)};
            pg8::gemm_phase<EpiGate3, TriOrder, true, true>(lds, g, S, E); }
        SEAM_L(p0 + 5);
        if (RUN(p0 + 6) && EN(7)) REPL(7) {
            PH_BEGIN();
            pg8::Gemm g{WSP(bf16, WS_MERGED), (const bf16*)(wl + WL_WOUT), T, D, D, D, D}; pg8::StaticOrder S; S.init(T, D, G, bx);
            EpiRes<0> E{(l == 0) ? pk->in[I_X] : (const float*)pk->out, nullptr, WSP(bf16, WS_XB), WSP(float, WS_SSQ), true};
            pg8::gemm_phase<EpiRes<0>, pg8::StaticOrder, true, true>(lds, g, S, E); }
        SEAM_L(p0 + 6);
        if (RUN(p0 + 7) && EN(8)) REPL(8) {
            PH_BEGIN();
            pg8::Gemm g{WSP(bf16, WS_XB), (const bf16*)(wl + WL_WUP), T, FF, D, D, D}; pg8::StaticOrder S; S.init(T, FF, G, bx);
            EpiUp E{WSP(bf16, WS_ACT), WSP(float, WS_SSQ)};
            pg8::gemm_phase<EpiUp, pg8::StaticOrder, true, true>(lds, g, S, E); }
        SEAM_L(p0 + 7);
        if (RUN(p0 + 8) && EN(9)) REPL(9) {
            PH_BEGIN();
            pg8::Gemm g{WSP(bf16, WS_ACT), (const bf16*)(wl + WL_WDN), T, D, FF, FF, FF}; pg8::StaticOrder S; S.init(T, D, G, bx);
            EpiRes<1> E{nullptr, pk->out, WSP(bf16, WS_XB), WSP(float, WS_SSQ), l + 1 < NLAYER};
            pg8::gemm_phase<EpiRes<1>, pg8::StaticOrder, true, true>(lds, g, S, E); }
        SEAM(p0 + 8);
    }
#if PROBE
    grid.sync(); STAMP(N_PHASES_);
    if (blockIdx.x == 0) { KArgP pq = (KArgP)__builtin_amdgcn_kernarg_segment_ptr(); const unsigned long long* ts = (const unsigned long long*)(pq->ws + WS_DBG); float* out = pq->out;
        if (threadIdx.x == 0) out[0] = (float)(ts[PROBE_A1] - ts[PROBE_A0]) * 0.0025f; }
#endif
#undef RUN
#undef SEAM
}
constexpr int N_PHASES = 1 + 9 * NLAYER;

#ifndef MK_PER_PHASE
#define MK_PER_PHASE 0
#endif
extern "C" void kernel_launch(void* const* d_in, const int* in_sizes, int n_in, void* d_out, int out_size, void* d_ws, size_t ws_size, hipStream_t stream) {
    static int grid = 0;
    if (grid == 0) {
        if (n_in != N_IN || in_sizes[0] != T * D || out_size != T * D || ws_size < WS_END) { fprintf(stderr, "kernel_launch: unexpected shapes (n_in %d, in0 %d, out %d, ws %zu)\n", n_in, n_in > 0 ? in_sizes[0] : -1, out_size, ws_size); grid = -1; return; }
        int dev = 0, cus = 0, per_cu = 0;
        if (hipGetDevice(&dev) != hipSuccess || hipDeviceGetAttribute(&cus, hipDeviceAttributeMultiprocessorCount, dev) != hipSuccess) { grid = -1; return; }
        if (hipFuncSetAttribute((const void*)fwd_kernel, hipFuncAttributeMaxDynamicSharedMemorySize, LDS_BYTES) != hipSuccess) { fprintf(stderr, "kernel_launch: hipFuncSetAttribute failed\n"); grid = -1; return; }
        if (hipOccupancyMaxActiveBlocksPerMultiprocessor(&per_cu, (const void*)fwd_kernel, 512, LDS_BYTES) != hipSuccess || per_cu < 1) { fprintf(stderr, "kernel_launch: occupancy query says %d\n", per_cu); per_cu = 1; }
        (void)hipGetLastError();
        grid = cus;
    }
    if (grid < 0) return;
    Params p{};
    for (int i = 0; i < N_IN; ++i) p.in[i] = (const float*)d_in[i];
    p.out = (float*)d_out; p.ws = (unsigned char*)d_ws; p.dbg = 0; p.pad = 0;
#if MK_PER_PHASE
    for (int k = 0; k < N_PHASES; ++k) { p.ph_lo = k; p.ph_hi = k + 1; hipLaunchKernelGGL(fwd_kernel, dim3(grid), dim3(512), LDS_BYTES, stream, p); }
#else
    p.ph_lo = 0; p.ph_hi = N_PHASES;
    void* args[] = {&p};
    const hipError_t e = hipLaunchCooperativeKernel((const void*)fwd_kernel, dim3(grid), dim3(512), args, LDS_BYTES, stream);
    if (e != hipSuccess) fprintf(stderr, "kernel_launch: cooperative launch failed: %s (grid %d)\n", hipGetErrorString(e), grid);
#endif
}
```

```cpp
#include <hip/hip_runtime.h>
#include <hip/hip_cooperative_groups.h>
#include <cstdio>
#include <cstdint>
namespace pg8 {
#define PG8_LAS __attribute__((address_space(3)))
typedef unsigned short bf16_t;
typedef short bf16x8 __attribute__((ext_vector_type(8)));
typedef float f32x4 __attribute__((ext_vector_type(4)));
typedef unsigned u32x4 __attribute__((ext_vector_type(4)));
constexpr int BM = 256, BK = 64, HALF = 128, HTB = HALF * BK * 2  , STAGE_BYTES = 8 * HTB, NXCD = 8, WGM = 8;

__host__ __device__ __forceinline__ int lds_byte(int r, int c) { const int st = (r >> 4) * 2 + (c >> 5), rr = r & 15, cc = c & 31, ob = rr * 64 + cc * 2; return st * 1024 + (ob ^ (((ob >> 9) & 1) << 5)); }
__host__ __device__ __forceinline__ void stage_rc(int b, int& R, int& C) { const int st = b / 1024, sb = b % 1024, swz = sb ^ (((sb >> 9) & 1) << 5); R = (st >> 1) * 16 + swz / 64; C = (st & 1) * 32 + (swz % 64) / 2; }
__host__ __device__ __forceinline__ int perm32(int rho) { const int n = rho >> 4, i = rho & 15; return 8 * (i >> 2) + 4 * n + (i & 3); }

struct Unit { int pm, pn, ko = 0, nt = 0; };
struct Gemm { const bf16_t* A; const bf16_t* Bt; int M, N, K, lda, ldb; };

struct StaticOrder {
    int nM, nN, nwg, G, c;
    __host__ __device__ void init(int M, int N, int G_, int c_) { nM = M / BM; nN = N / BM; nwg = nM * nN; G = G_; c = c_; }
    __host__ __device__ bool next(int i, Unit& u) const {
        const long L = (long)i * G + c; if (L >= nwg) return false;
        int wgid = (int)L; { const int q = nwg / NXCD, r = nwg % NXCD, xcd = wgid % NXCD, off = wgid / NXCD; wgid = (xcd < r ? xcd * (q + 1) : r * (q + 1) + (xcd - r) * q) + off; }
        const int nig = WGM * nN, gid = wgid / nig, fm = gid * WGM, gsz = (nM - fm) < WGM ? (nM - fm) : WGM;
        u.pm = fm + ((wgid % nig) % gsz); u.pn = (wgid % nig) / gsz; return true;
    }
    __device__ __forceinline__ void a_ready(const Unit&) const {}
    __device__ __forceinline__ void done(const Unit&) const {}
};

typedef float f32x2c_t __attribute__((ext_vector_type(2))); typedef __bf16 bf16x2c_t __attribute__((ext_vector_type(2)));
__device__ __forceinline__ unsigned cvt_pk_bf16(float lo, float hi) { const f32x2c_t v = {lo, hi}; const bf16x2c_t b = __builtin_convertvector(v, bf16x2c_t); return __builtin_bit_cast(unsigned, b); }
typedef float f32x2 __attribute__((ext_vector_type(2)));
__device__ __forceinline__ f32x2 gelu_pk(f32x2 v) {
    const f32x2 av = __builtin_elementwise_abs(v), d = av * 0.2316418882f + 1.0f;
    f32x2 t; t.x = __builtin_amdgcn_rcpf(d.x); t.y = __builtin_amdgcn_rcpf(d.y);
    f32x2 q = t * 0.5307027145f + (-0.7265760135f); q = q * t + 0.7107068705f; q = q * t + (-0.142248368f); q = q * t + 0.127414796f; q = q * t;
    const f32x2 s = (v * v) * (-0.72134752044f);
    f32x2 e; e.x = __builtin_amdgcn_exp2f(s.x); e.y = __builtin_amdgcn_exp2f(s.y);
    const f32x2 m = v * (q * e), r = v - m;
    f32x2 o; o.x = v.x < 0.f ? m.x : r.x; o.y = v.y < 0.f ? m.y : r.y; return o;
}

template <int ACT  > struct EpiBf16 {
    static constexpr bool PERM = true, AFTER_DRAIN = false, KEEP = false; static_assert(ACT == 0 || ACT == 1, "EpiBf16: ACT is 0 (none) or 1 (gelu_pk)");
    bf16_t* O; int ldc; const float* bias; int split_cols; size_t split_stride; float scale0;
    __device__ __forceinline__ void operator()(const f32x4 (&acc)[2][2][4][2], const Unit& u, int wr, int wc, int fr, int fq) const {
        const int row0 = u.pm * BM + wr * 64 + fr; int colt = u.pn * BM; bf16_t* base = O;
        float sc = 1.f; if (split_cols) { const int t = colt / split_cols; base += (size_t)t * split_stride; colt -= t * split_cols; if (t == 0) sc = scale0; }
        const int col0 = colt + wc * 32 + 8 * fq, bcol0 = u.pn * BM + wc * 32 + 8 * fq;
        f32x4 bv[2][2];
#pragma unroll
        for (int bj = 0; bj < 2; ++bj)
#pragma unroll
            for (int n = 0; n < 2; ++n) bv[bj][n] = bias ? *(const f32x4*)(bias + bcol0 + bj * HALF + 4 * n) : (f32x4){0.f, 0.f, 0.f, 0.f};
#pragma unroll
        for (int ai = 0; ai < 2; ++ai)
#pragma unroll
            for (int m = 0; m < 4; ++m) { bf16_t* rowp = base + (size_t)(row0 + ai * HALF + m * 16) * ldc + col0;
#pragma unroll
                for (int bj = 0; bj < 2; ++bj) { f32x4 v0 = acc[ai][bj][m][0] + bv[bj][0], v1 = acc[ai][bj][m][1] + bv[bj][1];
                    if (ACT == 1) { f32x2 a = gelu_pk((f32x2){v0[0], v0[1]}), b = gelu_pk((f32x2){v0[2], v0[3]}), c = gelu_pk((f32x2){v1[0], v1[1]}), d = gelu_pk((f32x2){v1[2], v1[3]});
                        v0 = (f32x4){a.x, a.y, b.x, b.y}; v1 = (f32x4){c.x, c.y, d.x, d.y}; }
                    v0 = v0 * sc; v1 = v1 * sc; u32x4 w; w.x = cvt_pk_bf16(v0[0], v0[1]); w.y = cvt_pk_bf16(v0[2], v0[3]); w.z = cvt_pk_bf16(v1[0], v1[1]); w.w = cvt_pk_bf16(v1[2], v1[3]);
                    *(u32x4*)(rowp + bj * HALF) = w; } }
    }
};


template <class Epi, class Sched, bool ALIGN_EPI = false, bool SP2 = false>
__device__ __forceinline__ void gemm_phase(PG8_LAS unsigned char* lds, const Gemm g, const Sched& S, const Epi& E) {
    int tid_l = threadIdx.x; asm volatile("" : "+v"(tid_l));
    const int tid = tid_l, wid = __builtin_amdgcn_readfirstlane(tid >> 6), lane = tid & 63, wr = wid >> 2, wc = wid & 3, fr = lane & 15, fq = lane >> 4;
    const int K = g.K, nt = K / BK;
    unsigned voffA[2], voffB[2];
#pragma unroll
    for (int i = 0; i < 2; ++i) { int R, C; stage_rc(tid * 16 + i * 8192, R, C); const int Rb = Epi::PERM ? ((R & ~31) + perm32(R & 31)) : R;
        voffA[i] = (unsigned)(R * g.lda + C) * 2u; voffB[i] = (unsigned)(Rb * g.ldb + C) * 2u; }
    const size_t kstep = (size_t)(BK * 2);
    const size_t hstepA = (size_t)HALF * g.lda * 2, hstepB = (size_t)HALF * g.ldb * 2;
    const size_t tstepA = 2 * hstepA, tstepB = 2 * hstepB;
    const unsigned ldsw = (unsigned)wid * 1024u;
    const int aoff = lds_byte(wr * 64 + fr, fq * 8), boff = lds_byte(wc * 32 + fr, fq * 8);
#define PG8_SA(b, h) (((b) * 2 + (h)) * HTB)
#define PG8_SB(b, h) ((4 + (b) * 2 + (h)) * HTB)
#define PG8_STAGE(bufoff, gbase, voff) do { _Pragma("unroll") for (int _i = 0; _i < 2; ++_i) \
        __builtin_amdgcn_global_load_lds((const unsigned*)((const char*)(gbase) + (voff)[_i]), (PG8_LAS unsigned*)(lds + (bufoff) + ldsw + _i * 8192), 16, 0, 0); } while (0)
#define PG8_LDA(dst, b, h) do { _Pragma("unroll") for (int m = 0; m < 4; ++m) _Pragma("unroll") for (int k = 0; k < 2; ++k) dst[m][k] = *(const PG8_LAS bf16x8*)(lds + PG8_SA(b, h) + aoff + m * 2048 + k * 1024); } while (0)
#define PG8_LDB(dst, b, h) do { _Pragma("unroll") for (int n = 0; n < 2; ++n) _Pragma("unroll") for (int k = 0; k < 2; ++k) dst[n][k] = *(const PG8_LAS bf16x8*)(lds + PG8_SB(b, h) + boff + n * 2048 + k * 1024); } while (0)
#define PG8_MMA(ai, bj, At, Bt) do { __builtin_amdgcn_s_setprio(1); _Pragma("unroll") for (int m = 0; m < 4; ++m) _Pragma("unroll") for (int n = 0; n < 2; ++n) _Pragma("unroll") for (int k = 0; k < 2; ++k) \
        acc[ai][bj][m][n] = __builtin_amdgcn_mfma_f32_16x16x32_bf16(Bt[n][k], At[m][k], acc[ai][bj][m][n], 0, 0, 0); __builtin_amdgcn_s_setprio(0); } while (0)
#define PG8_WAIT_V(n) asm volatile("s_waitcnt vmcnt(" #n ")" ::: "memory")
#define PG8_WAIT_L(n) asm volatile("s_waitcnt lgkmcnt(" #n ")" ::: "memory")
#define PG8_BAR __builtin_amdgcn_s_barrier()
#define PG8_SCHED __builtin_amdgcn_sched_barrier(0)
    Unit cur, nxt; int ui = 0;
    if (!S.next(0, cur)) return;
    f32x4 acc[2][2][4][2];
#pragma unroll
    for (int a = 0; a < 2; ++a)
#pragma unroll
        for (int b = 0; b < 2; ++b)
#pragma unroll
            for (int m = 0; m < 4; ++m)
#pragma unroll
                for (int n = 0; n < 2; ++n) acc[a][b][m][n] = (f32x4){0.f, 0.f, 0.f, 0.f};
    bf16x8 At[4][2], B0[2][2], B1[2][2];
    const char* cA = (const char*)g.A + (size_t)cur.pm * tstepA + (size_t)cur.ko * 2; const char* cB = (const char*)g.Bt + (size_t)cur.pn * tstepB + (size_t)cur.ko * 2;
    S.a_ready(cur);
    if constexpr (SP2) {
        PG8_STAGE(PG8_SB(0, 0), cB, voffB); PG8_STAGE(PG8_SB(0, 1), cB + hstepB, voffB); PG8_STAGE(PG8_SA(0, 0), cA, voffA); PG8_STAGE(PG8_SA(0, 1), cA + hstepA, voffA);
        if (wr == 1) PG8_BAR;
        PG8_WAIT_V(2); PG8_BAR;
        PG8_STAGE(PG8_SB(1, 0), cB + kstep, voffB); PG8_STAGE(PG8_SA(1, 0), cA + kstep, voffA); PG8_STAGE(PG8_SB(1, 1), cB + hstepB + kstep, voffB);
        PG8_WAIT_V(6); PG8_BAR;
    } else {
        PG8_STAGE(PG8_SB(0, 0), cB, voffB); PG8_STAGE(PG8_SA(0, 0), cA, voffA); PG8_STAGE(PG8_SB(0, 1), cB + hstepB, voffB); PG8_STAGE(PG8_SA(0, 1), cA + hstepA, voffA);
        if (wr == 1) PG8_BAR;
        PG8_WAIT_V(4); PG8_BAR;
        PG8_STAGE(PG8_SB(1, 0), cB + kstep, voffB); PG8_STAGE(PG8_SA(1, 0), cA + kstep, voffA); PG8_STAGE(PG8_SB(1, 1), cB + hstepB + kstep, voffB);
        PG8_WAIT_V(6); PG8_BAR;
    }
    for (;;) {
        const bool has_next = S.next(ui + 1, nxt);
        const char* nA = has_next ? (const char*)g.A + (size_t)nxt.pm * tstepA + (size_t)nxt.ko * 2 : cA; const char* nB = has_next ? (const char*)g.Bt + (size_t)nxt.pn * tstepB + (size_t)nxt.ko * 2 : cB;
        const int ntu = cur.nt ? cur.nt : nt;
#pragma unroll 1
        for (int t = 0; t < ntu; t += 2) {
            const bool last = (t == ntu - 2);
            const char* a1 = cA + (size_t)(t + 1) * kstep;
            const char* a2 = last ? nA : cA + (size_t)(t + 2) * kstep; const char* b2 = last ? nB : cB + (size_t)(t + 2) * kstep;
            const char* a3 = a2 + kstep; const char* b3 = b2 + kstep;
            if (last && has_next) S.a_ready(nxt);
            if constexpr (SP2) {
            PG8_LDB(B0, 0, 0); PG8_LDB(B1, 0, 1); PG8_SCHED; PG8_LDA(At, 0, 0); PG8_STAGE(PG8_SA(1, 1), a1 + hstepA, voffA);
            PG8_WAIT_V(8); PG8_WAIT_L(0); PG8_BAR; PG8_MMA(0, 0, At, B0); PG8_MMA(0, 1, At, B1); PG8_BAR; PG8_SCHED;
            PG8_LDA(At, 0, 1); PG8_STAGE(PG8_SB(0, 0), b2, voffB); PG8_STAGE(PG8_SB(0, 1), b2 + hstepB, voffB); PG8_STAGE(PG8_SA(0, 0), a2, voffA);
            PG8_WAIT_V(8); PG8_WAIT_L(0); PG8_BAR; PG8_MMA(1, 0, At, B0); PG8_MMA(1, 1, At, B1); PG8_BAR; PG8_SCHED;
            PG8_LDB(B0, 1, 0); PG8_LDB(B1, 1, 1); PG8_SCHED; PG8_LDA(At, 1, 0); PG8_STAGE(PG8_SA(0, 1), a2 + hstepA, voffA);
            PG8_WAIT_V(8); PG8_WAIT_L(0); PG8_BAR; PG8_MMA(0, 0, At, B0); PG8_MMA(0, 1, At, B1); PG8_BAR; PG8_SCHED;
            PG8_LDA(At, 1, 1); PG8_STAGE(PG8_SB(1, 0), b3, voffB); PG8_STAGE(PG8_SB(1, 1), b3 + hstepB, voffB); PG8_STAGE(PG8_SA(1, 0), a3, voffA);
            PG8_WAIT_V(8); PG8_WAIT_L(0); PG8_BAR; PG8_MMA(1, 0, At, B0); PG8_MMA(1, 1, At, B1); PG8_BAR; PG8_SCHED;
            } else {
            PG8_LDB(B0, 0, 0); PG8_SCHED; PG8_LDA(At, 0, 0); PG8_STAGE(PG8_SA(1, 1), a1 + hstepA, voffA);
            PG8_WAIT_L(8); PG8_BAR; PG8_WAIT_L(0); PG8_MMA(0, 0, At, B0); PG8_BAR; PG8_SCHED;
            PG8_LDB(B1, 0, 1); PG8_STAGE(PG8_SB(0, 0), b2, voffB);
            PG8_BAR; PG8_WAIT_L(0); PG8_MMA(0, 1, At, B1); PG8_BAR;
            PG8_LDA(At, 0, 1); PG8_STAGE(PG8_SA(0, 0), a2, voffA);
            PG8_BAR; PG8_WAIT_L(0); PG8_MMA(1, 0, At, B0); PG8_BAR; PG8_SCHED;
            PG8_STAGE(PG8_SB(0, 1), b2 + hstepB, voffB);
            PG8_WAIT_V(6); PG8_BAR; PG8_MMA(1, 1, At, B1); PG8_BAR;
            PG8_LDB(B0, 1, 0); PG8_SCHED; PG8_LDA(At, 1, 0); PG8_STAGE(PG8_SA(0, 1), a2 + hstepA, voffA);
            PG8_WAIT_L(8); PG8_BAR; PG8_WAIT_L(0); PG8_MMA(0, 0, At, B0); PG8_BAR; PG8_SCHED;
            PG8_LDB(B1, 1, 1); PG8_STAGE(PG8_SB(1, 0), b3, voffB);
            PG8_BAR; PG8_WAIT_L(0); PG8_MMA(0, 1, At, B1); PG8_BAR;
            PG8_LDA(At, 1, 1); PG8_STAGE(PG8_SA(1, 0), a3, voffA);
            PG8_BAR; PG8_WAIT_L(0); PG8_MMA(1, 0, At, B0); PG8_BAR; PG8_SCHED;
            PG8_STAGE(PG8_SB(1, 1), b3 + hstepB, voffB);
            PG8_WAIT_V(6); PG8_BAR; PG8_MMA(1, 1, At, B1); PG8_BAR;
            }
        }
        if constexpr (ALIGN_EPI) { if (wr == 0) PG8_BAR; }
        if constexpr (!Epi::AFTER_DRAIN) { E(acc, cur, wr, wc, fr, fq); S.done(cur); }
        if (!has_next) break;
        bool keep_acc = false; if constexpr (Epi::KEEP) keep_acc = E.keep(cur);
        if (!keep_acc) {
#pragma unroll
        for (int a = 0; a < 2; ++a)
#pragma unroll
            for (int b = 0; b < 2; ++b)
#pragma unroll
                for (int m = 0; m < 4; ++m)
#pragma unroll
                    for (int n = 0; n < 2; ++n) acc[a][b][m][n] = (f32x4){0.f, 0.f, 0.f, 0.f};
        }
        cur = nxt; cA = nA; cB = nB; ++ui;
        if constexpr (ALIGN_EPI) { if (wr == 1) PG8_BAR; }
    }
    PG8_WAIT_V(0);
    if constexpr (!ALIGN_EPI) { if (wr == 0) PG8_BAR; }
    PG8_BAR;
    if constexpr (Epi::AFTER_DRAIN) { E.fused(acc, cur, wr, wc, fr, fq, lds, wid, lane); S.done(cur); }
#undef PG8_SA
#undef PG8_SB
#undef PG8_STAGE
#undef PG8_LDA
#undef PG8_LDB
#undef PG8_MMA
#undef PG8_WAIT_V
#undef PG8_WAIT_L
#undef PG8_BAR
#undef PG8_SCHED
}
}
#include <hip/hip_bf16.h>
#include <cmath>
namespace attn_body {
using bf16=__hip_bfloat16;
using bf16x8=__attribute__((ext_vector_type(8)))short;
using s16x4=__attribute__((ext_vector_type(4)))short;
using f32x16=__attribute__((ext_vector_type(16)))float;
using u32x4=__attribute__((ext_vector_type(4)))unsigned;
using f32x4_t=__attribute__((ext_vector_type(4)))float;
constexpr int BATCH=16,NHEAD=8,SEQ=4096,D=64,DM=NHEAD*D;
constexpr int NW=8,QBLK=32,QB=QBLK*NW,KVBLK=64,NQB=SEQ/QB;
constexpr int ATTN_PITCH=DM, ATTN_UNIT_ROWS=QB, OPITCH=1024;
__device__ __forceinline__ int crow(int r,int hi){return (r&3)+8*(r>>2)+4*hi;}
#define SBAR() __builtin_amdgcn_sched_barrier(0)
__device__ __forceinline__ void cmask(f32x16&p0,f32x16&p1,int jb,int qrel,int hi){
  const float NEG=-INFINITY; int kb=64*jb+4*hi;
  #pragma unroll
  for(int r=0;r<16;++r){int kv=kb+(r&3)+8*(r>>2); if(kv>qrel)p0[r]=NEG; if(kv+32>qrel)p1[r]=NEG;}
}

constexpr int NSLOT=3, SLOTB=8192;
constexpr int LDS_K=0, LDS_V=NSLOT*SLOTB, LDS_WS=2*NSLOT*SLOTB, LDS_OST=LDS_WS+NW*64*4, LDS_KB=LDS_OST+NW*4096, LDS_NXT=LDS_KB+SEQ*4, LDS_BYTES=LDS_NXT+16;
constexpr float C2=0.125f*1.4426950408889634f;
__device__ __forceinline__ void glds16(const void*gsrc,unsigned lds_dst){unsigned keep;
  asm volatile("s_mov_b32 %0, m0\n\ts_mov_b32 m0, %2\n\ts_nop 0\n\tglobal_load_lds_dwordx4 %1, off\n\ts_mov_b32 m0, %0":"=&s"(keep):"v"(gsrc),"s"(lds_dst):"memory");}
__device__ __forceinline__ float max3f(float a,float b,float c){float r;asm("v_max3_f32 %0, %1, %2, %3":"=v"(r):"v"(a),"v"(b),"v"(c));return r;}
__device__ __forceinline__ float max2f(float a,float b){float r;asm("v_max_f32_e32 %0, %1, %2":"=v"(r):"v"(a),"v"(b));return r;}
__device__ __forceinline__ float fadd_s(float a,float b){float r;asm("v_add_f32_e32 %0, %1, %2":"=v"(r):"v"(a),"v"(b));return r;}
__device__ __forceinline__ float fsub_s(float a,float b){float r;asm("v_sub_f32_e32 %0, %1, %2":"=v"(r):"v"(a),"v"(b));return r;}
typedef float f32x2_t __attribute__((ext_vector_type(2))); typedef __bf16 bf16x2_t __attribute__((ext_vector_type(2)));
__device__ __forceinline__ unsigned cvtpk_s(float lo,float hi){f32x2_t v={lo,hi};bf16x2_t b=__builtin_convertvector(v,bf16x2_t);return __builtin_bit_cast(unsigned,b);}
#define WAIT_BAR(N) asm volatile("s_waitcnt vmcnt(" #N ") lgkmcnt(0)\n\ts_barrier":::"memory")

__device__ __forceinline__ void qkt(f32x16&p0,f32x16&p1,const char*Kslot,const bf16x8*qr,int r32,int hi){
  const char*kb=Kslot+hi*1024+r32*16;
  #pragma unroll
  for(int d0=0;d0<4;++d0){
    const bf16x8 b0=*reinterpret_cast<const bf16x8*>(kb+d0*2048);
    const bf16x8 b1=*reinterpret_cast<const bf16x8*>(kb+d0*2048+512);
    {p0=__builtin_amdgcn_mfma_f32_32x32x16_bf16(b0,qr[d0],p0,0,0,0);p1=__builtin_amdgcn_mfma_f32_32x32x16_bf16(b1,qr[d0],p1,0,0,0);}}
}
typedef __attribute__((address_space(3))) const char* lds_cptr;
typedef short v4i16_t __attribute__((ext_vector_type(4)));
__device__ __forceinline__ void kload8(bf16x8*kf,lds_cptr kp){
  kf[0]=*(const __attribute__((address_space(3))) bf16x8*)(kp);      kf[1]=*(const __attribute__((address_space(3))) bf16x8*)(kp+512);
  kf[2]=*(const __attribute__((address_space(3))) bf16x8*)(kp+2048); kf[3]=*(const __attribute__((address_space(3))) bf16x8*)(kp+2560);
  kf[4]=*(const __attribute__((address_space(3))) bf16x8*)(kp+4096); kf[5]=*(const __attribute__((address_space(3))) bf16x8*)(kp+4608);
  kf[6]=*(const __attribute__((address_space(3))) bf16x8*)(kp+6144); kf[7]=*(const __attribute__((address_space(3))) bf16x8*)(kp+6656);
}
__device__ __forceinline__ void kload2(bf16x8*kf,lds_cptr kp,int j){ kf[2*j]=*(const __attribute__((address_space(3))) bf16x8*)(kp+j*2048); kf[2*j+1]=*(const __attribute__((address_space(3))) bf16x8*)(kp+j*2048+512); }
__device__ __forceinline__ s16x4 vtr(lds_cptr p){ return __builtin_bit_cast(s16x4,__builtin_amdgcn_ds_read_tr16_b64_v4i16((__attribute__((address_space(3))) v4i16_t*)p)); }
__device__ __forceinline__ float rowmax(const f32x16&p0,const f32x16&p1){
  float a=max3f(p0[0],p0[1],p1[0]),b=max3f(p0[2],p0[3],p1[1]);a=max3f(a,p1[2],p1[3]);
  #pragma unroll
  for(int r=4;r<16;r+=4){a=max3f(a,p0[r],p0[r+1]);b=max3f(b,p0[r+2],p0[r+3]);a=max3f(a,p1[r],p1[r+1]);b=max3f(b,p1[r+2],p1[r+3]);}
  const float m=max2f(a,b);
  auto rr=__builtin_amdgcn_permlane32_swap(__float_as_uint(m),__float_as_uint(m),false,false);
  return max2f(__uint_as_float(rr[0]),__uint_as_float(rr[1]));
}
__device__ __forceinline__ void pv(f32x16*o,int vb,bf16x8 pa0,bf16x8 pa1,bf16x8 pa2,bf16x8 pa3){
  #pragma unroll
  for(int d0=0;d0<2;++d0){s16x4 lo[4],hi[4];
    #pragma unroll
    for(int ks=0;ks<4;++ks){
      asm volatile("ds_read_b64_tr_b16 %0,%1 offset:%c2":"=&v"(lo[ks]):"v"(vb),"i"(d0*4096+ks*1024):"memory");
      asm volatile("ds_read_b64_tr_b16 %0,%1 offset:%c2":"=&v"(hi[ks]):"v"(vb),"i"(d0*4096+ks*1024+512):"memory");}
    asm volatile("s_waitcnt lgkmcnt(0)":::"memory");SBAR();
    #define PK(k) (bf16x8){lo[k][0],lo[k][1],lo[k][2],lo[k][3],hi[k][0],hi[k][1],hi[k][2],hi[k][3]}
    o[d0]=__builtin_amdgcn_mfma_f32_32x32x16_bf16(pa0,PK(0),o[d0],0,0,0);
    o[d0]=__builtin_amdgcn_mfma_f32_32x32x16_bf16(pa1,PK(1),o[d0],0,0,0);
    o[d0]=__builtin_amdgcn_mfma_f32_32x32x16_bf16(pa2,PK(2),o[d0],0,0,0);
    o[d0]=__builtin_amdgcn_mfma_f32_32x32x16_bf16(pa3,PK(3),o[d0],0,0,0);
    #undef PK
  }
}

#ifndef ATTN_STORE16
#define ATTN_STORE16(p,v) (*(u32x4*)(p)=(v))
#endif
template<int THRL> __device__ __forceinline__ void attn_unit(int b,int h,int qb,const bf16*Q,const bf16*__restrict__ K,const bf16*__restrict__ V,bf16*O,const float*__restrict__ KBG,float sbound,unsigned*qctr,int qbase,int nxoff,char*shm){
  int tid_l=threadIdx.x; asm volatile("":"+v"(tid_l));
  const int tid=tid_l,lane=tid&63,r32=lane&31,hi=lane>>5; const int wid=__builtin_amdgcn_readfirstlane(tid>>6);
  const long rowbase=(long)b*SEQ; const int q0=qb*QB;
  const bf16*Qw=Q+(rowbase+q0+wid*QBLK)*DM+h*D;
  const bf16*Kh=K+rowbase*DM+h*D,*Vh=V+rowbase*DM+h*D;
  const lds_cptr shm3=(lds_cptr)shm;
  const unsigned lds0=(unsigned)(uintptr_t)shm;
  float*wsf=(float*)(shm+LDS_WS)+wid*64;
  const bf16*ksrc_=Kh+(long)lane*DM+wid*8;
  const bf16*vsrc_=Vh+(long)(16*(wid&3)+(lane>>2))*DM+(wid>>2)*32+(lane&3)*8;
  const unsigned kdst=lds0+LDS_K+wid*1024, vdst=lds0+LDS_V+wid*1024;
  #define DMA_K(t,slot) glds16(ksrc+(long)(t)*KVBLK*DM,(unsigned)__builtin_amdgcn_readfirstlane(kdst+(slot)))
  #define DMA_V(t,slot) glds16(vsrc+(long)(t)*KVBLK*DM,(unsigned)__builtin_amdgcn_readfirstlane(vdst+(slot)))
  const int vb0=(int)(lds0+LDS_V)+((lane>>4)&1)*32+(lane&3)*8+(4*hi+((lane&15)>>2))*64;
  const char*Kbase=shm+LDS_K; bf16x8 kf[8];
  const lds_cptr kp0=shm3+LDS_K+hi*1024+r32*16; const lds_cptr vp0=shm3+LDS_V+((lane>>4)&1)*32+(lane&3)*8+(4*hi+((lane&15)>>2))*64;
  int NT=(q0+QB)/KVBLK;
  {
    const float*kg=KBG+((long)b*NHEAD+h)*SEQ; const float ref=kg[q0]; float*kbl=(float*)(shm+LDS_KB);
    for(int j=tid;j<q0+QB;j+=NW*64)kbl[j]=kg[j]-ref;
    if(tid==0){ const unsigned nx=__hip_atomic_fetch_add(qctr,1u,__ATOMIC_RELAXED,__HIP_MEMORY_SCOPE_AGENT); *(volatile unsigned*)(shm+LDS_NXT+nxoff)=nx+(unsigned)qbase; }
    asm volatile("s_waitcnt vmcnt(0) lgkmcnt(0)\n\ts_barrier":::"memory"); }
  int tskip; { const float*kbl=(const float*)(shm+LDS_KB); const bool dead=(lane<NT-4)&&(kbl[64*lane+63]+sbound<-140.f); tskip=__builtin_popcountll(__ballot(dead))&~1; }
  tskip=__builtin_amdgcn_readfirstlane(tskip); NT-=tskip;
  const bf16*ksrc=ksrc_+(long)tskip*KVBLK*DM; const bf16*vsrc=vsrc_+(long)tskip*KVBLK*DM;
  const __attribute__((address_space(3))) float*kbp0=(const __attribute__((address_space(3))) float*)(shm3+LDS_KB)+4*hi+64*tskip;
  DMA_K(0,0);DMA_V(0,0);DMA_K(1,SLOTB);
  bf16x8 qr[4];
  #pragma unroll
  for(int d0=0;d0<4;++d0)qr[d0]=*reinterpret_cast<const bf16x8*>(&Qw[(long)r32*DM+d0*16+hi*8]);
  float mhat=0.f,l_reg=0.f;f32x16 o[2];o[0]=f32x16{};o[1]=f32x16{};
  const int qrel=wid*QBLK+r32;
  #define CMASK(P0,P1,t) do{int jb_=(t)-(NT-4); if(jb_>=0)cmask(P0,P1,jb_,qrel,hi);}while(0)
  #define KBP(t,i) (kbp0+64*(t)+(((i)<4)?8*(i):32+8*((i)-4)))
  #define KINIT(P0,P1,t,MH) do{ _Pragma("unroll") for(int k_=0;k_<4;++k_){ const f32x4_t a_=*(const __attribute__((address_space(3))) f32x4_t*)KBP(t,k_); const f32x4_t b_=*(const __attribute__((address_space(3))) f32x4_t*)KBP(t,k_+4); \
      P0[4*k_]=a_[0]-(MH);P0[4*k_+1]=a_[1]-(MH);P0[4*k_+2]=a_[2]-(MH);P0[4*k_+3]=a_[3]-(MH); P1[4*k_]=b_[0]-(MH);P1[4*k_+1]=b_[1]-(MH);P1[4*k_+2]=b_[2]-(MH);P1[4*k_+3]=b_[3]-(MH); } }while(0)
  #define KLD(G,t,i,P) do{ if(G){ const f32x4_t a_=*(const __attribute__((address_space(3))) f32x4_t*)KBP((t)+1,i); P[4*((i)&3)]=a_[0]; P[4*((i)&3)+1]=a_[1]; P[4*((i)&3)+2]=a_[2]; P[4*((i)&3)+3]=a_[3]; } }while(0)
  #define KSUB(G,i,P) do{ if(G){ P[4*((i)&3)]-=mhat; P[4*((i)&3)+1]-=mhat; P[4*((i)&3)+2]-=mhat; P[4*((i)&3)+3]-=mhat; } }while(0)
  bool resc=false;
  #define START(P0,P1) do{ const float rm=rowmax(P0,P1); resc=false; \
    { const float dl=__builtin_fmaxf(rm,0.f); mhat=fadd_s(mhat,dl); \
      _Pragma("unroll") for(int r=0;r<16;++r){P0[r]=fsub_s(P0[r],dl);P1[r]=fsub_s(P1[r],dl);} \
      } \
    _Pragma("unroll") for(int r=0;r<16;++r)P0[r]=__builtin_amdgcn_exp2f(P0[r]); }while(0)
  #define RESC() do{ if(resc){ asm volatile("s_waitcnt lgkmcnt(0)":::"memory"); \
      _Pragma("unroll") for(int d_=0;d_<2;++d_) _Pragma("unroll") for(int r=0;r<16;++r)o[d_][r]*=wsf[crow(r,hi)]; } }while(0)
  int sl_prev=0,sl_cur=0,sl_next=SLOTB;
  #define ROT() do{sl_prev=sl_cur;sl_cur=sl_next;sl_next=(sl_next==(NSLOT-1)*SLOTB)?0:sl_next+SLOTB;}while(0)
  DMA_K(2,2*SLOTB);
  WAIT_BAR(3);
  f32x16 pA0,pA1,pB0,pB1;
  mhat=((const float*)(shm+LDS_KB))[q0+qrel];
  KINIT(pA0,pA1,0,mhat);
  qkt(pA0,pA1,Kbase,qr,r32,hi);asm volatile("s_nop 15\n\ts_nop 7":"+v"(pA0),"+v"(pA1));CMASK(pA0,pA1,0);
  START(pA0,pA1);
  KINIT(pB0,pB1,1,mhat);
  _Pragma("unroll") for(int r=0;r<16;++r)pA1[r]=__builtin_amdgcn_exp2f(pA1[r]);
  WAIT_BAR(0);
  DMA_K(3,0);DMA_V(1,SLOTB);
  ROT();
  kload8(kf,kp0+sl_cur);
  WAIT_BAR(2);
  s16x4 vlo[8],vhi[8]; u32x4 pw0,pw1,pw2,pw3;
  #define PKW(P,B) cvtpk_s(P[B],P[B+1])
  #define PAF(k) __builtin_bit_cast(bf16x8,pw##k)
  #define VFR(i) (bf16x8){vlo[i][0],vlo[i][1],vlo[i][2],vlo[i][3],vhi[i][0],vhi[i][1],vhi[i][2],vhi[i][3]}
  #define PIN(x) asm volatile("":"+v"(x))
  #define MX3(a,b,c) __builtin_fmaxf(__builtin_fmaxf((a),(b)),(c))
  #define GAPA(MF,A0,A1,A2,A3,W0,W1,PW) do{ MF; sacc+=A0; sacc+=A1; sacc+=A2; sacc+=A3; PIN(sacc); W0; W1; PIN(PW); SBAR(); }while(0)
  #define EX(v) __builtin_amdgcn_exp2f(v)
  #define GAPB(MF,X,B) do{ MF; X[B]=EX(X[B]); X[B+1]=EX(X[B+1]); X[B+2]=EX(X[B+2]); X[B+3]=EX(X[B+3]); PIN(X); SBAR(); }while(0)
  #define VRD(i) do{ vlo[i]=vtr(vp_+(((i)>>2)*4096+((i)&3)*1024)); vhi[i]=vtr(vp_+(((i)>>2)*4096+((i)&3)*1024+512)); }while(0)
  #define KRD(G,j) do{ if(G){ kload2(kf,kp0+sl_next,j); SBAR(); } }while(0)
  #define STEP(C0,C1,P0,P1,t,GK,GV,GL) do{ SBAR(); \
    const lds_cptr vp_=vp0+sl_prev; \
    VRD(0); SBAR(); float sacc=(P0[0]+P0[1]); \
    GAPA(C0=__builtin_amdgcn_mfma_f32_32x32x16_bf16(kf[0],qr[0],C0,0,0,0), P0[2],P0[3],P0[4],P0[5],     pw0[0]=PKW(P0,0), pw0[1]=PKW(P0,2), pw0); \
    VRD(4); SBAR(); GAPA(C1=__builtin_amdgcn_mfma_f32_32x32x16_bf16(kf[1],qr[0],C1,0,0,0), P0[6],P0[7],P0[8],P0[9],     pw0[2]=PKW(P0,4), pw0[3]=PKW(P0,6), pw0); \
    VRD(1); SBAR(); GAPA(C0=__builtin_amdgcn_mfma_f32_32x32x16_bf16(kf[2],qr[1],C0,0,0,0),   P0[10],P0[11],P0[12],P0[13], pw1[0]=PKW(P0,8), pw1[1]=PKW(P0,10), pw1); \
    VRD(5); SBAR(); GAPA(C1=__builtin_amdgcn_mfma_f32_32x32x16_bf16(kf[3],qr[1],C1,0,0,0),   P0[14],P0[15],P1[0],P1[1],   pw1[2]=PKW(P0,12),pw1[3]=PKW(P0,14), pw1); \
    VRD(2); SBAR(); GAPA(C0=__builtin_amdgcn_mfma_f32_32x32x16_bf16(kf[4],qr[2],C0,0,0,0),   P1[2],P1[3],P1[4],P1[5],     pw2[0]=PKW(P1,0), pw2[1]=PKW(P1,2), pw2); \
    VRD(6); SBAR(); GAPA(C1=__builtin_amdgcn_mfma_f32_32x32x16_bf16(kf[5],qr[2],C1,0,0,0),   P1[6],P1[7],P1[8],P1[9],     pw2[2]=PKW(P1,4), pw2[3]=PKW(P1,6), pw2); \
    VRD(3); SBAR(); GAPA(C0=__builtin_amdgcn_mfma_f32_32x32x16_bf16(kf[6],qr[3],C0,0,0,0),   P1[10],P1[11],P1[12],P1[13], pw3[0]=PKW(P1,8), pw3[1]=PKW(P1,10), pw3); \
    VRD(7); SBAR(); GAPA(C1=__builtin_amdgcn_mfma_f32_32x32x16_bf16(kf[7],qr[3],C1,0,0,0),   P1[14],P1[15],0.f,0.f,       pw3[2]=PKW(P1,12),pw3[3]=PKW(P1,14), pw3); \
    l_reg+=sacc; \
    if(GK){DMA_K((t)+3,sl_cur);} if(GV){DMA_V((t)+1,sl_next);} \
    CMASK(C0,C1,t); \
    { float a=MX3(C0[0],C0[1],C1[0]),b=MX3(C0[2],C0[3],C1[1]); a=MX3(a,C1[2],C1[3]); \
      _Pragma("unroll") for(int r=4;r<16;r+=4){a=MX3(a,C0[r],C0[r+1]);b=MX3(b,C0[r+2],C0[r+3]);a=MX3(a,C1[r],C1[r+1]);b=MX3(b,C1[r+2],C1[r+3]);} \
      float rm=__builtin_fmaxf(a,b); { auto rr=__builtin_amdgcn_permlane32_swap(__float_as_uint(rm),__float_as_uint(rm),false,false); rm=__builtin_fmaxf(__uint_as_float(rr[0]),__uint_as_float(rr[1])); } \
      resc=false; \
      if(__builtin_expect(__any(rm>(float)THRL),0)){ const float dl=__builtin_fmaxf(rm,0.f); mhat+=dl; \
        _Pragma("unroll") for(int r=0;r<16;++r){C0[r]-=dl;C1[r]-=dl;} \
        const float f=__builtin_amdgcn_exp2f(-dl); l_reg*=f; if(hi==0)wsf[r32]=f; resc=true; } } \
    SBAR(); \
    KLD(GL,t,0,P0); GAPB(o[0]=__builtin_amdgcn_mfma_f32_32x32x16_bf16(PAF(0),VFR(0),o[0],0,0,0), C0,0); \
    KLD(GL,t,1,P0); KSUB(GL,0,P0); GAPB(o[1]=__builtin_amdgcn_mfma_f32_32x32x16_bf16(PAF(0),VFR(4),o[1],0,0,0), C0,4); \
    KRD(GL,0); KLD(GL,t,2,P0); KSUB(GL,1,P0); GAPB(o[0]=__builtin_amdgcn_mfma_f32_32x32x16_bf16(PAF(1),VFR(1),o[0],0,0,0), C0,8); \
    KRD(GL,1); KLD(GL,t,3,P0); KSUB(GL,2,P0); GAPB(o[1]=__builtin_amdgcn_mfma_f32_32x32x16_bf16(PAF(1),VFR(5),o[1],0,0,0), C0,12); \
    KRD(GL,2); KLD(GL,t,4,P1); KSUB(GL,3,P0); GAPB(o[0]=__builtin_amdgcn_mfma_f32_32x32x16_bf16(PAF(2),VFR(2),o[0],0,0,0), C1,0); \
    KRD(GL,3); KLD(GL,t,5,P1); KSUB(GL,4,P1); GAPB(o[1]=__builtin_amdgcn_mfma_f32_32x32x16_bf16(PAF(2),VFR(6),o[1],0,0,0), C1,4); \
    KLD(GL,t,6,P1); KSUB(GL,5,P1); GAPB(o[0]=__builtin_amdgcn_mfma_f32_32x32x16_bf16(PAF(3),VFR(3),o[0],0,0,0), C1,8); \
    KLD(GL,t,7,P1); KSUB(GL,6,P1); GAPB(o[1]=__builtin_amdgcn_mfma_f32_32x32x16_bf16(PAF(3),VFR(7),o[1],0,0,0), C1,12); \
    KSUB(GL,7,P1); \
    }while(0)
  int t=1;
  #undef CMASK
  #define CMASK(P0,P1,t) do{}while(0)
  for(;t+5<NT;t+=2){
    STEP(pB0,pB1,pA0,pA1,t,true,true,true);     WAIT_BAR(2); RESC(); ROT();
    STEP(pA0,pA1,pB0,pB1,t+1,true,true,true);   WAIT_BAR(2); RESC(); ROT();
  }
  #undef CMASK
  #define CMASK(P0,P1,t) do{int jb_=(t)-(NT-4); if(jb_>=0)cmask(P0,P1,jb_,qrel,hi);}while(0)
  #define ENDW(tt) do{ if((tt)+3<NT){WAIT_BAR(2);} else if((tt)+2<NT){WAIT_BAR(1);} else {WAIT_BAR(0);} }while(0)
  for(;t+1<NT;t+=2){
    STEP(pB0,pB1,pA0,pA1,t,(t+3<NT),(t+1<NT),(t+1<NT));       ENDW(t);   RESC(); ROT();
    STEP(pA0,pA1,pB0,pB1,t+1,(t+4<NT),(t+2<NT),(t+2<NT));     ENDW(t+1); RESC(); ROT();
  }
  STEP(pB0,pB1,pA0,pA1,NT-1,false,false,false); RESC();
  { float sacc=pB0[0]+pB0[1]; _Pragma("unroll") for(int r=2;r<16;++r)sacc+=pB0[r]; _Pragma("unroll") for(int r=0;r<16;++r)sacc+=pB1[r]; l_reg+=sacc;
    pw0=(u32x4){PKW(pB0,0),PKW(pB0,2),PKW(pB0,4),PKW(pB0,6)};pw1=(u32x4){PKW(pB0,8),PKW(pB0,10),PKW(pB0,12),PKW(pB0,14)};pw2=(u32x4){PKW(pB1,0),PKW(pB1,2),PKW(pB1,4),PKW(pB1,6)};pw3=(u32x4){PKW(pB1,8),PKW(pB1,10),PKW(pB1,12),PKW(pB1,14)};
    SBAR(); pv(o,vb0+sl_cur,PAF(0),PAF(1),PAF(2),PAF(3)); }
  #undef PKW
  #undef PAF
  #undef VFR
  #undef PIN
  #undef MX3
  #undef GAPA
  #undef GAPB
  #undef EX
  #undef VRD
  #undef KRD
  #undef STEP
  #undef ENDW
  {auto rr=__builtin_amdgcn_permlane32_swap(__float_as_uint(l_reg),__float_as_uint(l_reg),false,false);l_reg=__uint_as_float(rr[0])+__uint_as_float(rr[1]);}
  if(hi==0)wsf[32+r32]=l_reg;asm volatile("s_waitcnt lgkmcnt(0)":::"memory");
  float rli[16];
  #pragma unroll
  for(int r=0;r<16;++r)rli[r]=__builtin_amdgcn_rcpf(wsf[32+crow(r,hi)]);
  bf16*Ow=O+(rowbase+q0+wid*QBLK)*OPITCH+h*D;
  { bf16*stg=(bf16*)(shm+LDS_OST)+wid*2048;
    #pragma unroll
    for(int r=0;r<16;++r){const int orow=crow(r,hi);
      #pragma unroll
      for(int d0=0;d0<2;++d0)stg[orow*64+d0*32+r32]=__float2bfloat16(o[d0][r]*rli[r]);}
    asm volatile("s_waitcnt lgkmcnt(0)":::"memory");
    #pragma unroll
    for(int i=0;i<4;++i){const int row=i*8+(lane>>3),ch=lane&7; const u32x4 v=*(const u32x4*)(stg+row*64+ch*8); ATTN_STORE16(Ow+(long)row*OPITCH+ch*8,v);} }
  asm volatile("s_waitcnt lgkmcnt(0)\n\ts_barrier":::"memory");
  #undef DMA_K
  #undef DMA_V
  #undef CMASK
  #undef KINIT
  #undef KLD
  #undef KSUB
  #undef KBP
  #undef START
  #undef RESC
  #undef ROT
}
constexpr int ATTN_LDS_BYTES=LDS_BYTES;
struct AttnTensors { const bf16* Q; const bf16* K; const bf16* V; bf16* O; const float* KB; };
template<int THRL=8> __device__ __forceinline__ void attn_phase(char*lds,const AttnTensors&T,float sbound,unsigned*qctr,int bx,int G){
  constexpr int NU=BATCH*NHEAD*NQB; int u=bx,nxoff=0;
  _Pragma("unroll 1") while(u<NU){ const int qb=NQB-1-u/(BATCH*NHEAD), bh=u%(BATCH*NHEAD);
    attn_unit<THRL>(bh/NHEAD,bh%NHEAD,qb,T.Q,T.K,T.V,T.O,T.KB,sbound,qctr,G,nxoff,lds);
    u=(int)*(volatile unsigned*)(lds+LDS_NXT+nxoff); u=__builtin_amdgcn_readfirstlane(u); nxoff^=4; }
}
#undef SBAR
#undef WAIT_BAR
}
namespace cg = cooperative_groups;
#define LAS __attribute__((address_space(3)))
typedef unsigned short bf16;
using pg8::f32x4; using pg8::u32x4; using pg8::Unit; using pg8::cvt_pk_bf16;
typedef unsigned u32x2 __attribute__((ext_vector_type(2)));

constexpr int NB = 16, SEQ = 4096, T = NB * SEQ, D = 1024, FF = 4096, INC = 5128, NIN = 5376, UP = 640, NLAYER = 2;
constexpr float EPS = 1e-6f, LOG2E = 1.4426950408889634f, C2Q = 0.125f * LOG2E;
enum { I_X = 0, I_MIXN, I_WIN, I_BF, I_QN, I_KN, I_ARE, I_AIM, I_LDT, I_BRE, I_BIM, I_CRE, I_CIM, I_SD, I_WGLU, I_PW, I_PS, I_WBA, I_WBS, I_WBP, I_BG, I_WOUT, I_MLPN, I_WUP, I_WDN, N_IN };

constexpr size_t MiB = 1u << 20;
constexpr size_t WL_STRIDE = 48 * MiB;
constexpr size_t WL_WIN = 0, WL_WA = 11 * MiB  , WL_WOUT = 13 * MiB, WL_WUP = 15 * MiB, WL_WDN = 23 * MiB,
                 WL_WGLU = 31 * MiB, WL_TZ = 32 * MiB, WL_MEND = 42 * MiB, WL_DL = 46 * MiB;
constexpr size_t WS_ACAT = 96 * MiB;
constexpr size_t WS_XB = 96 * MiB, WS_SSQ = 224 * MiB, WS_Q = 228 * MiB, WS_K = 292 * MiB, WS_V = 356 * MiB, WS_MERGED = WS_K, WS_U = 420 * MiB, WS_UPOOL = 460 * MiB,
                 WS_GATES = 492 * MiB, WS_FLOG = 876 * MiB, WS_KB = 878 * MiB, WS_S = 880 * MiB, WS_YPRE = 896 * MiB, WS_YSSM = 928 * MiB, WS_POOLED = 960 * MiB,
                 WS_DBG = 992 * MiB, WS_SSQ1 = 994 * MiB  , WS_END = 1001 * MiB, WS_ACT = WS_U;
static_assert(WS_ACT + (size_t)T * FF * 2 <= WS_POOLED && WS_MERGED + (size_t)T * D * 2 <= WS_ACT, "act overlay");
constexpr int LDS_BYTES = 147456;

constexpr int N_PHASES_ = 1 + 9 * NLAYER;
struct Params { const float* in[N_IN]; float* out; unsigned char* ws; int ph_lo, ph_hi, dbg, pad; };

__device__ __forceinline__ u32x4 pack8(f32x4 a, f32x4 b) { u32x4 w; w.x = cvt_pk_bf16(a[0], a[1]); w.y = cvt_pk_bf16(a[2], a[3]); w.z = cvt_pk_bf16(b[0], b[1]); w.w = cvt_pk_bf16(b[2], b[3]); return w; }
__device__ __forceinline__ void unpack8(u32x4 w, f32x4& a, f32x4& b) {
    a[0] = __uint_as_float(w.x << 16); a[1] = __uint_as_float(w.x & 0xffff0000u); a[2] = __uint_as_float(w.y << 16); a[3] = __uint_as_float(w.y & 0xffff0000u);
    b[0] = __uint_as_float(w.z << 16); b[1] = __uint_as_float(w.z & 0xffff0000u); b[2] = __uint_as_float(w.w << 16); b[3] = __uint_as_float(w.w & 0xffff0000u); }
__device__ __forceinline__ float bf2f(bf16 v) { return __uint_as_float((unsigned)v << 16); }
__device__ __forceinline__ float dot4(f32x4 a) { return (a[0] * a[0] + a[1] * a[1]) + (a[2] * a[2] + a[3] * a[3]); }
__device__ __forceinline__ float row_rstd(const float* ssq, int row) {
    const f32x4* p = (const f32x4*)(ssq + (size_t)row * 16); const f32x4 a = p[0], b = p[1], c = p[2], d = p[3];
    const float s = ((a[0] + a[1]) + (a[2] + a[3])) + ((b[0] + b[1]) + (b[2] + b[3])) + ((c[0] + c[1]) + (c[2] + c[3])) + ((d[0] + d[1]) + (d[2] + d[3]));
    return __builtin_amdgcn_rsqf(s * (1.0f / D) + EPS); }
__device__ __forceinline__ float sigm(float x) { return __builtin_amdgcn_rcpf(1.0f + __expf(-x)); }
__device__ __forceinline__ f32x4 sigm4(f32x4 x) { f32x4 r; r[0] = sigm(x[0]); r[1] = sigm(x[1]); r[2] = sigm(x[2]); r[3] = sigm(x[3]); return r; }
__device__ __forceinline__ float gelu_t(float y) { const float z = 1.5957691216057308f * (y + 0.044715f * y * y * y); return y * __builtin_amdgcn_rcpf(1.0f + __expf(-z)); }
__device__ __forceinline__ f32x4 gelu4(f32x4 x) { f32x4 r; r[0] = gelu_t(x[0]); r[1] = gelu_t(x[1]); r[2] = gelu_t(x[2]); r[3] = gelu_t(x[3]); return r; }
__device__ __forceinline__ float logsig(float x) { return fminf(x, 0.f) - log1pf(__expf(-fabsf(x))); }

struct EpiIn {
    static constexpr bool PERM = true, AFTER_DRAIN = false, KEEP = false;
    bf16 *q, *k, *v, *U, *upool, *gates; float* flog; const float* ssq; const float *qg, *kg, *bgate, *bforget;
    __device__ __forceinline__ void operator()(const f32x4 (&acc)[2][2][4][2], const Unit& u, int wr, int wc, int fr, int fq) const {
        const int tile = u.pn, row0 = u.pm * 256 + wr * 64 + fr, cc0 = wc * 32 + 8 * fq;
        float rsv[2][4];
#pragma unroll
        for (int ai = 0; ai < 2; ++ai)
#pragma unroll
            for (int m = 0; m < 4; ++m) rsv[ai][m] = row_rstd(ssq, row0 + ai * 128 + m * 16);
        if (tile < 4) {
            const bool isq = tile < 2; const float* gp = (isq ? qg : kg) + 8 * fq; bf16* O = isq ? q : k; const int head = (tile & 1) * 4 + wc; const float sc = isq ? C2Q : 1.f;
            f32x4 g[2][2];
#pragma unroll
            for (int bj = 0; bj < 2; ++bj)
#pragma unroll
                for (int n = 0; n < 2; ++n) g[bj][n] = *(const f32x4*)(gp + 32 * bj + 4 * n);
#pragma unroll
            for (int ai = 0; ai < 2; ++ai)
#pragma unroll
                for (int m = 0; m < 4; ++m) { const int row = row0 + ai * 128 + m * 16; const float rs = rsv[ai][m];
                    f32x4 vv[2][2]; float ss = 0.f;
#pragma unroll
                    for (int bj = 0; bj < 2; ++bj)
#pragma unroll
                        for (int n = 0; n < 2; ++n) { vv[bj][n] = acc[ai][bj][m][n] * rs; ss += dot4(vv[bj][n]); }
                    ss += __shfl_xor(ss, 16); ss += __shfl_xor(ss, 32);
                    const float r = __builtin_amdgcn_rsqf(ss * (1.0f / 64.0f) + EPS) * sc;
#pragma unroll
                    for (int bj = 0; bj < 2; ++bj) *(u32x4*)(O + (size_t)row * 512 + head * 64 + 32 * bj + 8 * fq) = pack8(vv[bj][0] * r * g[bj][0], vv[bj][1] * r * g[bj][1]); __builtin_amdgcn_sched_barrier(0); }
        } else if (tile < 8) {
#pragma unroll
            for (int ai = 0; ai < 2; ++ai)
#pragma unroll
                for (int m = 0; m < 4; ++m) { const int row = row0 + ai * 128 + m * 16; const float rs = rsv[ai][m];
#pragma unroll
                    for (int bj = 0; bj < 2; ++bj) { const int cc = 128 * bj + cc0; bf16* dst;
                        if (tile < 6) dst = v + (size_t)row * 512 + (tile - 4) * 256 + cc;
                        else if (tile == 6) { const int g = cc >> 4, ci0 = cc & 15, b = row >> 12, s = row & 4095; dst = U + ((size_t)(g * 2048 + b * 128 + (s >> 5)) * UP + (s & 31) * 16 + ci0); }
                        else dst = upool + (size_t)row * 256 + cc;
                        *(u32x4*)dst = pack8(acc[ai][bj][m][0] * rs, acc[ai][bj][m][1] * rs); } __builtin_amdgcn_sched_barrier(0); }
        } else if (tile < 20) {
#pragma unroll
            for (int bj = 0; bj < 2; ++bj) { const int col = (tile - 8) * 256 + 128 * bj + cc0; const f32x4 b0 = *(const f32x4*)(bgate + col), b1 = *(const f32x4*)(bgate + col + 4);
#pragma unroll
                for (int ai = 0; ai < 2; ++ai)
#pragma unroll
                    for (int m = 0; m < 4; ++m) { const int row = row0 + ai * 128 + m * 16; const float rs = rsv[ai][m];
                        *(u32x4*)(gates + (size_t)row * 3072 + col) = pack8(sigm4(acc[ai][bj][m][0] * rs + b0), sigm4(acc[ai][bj][m][1] * rs + b1)); __builtin_amdgcn_sched_barrier(0); } }
        } else {
            if (wc == 0 && fq == 0) { const f32x4 b0 = *(const f32x4*)(bforget), b1 = *(const f32x4*)(bforget + 4);
#pragma unroll
                for (int ai = 0; ai < 2; ++ai)
#pragma unroll
                    for (int m = 0; m < 4; ++m) { const int row = row0 + ai * 128 + m * 16; const float rs = rsv[ai][m];
                        const f32x4 x0 = acc[ai][0][m][0] * rs + b0, x1 = acc[ai][0][m][1] * rs + b1; f32x4 o0, o1;
#pragma unroll
                        for (int e = 0; e < 4; ++e) { o0[e] = logsig(x0[e]); o1[e] = logsig(x1[e]); }
                        *(f32x4*)(flog + (size_t)row * 8) = o0; *(f32x4*)(flog + (size_t)row * 8 + 4) = o1; } }
        }
    }
};
struct EpiSend {
    static constexpr bool PERM = true, AFTER_DRAIN = false, KEEP = false;
    float* S;
    __device__ __forceinline__ void operator()(const f32x4 (&acc)[2][2][4][2], const Unit& u, int wr, int wc, int fr, int fq) const {
        const int row0 = u.pm * 256 + wr * 64 + fr, cc0 = wc * 32 + 8 * fq;
#pragma unroll
        for (int ai = 0; ai < 2; ++ai)
#pragma unroll
            for (int m = 0; m < 4; ++m) { float* p = S + (size_t)(row0 + ai * 128 + m * 16) * 128 + cc0; *(f32x4*)p = acc[ai][0][m][0]; *(f32x4*)(p + 4) = acc[ai][0][m][1]; }
    }
};
struct EpiSsmY {
    static constexpr bool PERM = true, AFTER_DRAIN = false, KEEP = false;
    const bf16* U; const float* sd; bf16* ypre;
    __device__ __forceinline__ void operator()(const f32x4 (&acc)[2][2][4][2], const Unit& u, int wr, int wc, int fr, int fq) const {
        const int g = u.pm >> 3, pnl = u.pn & 1, row0 = u.pm * 256 + wr * 64 + fr, cc0 = wc * 32 + 8 * fq;
        u32x4 uw[2][2][4];
#pragma unroll
        for (int bj = 0; bj < 2; ++bj)
#pragma unroll
            for (int ai = 0; ai < 2; ++ai)
#pragma unroll
                for (int m = 0; m < 4; ++m) uw[bj][ai][m] = *(const u32x4*)(U + (size_t)(row0 + ai * 128 + m * 16) * UP + pnl * 256 + 128 * bj + cc0);
#pragma unroll
        for (int bj = 0; bj < 2; ++bj) { const int colidx = pnl * 256 + 128 * bj + cc0, t = colidx >> 4, co0 = colidx & 15;
            const f32x4 d0 = *(const f32x4*)(sd + g * 16 + co0), d1 = *(const f32x4*)(sd + g * 16 + co0 + 4);
#pragma unroll
            for (int ai = 0; ai < 2; ++ai)
#pragma unroll
                for (int m = 0; m < 4; ++m) { const int grow = row0 + ai * 128 + m * 16, rl = grow & 2047, b = rl >> 7, c = rl & 127;
                    f32x4 ua, ub; unpack8(uw[bj][ai][m], ua, ub);
                    *(u32x4*)(ypre + (size_t)(b * 4096 + c * 32 + t) * 256 + g * 16 + co0) = pack8(gelu4(acc[ai][bj][m][0] + d0 * ua), gelu4(acc[ai][bj][m][1] + d1 * ub)); } }
    }
};
struct EpiGlu {
    static constexpr bool PERM = true, AFTER_DRAIN = false, KEEP = false;
    bf16* yssm;
    __device__ __forceinline__ void operator()(const f32x4 (&acc)[2][2][4][2], const Unit& u, int wr, int wc, int fr, int fq) const {
        const int row0 = u.pm * 256 + wr * 64 + fr, col = u.pn * 128 + wc * 32 + 8 * fq;
#pragma unroll
        for (int ai = 0; ai < 2; ++ai)
#pragma unroll
            for (int m = 0; m < 4; ++m) { const int row = row0 + ai * 128 + m * 16;
                *(u32x4*)(yssm + (size_t)row * 1024 + 512 + col) = pack8(acc[ai][0][m][0] * sigm4(acc[ai][1][m][0]), acc[ai][0][m][1] * sigm4(acc[ai][1][m][1])); __builtin_amdgcn_sched_barrier(0); }
    }
};
struct EpiGate3 {
    static constexpr bool PERM = true, AFTER_DRAIN = false, KEEP = true;
    const bf16* gates; bf16* merged;
    __device__ __forceinline__ bool keep(const Unit& u) const { return u.ko != 768; }
    __device__ __forceinline__ void operator()(f32x4 (&acc)[2][2][4][2], const Unit& u, int wr, int wc, int fr, int fq) const {
        const int row0 = u.pm * 256 + wr * 64 + fr, cc0 = wc * 32 + 8 * fq, gi = (u.ko == 0) ? 0 : (u.ko == 512) ? 1 : 2;
        const bf16* gp = gates + (size_t)row0 * 3072 + gi * 1024 + u.pn * 256 + cc0; bf16* mp = merged + (size_t)row0 * 1024 + u.pn * 256 + cc0;
#pragma unroll
        for (int ai = 0; ai < 2; ++ai) { u32x4 gw[4][2], hw[4][2];
#pragma unroll
            for (int m = 0; m < 4; ++m)
#pragma unroll
                for (int bj = 0; bj < 2; ++bj) { const bf16* p = gp + (size_t)(ai * 128 + m * 16) * 3072 + 128 * bj; gw[m][bj] = *(const u32x4*)p; if (gi != 2) hw[m][bj] = *(const u32x4*)(p + 1024); }
#pragma unroll
            for (int m = 0; m < 4; ++m)
#pragma unroll
                for (int bj = 0; bj < 2; ++bj) { f32x4 ga, gb; unpack8(gw[m][bj], ga, gb);
                    if (gi != 2) { f32x4 ha, hb; unpack8(hw[m][bj], ha, hb);
#pragma unroll
                        for (int e = 0; e < 4; ++e) { ga[e] *= __builtin_amdgcn_rcpf(fmaxf(ha[e], 1e-30f)); gb[e] *= __builtin_amdgcn_rcpf(fmaxf(hb[e], 1e-30f)); }
                        acc[ai][bj][m][0] *= ga; acc[ai][bj][m][1] *= gb; }
                    else *(u32x4*)(mp + (size_t)(ai * 128 + m * 16) * 1024 + 128 * bj) = pack8(acc[ai][bj][m][0] * ga, acc[ai][bj][m][1] * gb); } }
    }
};
struct TriOrder {
    pg8::StaticOrder S;
    __device__ __forceinline__ bool next(int i, Unit& u) const { const int ib = i / 3, gi = i - 3 * ib; if (!S.next(ib, u)) return false; u.ko = (gi == 0) ? 0 : (gi == 1) ? 512 : 768; u.nt = (gi == 0) ? 8 : 4; return true; }
    __device__ __forceinline__ void a_ready(const Unit&) const {}
    __device__ __forceinline__ void done(const Unit&) const {}
};
template <int MODE> struct EpiRes {
    static constexpr bool PERM = true, AFTER_DRAIN = false, KEEP = false;
    const float* xin; float* xout; bf16* xb; float* ssq; bool next; const float* ssq_in;
    __device__ __forceinline__ void operator()(const f32x4 (&acc)[2][2][4][2], const Unit& u, int wr, int wc, int fr, int fq) const {
        const int row0 = u.pm * 256 + wr * 64 + fr, cc0 = wc * 32 + 8 * fq; const size_t off0 = (size_t)row0 * 1024 + u.pn * 256 + cc0;
#pragma unroll
        for (int ai = 0; ai < 2; ++ai) { f32x4 ra[4][2], rb[4][2]; float rs2[4];
            if (MODE == 1) {
#pragma unroll
                for (int m = 0; m < 4; ++m) { const float r = row_rstd(ssq_in, row0 + ai * 128 + m * 16); rs2[m] = r * r; } }
#pragma unroll
            for (int m = 0; m < 4; ++m)
#pragma unroll
                for (int bj = 0; bj < 2; ++bj) { const size_t off = off0 + (size_t)(ai * 128 + m * 16) * 1024 + 128 * bj;
                    if (MODE == 0) { ra[m][bj] = *(const f32x4*)(xin + off); rb[m][bj] = *(const f32x4*)(xin + off + 4); } else unpack8(*(const u32x4*)(xb + off), ra[m][bj], rb[m][bj]); }
#pragma unroll
            for (int m = 0; m < 4; ++m) { const int row = row0 + ai * 128 + m * 16; float ss = 0.f;
#pragma unroll
                for (int bj = 0; bj < 2; ++bj) { const size_t off = off0 + (size_t)(ai * 128 + m * 16) * 1024 + 128 * bj;
                    const f32x4 a = (MODE == 1) ? ra[m][bj] + acc[ai][bj][m][0] * rs2[m] : ra[m][bj] + acc[ai][bj][m][0], b = (MODE == 1) ? rb[m][bj] + acc[ai][bj][m][1] * rs2[m] : rb[m][bj] + acc[ai][bj][m][1];
                    if (MODE == 1) { *(f32x4*)(xout + off) = a; *(f32x4*)(xout + off + 4) = b; }
                    if (MODE == 0 || next) { *(u32x4*)(xb + off) = pack8(a, b); ss += dot4(a) + dot4(b); } }
                if (MODE == 0 || next) { ss += __shfl_xor(ss, 16); ss += __shfl_xor(ss, 32); if (fq == 0) ssq[(size_t)row * 16 + u.pn * 4 + wc] = ss; } }
            __builtin_amdgcn_sched_barrier(0); }
    }
};
struct EpiUp {
    static constexpr bool PERM = true, AFTER_DRAIN = false, KEEP = false;
    bf16* act;
    __device__ __forceinline__ void operator()(const f32x4 (&acc)[2][2][4][2], const Unit& u, int wr, int wc, int fr, int fq) const {
        const int row0 = u.pm * 256 + wr * 64 + fr, cc0 = wc * 32 + 8 * fq;
#pragma unroll
        for (int ai = 0; ai < 2; ++ai)
#pragma unroll
            for (int m = 0; m < 4; ++m) { const int row = row0 + ai * 128 + m * 16;
#pragma unroll
                for (int bj = 0; bj < 2; ++bj) { f32x4 a = acc[ai][bj][m][0], b = acc[ai][bj][m][1];
#pragma unroll
                    for (int e = 0; e < 4; ++e) { const float x0 = fmaxf(a[e], 0.f), x1 = fmaxf(b[e], 0.f); a[e] = x0 * x0; b[e] = x1 * x1; }
                    *(u32x4*)(act + (size_t)row * FF + u.pn * 256 + 128 * bj + cc0) = pack8(a, b); } __builtin_amdgcn_sched_barrier(0); }
    }
};
__device__ __forceinline__ void flog_panel(const bf16* xb, const bf16* wf, const float* ssq, const float* bforget, float* flog, int pm, int wave, int lane) {
    typedef short bf16x8_t __attribute__((ext_vector_type(8)));
    const int fr = lane & 15, fq = lane >> 4, r0 = pm * 256 + wave * 32;
    const bf16* a0 = xb + (size_t)(r0 + fr) * D + 8 * fq; const bf16* a1 = a0 + (size_t)16 * D; const bf16* bp = wf + (size_t)fr * D + 8 * fq;
    f32x4 c0 = {0.f, 0.f, 0.f, 0.f}, c1 = c0;
#pragma unroll 8
    for (int ks = 0; ks < D / 32; ++ks) { const bf16x8_t bv = *(const bf16x8_t*)(bp + 32 * ks), x0 = *(const bf16x8_t*)(a0 + 32 * ks), x1 = *(const bf16x8_t*)(a1 + 32 * ks);
        c0 = __builtin_amdgcn_mfma_f32_16x16x32_bf16(bv, x0, c0, 0, 0, 0); c1 = __builtin_amdgcn_mfma_f32_16x16x32_bf16(bv, x1, c1, 0, 0, 0); }
    if (fq < 2) { const f32x4 bb = *(const f32x4*)(bforget + 4 * fq);
        const float rs0 = row_rstd(ssq, r0 + fr), rs1 = row_rstd(ssq, r0 + 16 + fr); f32x4 o0, o1;
#pragma unroll
        for (int e = 0; e < 4; ++e) { o0[e] = logsig(c0[e] * rs0 + bb[e]); o1[e] = logsig(c1[e] * rs1 + bb[e]); }
        *(f32x4*)(flog + (size_t)(r0 + fr) * 8 + 4 * fq) = o0; *(f32x4*)(flog + (size_t)(r0 + 16 + fr) * 8 + 4 * fq) = o1; }
}
struct BatchOrder {
    int nG, nMg, nNg, G, c;
    __device__ __forceinline__ bool next(int i, Unit& u) const { const long L = (long)i * G + c; if (L >= (long)nG * nMg * nNg) return false;
        const int l = (int)L, per = nMg * nNg, g = l / per, r = l % per; u.pm = g * nMg + (r % nMg); u.pn = g * nNg + (r / nMg); return true; }
    __device__ __forceinline__ void a_ready(const Unit&) const {}
    __device__ __forceinline__ void done(const Unit&) const {}
};

#define LDS_WAIT() asm volatile("s_waitcnt lgkmcnt(0)" ::: "memory")
__device__ __forceinline__ float wave_sum(float v) {
#pragma unroll
    for (int o = 1; o < 64; o <<= 1) v += __shfl_xor(v, o);
    return v; }
__device__ __forceinline__ unsigned f2bf(float f) { unsigned u = __builtin_bit_cast(unsigned, f); return (u + 0x7fffu + ((u >> 16) & 1u)) >> 16; }
__device__ __forceinline__ unsigned pk2(float lo, float hi) { return f2bf(lo) | (f2bf(hi) << 16); }
__device__ __forceinline__ int dst_row(int mode, int n) {
    if (mode == 1) {
        if (n < 1024) { const int base = n & ~511, nn = n & 511, h = nn >> 6, d = nn & 63; return base + (h >> 2) * 256 + (d >> 5) * 128 + (h & 3) * 32 + (d & 31); }
        if (n < 1536) return n;
        if (n < 1544) return 5120 + (n - 1536);
        return n - 8; }
    if (mode == 2) { const int hb = n >> 8, nn = n & 255; return (nn >> 7) * 256 + hb * 128 + (nn & 127); }
    return n; }
__device__ __forceinline__ void tr_item(const float* W, int K, int N, bf16* WT, int ldt, int mode, const float* ksc, LAS float* scr, int item, int lane) {
    const int nblk = (N + 31) / 32, kb = item / nblk, nb = item % nblk, k0 = 64 * kb, n0 = 32 * nb; const int nn = n0 + (lane & 31); const bool ok = nn < N;
#pragma unroll 8
    for (int i = 0; i < 32; ++i) { const int kk = 2 * i + (lane >> 5); float w = ok ? W[(size_t)(k0 + kk) * N + nn] : 0.f; if (ksc) w *= ksc[k0 + kk]; scr[kk * 33 + (lane & 31)] = w; }
    LDS_WAIT(); asm volatile("" ::: "memory");
    const int c = lane & 7;
#pragma unroll
    for (int j = 0; j < 4; ++j) { const int n = (lane >> 3) + 8 * j; const LAS float* s = scr + (8 * c) * 33 + n;
        u32x4 o; o.x = pk2(s[0 * 33], s[1 * 33]); o.y = pk2(s[2 * 33], s[3 * 33]); o.z = pk2(s[4 * 33], s[5 * 33]); o.w = pk2(s[6 * 33], s[7 * 33]);
        if (n0 + n < N) *(u32x4*)(WT + (size_t)dst_row(mode, n0 + n) * ldt + k0 + 8 * c) = o; }
    LDS_WAIT(); asm volatile("" ::: "memory");
}
__device__ __forceinline__ void sincos_d(double x, double& s, double& c) {
    const double q = rint(x * 0.6366197723675814); const int n = (int)q;
    double r = fma(-q, 1.5707963267948966, x); r = fma(-q, 6.123233995736766e-17, r);
    const double r2 = r * r;
    const double sp = r * (1.0 + r2 * (-1.0 / 6 + r2 * (1.0 / 120 + r2 * (-1.0 / 5040 + r2 * (1.0 / 362880 + r2 * (-1.0 / 39916800 + r2 * (1.0 / 6227020800.0)))))));
    const double cp = 1.0 + r2 * (-0.5 + r2 * (1.0 / 24 + r2 * (-1.0 / 720 + r2 * (1.0 / 40320 + r2 * (-1.0 / 3628800 + r2 * (1.0 / 479001600 + r2 * (-1.0 / 87178291200.0)))))));
    const int k = n & 3; s = (k == 0) ? sp : (k == 1) ? cp : (k == 2) ? -sp : -cp; c = (k == 0) ? cp : (k == 1) ? -sp : (k == 2) ? -cp : sp; }
__device__ __forceinline__ double exp_small_d(double x) {
    double r = 1.0 / 479001600; r = r * x + 1.0 / 39916800; r = r * x + 1.0 / 3628800; r = r * x + 1.0 / 362880; r = r * x + 1.0 / 40320; r = r * x + 1.0 / 5040; r = r * x + 1.0 / 720;
    r = r * x + 1.0 / 120; r = r * x + 1.0 / 24; r = r * x + 1.0 / 6; r = r * x + 0.5; r = r * x + 1.0; r = r * x + 1.0; return r; }

__device__ __forceinline__ void ssm_gen(const Params& P, int l, int g, LAS unsigned char* lds, int tid) {
    LAS float* Ap = (LAS float*)lds;
    LAS float* Bb = Ap + 33 * 128;
    LAS float* Cc = Bb + 2048;
    LAS float* Kl = Cc + 2048;
    LAS float* Cf = Kl + 8192;
    const float* are = P.in[I_ARE] + (size_t)l * 1024 + g * 64; const float* aim = P.in[I_AIM] + (size_t)l * 1024 + g * 64;
    const float* bre = P.in[I_BRE] + (size_t)l * 16384 + g * 1024; const float* bim = P.in[I_BIM] + (size_t)l * 16384 + g * 1024;
    const float* cre = P.in[I_CRE] + (size_t)l * 16384 + g * 1024; const float* cim = P.in[I_CIM] + (size_t)l * 16384 + g * 1024;
    bf16* Tz = (bf16*)(P.ws + l * WL_STRIDE + WL_TZ) + (size_t)g * 512 * UP; bf16* Me = (bf16*)(P.ws + l * WL_STRIDE + WL_MEND) + (size_t)g * 256 * 512;
    float* DL = (float*)(P.ws + l * WL_STRIDE + WL_DL) + g * 128;
    if (tid < 64) { const int n = tid; const double dt = (double)expf(P.in[I_LDT][l * 16 + g]); const double ar = (double)are[n], ai = (double)aim[n];
        const double mag = exp_small_d(ar * dt); double sn, cs; sincos_d(ai * dt, sn, cs); const double abr = mag * cs, abi = mag * sn, den = ar * ar + ai * ai, nr = abr - 1.0, ni = abi;
        Cf[2 * n] = (float)((nr * ar + ni * ai) / den); Cf[2 * n + 1] = (float)((ni * ar - nr * ai) / den);
        double pr = 1.0, pi = 0.0;
        for (int k = 0; k <= 32; ++k) { Ap[(k * 64 + n) * 2] = (float)pr; Ap[(k * 64 + n) * 2 + 1] = (float)pi; const double t = pr * abr - pi * abi; pi = pr * abi + pi * abr; pr = t; }
        DL[2 * n] = Ap[(32 * 64 + n) * 2]; DL[2 * n + 1] = Ap[(32 * 64 + n) * 2 + 1]; }
    __syncthreads();
    for (int e = tid; e < 1024; e += 512) { const int n = e >> 4; const float cr = Cf[2 * n], ci = Cf[2 * n + 1], br = bre[e], bi = bim[e];
        Bb[2 * e] = cr * br - ci * bi; Bb[2 * e + 1] = cr * bi + ci * br; Cc[2 * e] = cre[e]; Cc[2 * e + 1] = cim[e]; }
    __syncthreads();
    for (int e = tid; e < 8192; e += 512) { const int lag = e >> 8, co = (e >> 4) & 15, ci = e & 15; float s = 0.f;
        for (int n = 0; n < 64; ++n) { const float cr = Cc[(co * 64 + n) * 2], cI = Cc[(co * 64 + n) * 2 + 1], ar = Ap[(lag * 64 + n) * 2], aI = Ap[(lag * 64 + n) * 2 + 1];
            const float car = cr * ar - cI * aI, cai = cr * aI + cI * ar; s += car * Bb[(n * 16 + ci) * 2] - cai * Bb[(n * 16 + ci) * 2 + 1]; }
        Kl[e] = s; }
    __syncthreads();
    for (int ch = tid; ch < 512 * 80; ch += 512) { const int row = ch / 80, cq = ch % 80, t = row >> 4, co = row & 15; float v[8];
        if (cq < 64) { const int j = cq >> 1, ci0 = (cq & 1) * 8;
#pragma unroll
            for (int i = 0; i < 8; ++i) v[i] = (j <= t) ? Kl[(t - j) * 256 + co * 16 + ci0 + i] : 0.f;
        } else { const int n0 = (cq - 64) * 8;
#pragma unroll
            for (int i = 0; i < 8; ++i) { const int nn = n0 + i, n = nn & 63; const float cr = Cc[(co * 64 + n) * 2], cI = Cc[(co * 64 + n) * 2 + 1], ar = Ap[((t + 1) * 64 + n) * 2], aI = Ap[((t + 1) * 64 + n) * 2 + 1];
                v[i] = (nn < 64) ? (cr * ar - cI * aI) : -(cr * aI + cI * ar); } }
        u32x4 o; o.x = pk2(v[0], v[1]); o.y = pk2(v[2], v[3]); o.z = pk2(v[4], v[5]); o.w = pk2(v[6], v[7]); *(u32x4*)(Tz + (size_t)row * UP + cq * 8) = o; }
    for (int ch = tid; ch < 256 * 64; ch += 512) { const int row = ch >> 6, cq = ch & 63, j = cq >> 1, ci0 = (cq & 1) * 8; float v[8];
#pragma unroll
        for (int i = 0; i < 8; ++i) { const int n = row & 63; const float ar = Ap[((31 - j) * 64 + n) * 2], aI = Ap[((31 - j) * 64 + n) * 2 + 1], br = Bb[(n * 16 + ci0 + i) * 2], bI = Bb[(n * 16 + ci0 + i) * 2 + 1];
            v[i] = (row < 64) ? (ar * br - aI * bI) : (row < 128) ? (ar * bI + aI * br) : 0.f; }
        u32x4 o; o.x = pk2(v[0], v[1]); o.y = pk2(v[2], v[3]); o.z = pk2(v[4], v[5]); o.w = pk2(v[6], v[7]); *(u32x4*)(Me + (size_t)row * 512 + cq * 8) = o; }
    __syncthreads();
}
__device__ __forceinline__ void wp_item(const Params& P, int l, int item, int lane) {
    const int kc = item >> 4, nb = item & 15, k0 = kc * 8, g = k0 >> 6, c0 = k0 & 63, n = nb * 64 + lane;
    const float* pw = P.in[I_PW] + (size_t)l * 16384 + g * 4096 + c0 * 64; const float* ps = P.in[I_PS] + l * 256 + g * 64; const float* wb = P.in[I_WBP] + (size_t)l * 262144 + (size_t)(g * 64) * 1024 + n;
    float a[8] = {0, 0, 0, 0, 0, 0, 0, 0};
    for (int d = 0; d < 64; ++d) { const float w = wb[(size_t)d * 1024] * ps[d];
#pragma unroll
        for (int i = 0; i < 8; ++i) a[i] += pw[i * 64 + d] * w; }
    u32x4 o; o.x = pk2(a[0], a[1]); o.y = pk2(a[2], a[3]); o.z = pk2(a[4], a[5]); o.w = pk2(a[6], a[7]);
    *(u32x4*)((bf16*)(P.ws + l * WL_STRIDE + WL_WA) + (size_t)n * 1024 + 768 + k0) = o;
}
__device__ __forceinline__ void prologue(const Params& P, LAS unsigned char* lds, int tid, int lane, int wave, int bx, int G) {
    for (int it = bx; it < NLAYER * 16; it += G) ssm_gen(P, it >> 4, it & 15, lds, tid);
    __syncthreads();
    LAS float* scr = (LAS float*)(lds + wave * 16384);
    const int gw = bx * 8 + wave, NGW = G * 8;
    constexpr int I_IN = 16 * 161, I_A = 8 * 32, I_S = 4 * 32, I_O = 16 * 32, I_U = 16 * 128, I_D = 64 * 32, I_G = 4 * 16, I_P = 512, I_Z = 31, PER = I_IN + I_A + I_S + I_O + I_U + I_D + I_G + I_P + I_Z;
    const int nssm = (G > 2 * NLAYER * 16) ? NLAYER * 16 : 0;
    for (int it = (bx - nssm) * 8 + wave; bx >= nssm && it < NLAYER * PER; it += (G - nssm) * 8) { const int l = it / PER; int r = it % PER; unsigned char* wl = P.ws + l * WL_STRIDE;
        if (r < I_IN) { tr_item(P.in[I_WIN] + (size_t)l * D * INC, D, INC, (bf16*)(wl + WL_WIN), D, 1, P.in[I_MIXN] + l * D, scr, r, lane); continue; } r -= I_IN;
        if (r < I_A) { tr_item(P.in[I_WBA] + (size_t)l * 512 * D, 512, D, (bf16*)(wl + WL_WA), 1024, 0, nullptr, scr, r, lane); continue; } r -= I_A;
        if (r < I_S) { tr_item(P.in[I_WBS] + (size_t)l * 256 * D, 256, D, (bf16*)(wl + WL_WA) + 512, 1024, 0, nullptr, scr, r, lane); continue; } r -= I_S;
        if (r < I_O) { tr_item(P.in[I_WOUT] + (size_t)l * D * D, D, D, (bf16*)(wl + WL_WOUT), D, 0, nullptr, scr, r, lane); continue; } r -= I_O;
        if (r < I_U) { tr_item(P.in[I_WUP] + (size_t)l * D * FF, D, FF, (bf16*)(wl + WL_WUP), D, 0, P.in[I_MLPN] + l * D, scr, r, lane); continue; } r -= I_U;
        if (r < I_D) { tr_item(P.in[I_WDN] + (size_t)l * FF * D, FF, D, (bf16*)(wl + WL_WDN), FF, 0, nullptr, scr, r, lane); continue; } r -= I_D;
        if (r < I_G) { tr_item(P.in[I_WGLU] + (size_t)l * 256 * 512, 256, 512, (bf16*)(wl + WL_WGLU), 256, 2, nullptr, scr, r, lane); continue; } r -= I_G;
        if (r < I_P) { wp_item(P, l, r, lane); continue; } r -= I_P;
        { u32x4* z = (u32x4*)((bf16*)(wl + WL_WIN) + (size_t)(5128 + 8 * r) * D) + lane; const u32x4 zero = {0u, 0u, 0u, 0u};
#pragma unroll
          for (int i = 0; i < 16; ++i) z[64 * i] = zero; }
    }
    const float* x = P.in[I_X]; bf16* xb = (bf16*)(P.ws + WS_XB); float* ssq = (float*)(P.ws + WS_SSQ);
    for (int m0 = gw * 4; m0 < T; m0 += NGW * 4) {
        f32x4 v[4][4]; float sq[4];
#pragma unroll
        for (int r = 0; r < 4; ++r) { const f32x4* xr = (const f32x4*)(x + (size_t)(m0 + r) * D) + lane;
#pragma unroll
            for (int j = 0; j < 4; ++j) v[r][j] = xr[64 * j]; }
#pragma unroll
        for (int r = 0; r < 4; ++r) { float s = 0.f;
#pragma unroll
            for (int j = 0; j < 4; ++j) s += dot4(v[r][j]);
            sq[r] = wave_sum(s); }
#pragma unroll
        for (int r = 0; r < 4; ++r) { u32x2* o = (u32x2*)(xb + (size_t)(m0 + r) * D) + lane;
#pragma unroll
            for (int j = 0; j < 4; ++j) { u32x2 w; w.x = cvt_pk_bf16(v[r][j][0], v[r][j][1]); w.y = cvt_pk_bf16(v[r][j][2], v[r][j][3]); o[64 * j] = w; }
            if (lane < 16) ssq[(size_t)(m0 + r) * 16 + lane] = (lane == 0) ? sq[r] : 0.f; } }
}
__device__ __forceinline__ void fcum_seq(const float* flog, float* kb, int sq, LAS unsigned char* lds, int tid, int lane, int wave) {
    const int b = sq >> 3, h = sq & 7; LAS float* wt = (LAS float*)lds;
    float v[8]; float run = 0.f;
#pragma unroll
    for (int i = 0; i < 8; ++i) { run += flog[((size_t)b * SEQ + tid * 8 + i) * 8 + h]; v[i] = run; }
    float inc = run;
#pragma unroll
    for (int o = 1; o < 64; o <<= 1) { const float t = __shfl_up(inc, o); if (lane >= o) inc += t; }
    if (lane == 63) wt[wave] = inc;
    __syncthreads();
    float off = inc - run;
    for (int w = 0; w < wave; ++w) off += wt[w];
#pragma unroll
    for (int i = 0; i < 8; ++i) kb[(size_t)sq * SEQ + tid * 8 + i] = -LOG2E * (off + v[i]);
    __syncthreads();
}
template <int W> __device__ __forceinline__ void pool_item(const bf16* up, bf16* acat, int tok, int ch0) {
    const int s = tok & (SEQ - 1); f32x4 sa = {0.f, 0.f, 0.f, 0.f}, sb = sa, ca = sa, cb = sa; u32x4 r[W];
#pragma unroll
    for (int j = 0; j < W; ++j) r[j] = (j <= s) ? *(const u32x4*)(up + (size_t)(tok - ((j <= s) ? j : 0)) * 256 + ch0) : (u32x4){0u, 0u, 0u, 0u};
#pragma unroll
    for (int j = 0; j < W; ++j) { f32x4 a, b; unpack8(r[j], a, b); if (j == 0) { ca = a; cb = b; } sa += a; sb += b; }
    const float inv = 1.0f / (float)((s + 1 < W) ? s + 1 : W);
    *(u32x4*)(acat + (size_t)tok * 1024 + 768 + ch0) = pack8(sa * inv - ca, sb * inv - cb);
}
__device__ __forceinline__ void pool_pass(const bf16* up, bf16* acat, int gwave, int nwaves, int lane) {
    for (int wi = gwave; wi < (T / 8) * 4; wi += nwaves) { const int g = wi & 3, tok = (wi >> 2) * 8 + (lane >> 3), ch0 = g * 64 + (lane & 7) * 8;
        if (g == 0) pool_item<2>(up, acat, tok, ch0); else if (g == 1) pool_item<4>(up, acat, tok, ch0); else if (g == 2) pool_item<8>(up, acat, tok, ch0); else pool_item<16>(up, acat, tok, ch0); }
}
__device__ __forceinline__ void state_scan(const float* S, const float* DL, bf16* U, int gid) {
    const int g = gid >> 10, b = (gid >> 6) & 15, n = gid & 63; const float dr = DL[g * 128 + 2 * n], di = DL[g * 128 + 2 * n + 1];
    float xr = 0.f, xi = 0.f; const size_t r0 = (size_t)g * 2048 + b * 128;
#pragma unroll 8
    for (int c = 0; c < 128; ++c) { const float sr = S[(r0 + c) * 128 + n], si = S[(r0 + c) * 128 + 64 + n];
        U[(r0 + c) * UP + 512 + n] = (bf16)f2bf(xr); U[(r0 + c) * UP + 576 + n] = (bf16)f2bf(xi);
        const float t = dr * xr - di * xi + sr; xi = dr * xi + di * xr + si; xr = t; }
}

#define XB_TMO      128
#define XB_XCNT(j)  (256  + 64 * (j))
#define XB_XSUB(j)  (1280 + 64 * (j))
#define XB_XGEN(j)  (2304 + 64 * (j))
#define XB_TOP      3328
#define XB_TOPGEN   3392
#define XCD_BAR_WORDS 3456
#define XB_SPIN_CAP (1u << 18)

__device__ __forceinline__ unsigned xb_ld(unsigned* p)              { return __hip_atomic_load(p, __ATOMIC_RELAXED, __HIP_MEMORY_SCOPE_AGENT); }
__device__ __forceinline__ unsigned xb_add(unsigned* p, unsigned v) { return __hip_atomic_fetch_add(p, v, __ATOMIC_RELAXED, __HIP_MEMORY_SCOPE_AGENT); }
__device__ __forceinline__ unsigned xb_xcc_id() { return (unsigned)__builtin_amdgcn_s_getreg((3 << 11) | 20) & 0xFu; }
#define XB_SPIN(cond, bar) do { unsigned _sp = 0; while (cond) { __builtin_amdgcn_s_sleep(1); \
    if ((++_sp & 255u) == 0u) { if (xb_ld(&(bar)[XB_TMO])) break; if (_sp > XB_SPIN_CAP) { atomicAdd(&(bar)[XB_TMO], 1u); break; } } } } while (0)

struct XcdBarrier {
    unsigned* bar; unsigned x;
    volatile LAS unsigned* st;
};

__device__ __forceinline__ XcdBarrier xcd_barrier_post(unsigned* bar, volatile LAS unsigned* st) {
    XcdBarrier b; b.bar = bar; b.x = xb_xcc_id(); b.st = st;
    if (threadIdx.x == 0) (void)xb_add(&bar[XB_XCNT(b.x)], 1u);
    return b;
}
__device__ __forceinline__ void xcd_barrier_complete(unsigned* bar, unsigned x, unsigned& nloc, unsigned& nx) {
    const unsigned G = gridDim.x * gridDim.y * gridDim.z;
    unsigned sum, cnt, mine, sp = 0u;
    for (;;) {
        sum = 0u; cnt = 0u; mine = 0u;
#pragma unroll
        for (unsigned j = 0; j < 16; ++j) { const unsigned c = xb_ld(&bar[XB_XCNT(j)]); sum += c; cnt += (c > 0u) ? 1u : 0u; mine = (j == x) ? c : mine; }
        if (sum == G) break;
        __builtin_amdgcn_s_sleep(1);
        if ((++sp & 255u) == 0u) { if (xb_ld(&bar[XB_TMO])) break; if (sp > XB_SPIN_CAP) { atomicAdd(&bar[XB_TMO], 1u); break; } }
    }
    nloc = mine > 0u ? mine : 1u; nx = cnt > 0u ? cnt : 1u;
}

__device__ __forceinline__ void xcd_barrier(const XcdBarrier& b) {
    asm volatile("s_waitcnt vmcnt(0)" ::: "memory");
    __syncthreads();
    if (threadIdx.x == 0) {
        unsigned* bar = b.bar;
        __builtin_amdgcn_s_waitcnt(0);
        unsigned nloc = b.st[0], nx = b.st[1];
        if (nloc == 0u) { xcd_barrier_complete(bar, b.x, nloc, nx); b.st[0] = nloc; b.st[1] = nx; }
        const unsigned old = xb_add(&bar[XB_XSUB(b.x)], 1u);
        const unsigned gen = old / nloc;
        if (old + 1u == (gen + 1u) * nloc) {
            __builtin_amdgcn_fence(__ATOMIC_RELEASE, "agent");
            asm volatile("s_waitcnt vmcnt(0)" ::: "memory");
            const unsigned og = xb_add(&bar[XB_TOP], 1u);
            const unsigned tg = og / nx;
            if (og + 1u == (tg + 1u) * nx) xb_add(&bar[XB_TOPGEN], 1u);
            else XB_SPIN(xb_ld(&bar[XB_TOPGEN]) == tg, bar);
            __builtin_amdgcn_fence(__ATOMIC_ACQUIRE, "agent");
            xb_add(&bar[XB_XGEN(b.x)], 1u);
            asm volatile("s_waitcnt vmcnt(0)" ::: "memory");
        } else {
            XB_SPIN(xb_ld(&bar[XB_XGEN(b.x)]) == gen, bar);
            __builtin_amdgcn_fence(__ATOMIC_ACQUIRE, "agent");
            asm volatile("s_waitcnt vmcnt(0)" ::: "memory");
        }
    }
    __syncthreads();
}

constexpr size_t WS_BAR = 1000 * MiB;
#define GB_CNT(g) (4096 + 64 * (g))
__device__ __forceinline__ void group_barrier(unsigned* bar, volatile LAS unsigned* st, unsigned grp, unsigned nloc) {
    asm volatile("s_waitcnt vmcnt(0)" ::: "memory");
    __syncthreads();
    if (threadIdx.x == 0) {
        const unsigned k = st[2] + 1u; st[2] = k;
        __builtin_amdgcn_fence(__ATOMIC_RELEASE, "agent");
        asm volatile("s_waitcnt vmcnt(0)" ::: "memory");
        (void)xb_add(&bar[GB_CNT(grp)], 1u);
        const unsigned target = k * nloc;
        XB_SPIN(xb_ld(&bar[GB_CNT(grp)]) < target, bar);
        __builtin_amdgcn_fence(__ATOMIC_ACQUIRE, "agent");
        asm volatile("s_waitcnt vmcnt(0)" ::: "memory");
    }
    __syncthreads();
}
constexpr int LDS_BARST = 131072 + 1024;
#ifndef PHM
#define PHM 0x3ff
#endif
#ifndef PROBE
#define PROBE 0
#endif
typedef const __attribute__((address_space(4))) Params* KArgP;
__global__ void __launch_bounds__(512, 2) fwd_kernel(Params P) {
    extern __shared__ __attribute__((aligned(16))) unsigned char lds_raw[];
    cg::grid_group grid = cg::this_grid();
    LAS unsigned char* lds = (LAS unsigned char*)lds_raw;
    const int ph_lo = P.ph_lo, ph_hi = P.ph_hi;
    if (threadIdx.x < 4) ((volatile LAS unsigned*)(lds + LDS_BARST))[threadIdx.x] = 0u;
    __syncthreads();
#define PH_BEGIN() int tid = threadIdx.x; asm volatile("" : "+v"(tid)); const int lane = tid & 63, wave = __builtin_amdgcn_readfirstlane(tid >> 6); (void)lane; (void)wave; \
    KArgP pk = (KArgP)__builtin_amdgcn_kernarg_segment_ptr(); asm volatile("" : "+s"(pk)); unsigned char* const ws = pk->ws; unsigned char* const wl = ws + l * WL_STRIDE; (void)wl; \
    const int G = gridDim.x, bx = blockIdx.x; (void)G; (void)bx
#define RUN(k) (ph_lo <= (k) && (k) < ph_hi)
#define EN(j) ((PHM >> (j)) & 1)
#ifndef REP
#define REP 0
#endif
#define REPL(j) _Pragma("unroll 1") for (int rep_ = (((REP) >> (j)) & 1) ? 0 : 1; rep_ < 2; ++rep_)
#define STAMP(i) do { if (PROBE && blockIdx.x == 0 && threadIdx.x == 0) { KArgP pq = (KArgP)__builtin_amdgcn_kernarg_segment_ptr(); asm volatile("" : "+s"(pq)); ((unsigned long long*)(pq->ws + WS_DBG))[i] = __builtin_amdgcn_s_memrealtime(); } } while (0)
#define SEAM(k) do { if (RUN(k) && RUN((k) + 1)) { if ((k) == 0) { grid.sync(); KArgP pb = (KArgP)__builtin_amdgcn_kernarg_segment_ptr(); asm volatile("" : "+s"(pb)); (void)xcd_barrier_post((unsigned*)(pb->ws + WS_BAR), (volatile LAS unsigned*)(lds + LDS_BARST)); } \
        else { KArgP pb = (KArgP)__builtin_amdgcn_kernarg_segment_ptr(); asm volatile("" : "+s"(pb)); XcdBarrier xb_; xb_.bar = (unsigned*)(pb->ws + WS_BAR); xb_.x = xb_xcc_id(); xb_.st = (volatile LAS unsigned*)(lds + LDS_BARST); xcd_barrier(xb_); } } STAMP((k) + 1); } while (0)
#define WSP(T_, off) ((T_*)(ws + (off)))
#ifndef LOCAL_SEAMS
#define LOCAL_SEAMS 0
#endif
#define SEAM_L(k) do { if (LOCAL_SEAMS && (gridDim.x % 8u) == 0u) { if (RUN(k) && RUN((k) + 1)) { KArgP pb = (KArgP)__builtin_amdgcn_kernarg_segment_ptr(); asm volatile("" : "+s"(pb)); \
        group_barrier((unsigned*)(pb->ws + WS_BAR), (volatile LAS unsigned*)(lds + LDS_BARST), blockIdx.x % 8u, gridDim.x / 8u); } STAMP((k) + 1); } else SEAM(k); } while (0)
    STAMP(0);
#ifdef EXTRA_SYNC
    if (ph_hi - ph_lo > 1) { _Pragma("unroll 1") for (int i_ = 0; i_ < EXTRA_SYNC; ++i_) grid.sync(); }
#endif
    if (RUN(0) && EN(0)) { const int l = 0; PH_BEGIN(); if (bx == 0) { for (int i = tid; i < 8192 + 256; i += 512) ((unsigned*)(ws + WS_BAR))[i] = 0u;   } const Params& Pc = *(const Params*)pk; prologue(Pc, lds, tid, lane, wave, bx, G); }
    SEAM(0);
#pragma unroll 1
    for (int l = 0; l < NLAYER; ++l) {
        const int p0 = 1 + 9 * l;
        if (RUN(p0) && EN(1)) REPL(1) {
            PH_BEGIN();
            pg8::Gemm g{WSP(bf16, WS_XB), (const bf16*)(wl + WL_WIN), T, 5120, D, D, D}; pg8::StaticOrder S; S.init(T, 5120, G, bx);
            EpiIn E{WSP(bf16, WS_Q), WSP(bf16, WS_K), WSP(bf16, WS_V), WSP(bf16, WS_U), WSP(bf16, WS_UPOOL), WSP(bf16, WS_GATES), WSP(float, WS_FLOG), WSP(float, WS_SSQ),
                    pk->in[I_QN] + l * 64, pk->in[I_KN] + l * 64, pk->in[I_BG] + l * 3072, pk->in[I_BF] + l * 8};
            pg8::gemm_phase<EpiIn, pg8::StaticOrder, true, true>(lds, g, S, E);
            for (int pm = bx; pm < T / 256; pm += G) flog_panel(WSP(bf16, WS_XB), (const bf16*)(wl + WL_WIN) + (size_t)5120 * D, WSP(float, WS_SSQ), pk->in[I_BF] + l * 8, WSP(float, WS_FLOG), pm, wave, lane); }
        SEAM(p0);
        if (RUN(p0 + 1) && EN(2)) REPL(2) {
            PH_BEGIN();
            for (int sq = bx; sq < NB * 8; sq += G) fcum_seq(WSP(float, WS_FLOG), WSP(float, WS_KB), sq, lds, tid, lane, wave);
            pool_pass(WSP(bf16, WS_UPOOL), WSP(bf16, WS_ACAT), bx * 8 + wave, G * 8, lane);
            __syncthreads();
            pg8::Gemm g{WSP(bf16, WS_U), (const bf16*)(wl + WL_MEND), 16 * 2048, 16 * 256, 512, UP, 512}; BatchOrder S{16, 8, 1, G, bx};
            EpiSend E{WSP(float, WS_S)};
            pg8::gemm_phase<EpiSend, BatchOrder, true, true>(lds, g, S, E); }
        SEAM(p0 + 1);
        if (RUN(p0 + 2) && EN(3)) {
            { PH_BEGIN();
              for (int gid = bx * 512 + tid; gid < 16384; gid += G * 512) state_scan(WSP(float, WS_S), (const float*)(wl + WL_DL), WSP(bf16, WS_U), gid);
              __syncthreads(); }
            { PH_BEGIN();
              float sb; { const float qa = fabsf(pk->in[I_QN][l * 64 + lane]), ka = fabsf(pk->in[I_KN][l * 64 + lane]); float qm = qa, km = ka;
#pragma unroll
                  for (int o = 1; o < 64; o <<= 1) { qm = fmaxf(qm, __shfl_xor(qm, o)); km = fmaxf(km, __shfl_xor(km, o)); }
                  sb = __uint_as_float(__builtin_amdgcn_readfirstlane(__float_as_uint(64.0f * C2Q * qm * km * 1.02f + 1.0f))); }
              const attn_body::AttnTensors AT{WSP(const attn_body::bf16, WS_Q), WSP(const attn_body::bf16, WS_K), WSP(const attn_body::bf16, WS_V), WSP(attn_body::bf16, WS_ACAT), WSP(const float, WS_KB)};
              attn_body::attn_phase<8>((char*)lds_raw, AT, sb, (unsigned*)(ws + WS_BAR) + 8192 + 64 * l, bx, G); } }
        SEAM(p0 + 2);
        if (RUN(p0 + 3) && EN(4)) REPL(4) {
            PH_BEGIN();
            pg8::Gemm g{WSP(bf16, WS_U), (const bf16*)(wl + WL_TZ), 16 * 2048, 16 * 512, UP, UP, UP}; BatchOrder S{16, 8, 2, G, bx};
            EpiSsmY E{WSP(bf16, WS_U), pk->in[I_SD] + l * 256, WSP(bf16, WS_YPRE)};
            pg8::gemm_phase<EpiSsmY, BatchOrder, true, true>(lds, g, S, E); }
        SEAM(p0 + 3);
        if (RUN(p0 + 4) && EN(5)) REPL(5) {
            PH_BEGIN();
            pg8::Gemm g{WSP(bf16, WS_YPRE), (const bf16*)(wl + WL_WGLU), T, 512, 256, 256, 256}; pg8::StaticOrder S; S.init(T, 512, G, bx);
            EpiGlu E{WSP(bf16, WS_ACAT)};
            pg8::gemm_phase<EpiGlu, pg8::StaticOrder, true, true>(lds, g, S, E); }
        SEAM_L(p0 + 4);
        if (RUN(p0 + 5) && EN(6)) REPL(6) {
            PH_BEGIN(); TriOrder S; S.S.init(T, D, G, bx);
            pg8::Gemm g{WSP(bf16, WS_ACAT), (const bf16*)(wl + WL_WA), T, D, 512, 1024, 1024}; EpiGate3 E{WSP(bf16, WS_GATES), WSP(bf16, WS_MERGED)};
            pg8::gemm_phase<EpiGate3, TriOrder, true, true>(lds, g, S, E); }
        SEAM_L(p0 + 5);
        if (RUN(p0 + 6) && EN(7)) REPL(7) {
            PH_BEGIN();
            pg8::Gemm g{WSP(bf16, WS_MERGED), (const bf16*)(wl + WL_WOUT), T, D, D, D, D}; pg8::StaticOrder S; S.init(T, D, G, bx);
            EpiRes<0> E{(l == 0) ? pk->in[I_X] : (const float*)pk->out, nullptr, WSP(bf16, WS_XB), WSP(float, WS_SSQ1), true, nullptr};
            pg8::gemm_phase<EpiRes<0>, pg8::StaticOrder, true, true>(lds, g, S, E); }
        SEAM_L(p0 + 6);
        if (RUN(p0 + 7) && EN(8)) REPL(8) {
            PH_BEGIN();
            pg8::Gemm g{WSP(bf16, WS_XB), (const bf16*)(wl + WL_WUP), T, FF, D, D, D}; pg8::StaticOrder S; S.init(T, FF, G, bx);
            EpiUp E{WSP(bf16, WS_ACT)};
            pg8::gemm_phase<EpiUp, pg8::StaticOrder, true, true>(lds, g, S, E); }
        SEAM_L(p0 + 7);
        if (RUN(p0 + 8) && EN(9)) REPL(9) {
            PH_BEGIN();
            pg8::Gemm g{WSP(bf16, WS_ACT), (const bf16*)(wl + WL_WDN), T, D, FF, FF, FF}; pg8::StaticOrder S; S.init(T, D, G, bx);
            EpiRes<1> E{nullptr, pk->out, WSP(bf16, WS_XB), WSP(float, WS_SSQ), l + 1 < NLAYER, WSP(const float, WS_SSQ1)};
            pg8::gemm_phase<EpiRes<1>, pg8::StaticOrder, true, true>(lds, g, S, E); }
        SEAM(p0 + 8);
    }
#if PROBE
    grid.sync(); STAMP(N_PHASES_);
    if (blockIdx.x == 0) { KArgP pq = (KArgP)__builtin_amdgcn_kernarg_segment_ptr(); const unsigned long long* ts = (const unsigned long long*)(pq->ws + WS_DBG); float* out = pq->out;
        if (threadIdx.x == 0) out[0] = (float)(ts[PROBE_A1] - ts[PROBE_A0]) * 0.0025f; }
#endif
#undef RUN
#undef SEAM
}
constexpr int N_PHASES = 1 + 9 * NLAYER;

#ifndef MK_PER_PHASE
#define MK_PER_PHASE 0
#endif
extern "C" void kernel_launch(void* const* d_in, const int* in_sizes, int n_in, void* d_out, int out_size, void* d_ws, size_t ws_size, hipStream_t stream) {
    static int grid = 0;
    if (grid == 0) {
        if (n_in != N_IN || in_sizes[0] != T * D || out_size != T * D || ws_size < WS_END) { fprintf(stderr, "kernel_launch: unexpected shapes (n_in %d, in0 %d, out %d, ws %zu)\n", n_in, n_in > 0 ? in_sizes[0] : -1, out_size, ws_size); grid = -1; return; }
        int dev = 0, cus = 0, per_cu = 0;
        if (hipGetDevice(&dev) != hipSuccess || hipDeviceGetAttribute(&cus, hipDeviceAttributeMultiprocessorCount, dev) != hipSuccess) { grid = -1; return; }
        if (hipFuncSetAttribute((const void*)fwd_kernel, hipFuncAttributeMaxDynamicSharedMemorySize, LDS_BYTES) != hipSuccess) { fprintf(stderr, "kernel_launch: hipFuncSetAttribute failed\n"); grid = -1; return; }
        if (hipOccupancyMaxActiveBlocksPerMultiprocessor(&per_cu, (const void*)fwd_kernel, 512, LDS_BYTES) != hipSuccess || per_cu < 1) { fprintf(stderr, "kernel_launch: occupancy query says %d\n", per_cu); per_cu = 1; }
        (void)hipGetLastError();
        grid = cus;
    }
    if (grid < 0) return;
    Params p{};
    for (int i = 0; i < N_IN; ++i) p.in[i] = (const float*)d_in[i];
    p.out = (float*)d_out; p.ws = (unsigned char*)d_ws; p.dbg = 0; p.pad = 0;
#if MK_PER_PHASE
    for (int k = 0; k < N_PHASES; ++k) { p.ph_lo = k; p.ph_hi = k + 1; hipLaunchKernelGGL(fwd_kernel, dim3(grid), dim3(512), LDS_BYTES, stream, p); }
#else
    p.ph_lo = 0; p.ph_hi = N_PHASES;
    void* args[] = {&p};
    const hipError_t e = hipLaunchCooperativeKernel((const void*)fwd_kernel, dim3(grid), dim3(512), args, LDS_BYTES, stream);
    if (e != hipSuccess) fprintf(stderr, "kernel_launch: cooperative launch failed: %s (grid %d)\n", hipGetErrorString(e), grid);
#endif
}
```

```cpp
#include <hip/hip_runtime.h>
#include <hip/hip_cooperative_groups.h>
#include <cstdio>
#include <cstdint>
namespace pg8 {
#define PG8_LAS __attribute__((address_space(3)))
typedef unsigned short bf16_t;
typedef short bf16x8 __attribute__((ext_vector_type(8)));
typedef float f32x4 __attribute__((ext_vector_type(4)));
typedef unsigned u32x4 __attribute__((ext_vector_type(4)));
constexpr int BM = 256, BK = 64, HALF = 128, HTB = HALF * BK * 2  , STAGE_BYTES = 8 * HTB, NXCD = 8, WGM = 8;

__host__ __device__ __forceinline__ int lds_byte(int r, int c) { const int st = (r >> 4) * 2 + (c >> 5), rr = r & 15, cc = c & 31, ob = rr * 64 + cc * 2; return st * 1024 + (ob ^ (((ob >> 9) & 1) << 5)); }
__host__ __device__ __forceinline__ void stage_rc(int b, int& R, int& C) { const int st = b / 1024, sb = b % 1024, swz = sb ^ (((sb >> 9) & 1) << 5); R = (st >> 1) * 16 + swz / 64; C = (st & 1) * 32 + (swz % 64) / 2; }
__host__ __device__ __forceinline__ int perm32(int rho) { const int n = rho >> 4, i = rho & 15; return 8 * (i >> 2) + 4 * n + (i & 3); }

struct Unit { int pm, pn, ko = 0, nt = 0; };
struct Gemm { const bf16_t* A; const bf16_t* Bt; int M, N, K, lda, ldb; };

struct StaticOrder {
    int nM, nN, nwg, G, c;
    __host__ __device__ void init(int M, int N, int G_, int c_) { nM = M / BM; nN = N / BM; nwg = nM * nN; G = G_; c = c_; }
    __host__ __device__ bool next(int i, Unit& u) const {
        const long L = (long)i * G + c; if (L >= nwg) return false;
        int wgid = (int)L; { const int q = nwg / NXCD, r = nwg % NXCD, xcd = wgid % NXCD, off = wgid / NXCD; wgid = (xcd < r ? xcd * (q + 1) : r * (q + 1) + (xcd - r) * q) + off; }
        const int nig = WGM * nN, gid = wgid / nig, fm = gid * WGM, gsz = (nM - fm) < WGM ? (nM - fm) : WGM;
        u.pm = fm + ((wgid % nig) % gsz); u.pn = (wgid % nig) / gsz; return true;
    }
    __device__ __forceinline__ void a_ready(const Unit&) const {}
    __device__ __forceinline__ void done(const Unit&) const {}
};

typedef float f32x2c_t __attribute__((ext_vector_type(2))); typedef __bf16 bf16x2c_t __attribute__((ext_vector_type(2)));
__device__ __forceinline__ unsigned cvt_pk_bf16(float lo, float hi) { const f32x2c_t v = {lo, hi}; const bf16x2c_t b = __builtin_convertvector(v, bf16x2c_t); return __builtin_bit_cast(unsigned, b); }
typedef float f32x2 __attribute__((ext_vector_type(2)));
__device__ __forceinline__ f32x2 gelu_pk(f32x2 v) {
    const f32x2 av = __builtin_elementwise_abs(v), d = av * 0.2316418882f + 1.0f;
    f32x2 t; t.x = __builtin_amdgcn_rcpf(d.x); t.y = __builtin_amdgcn_rcpf(d.y);
    f32x2 q = t * 0.5307027145f + (-0.7265760135f); q = q * t + 0.7107068705f; q = q * t + (-0.142248368f); q = q * t + 0.127414796f; q = q * t;
    const f32x2 s = (v * v) * (-0.72134752044f);
    f32x2 e; e.x = __builtin_amdgcn_exp2f(s.x); e.y = __builtin_amdgcn_exp2f(s.y);
    const f32x2 m = v * (q * e), r = v - m;
    f32x2 o; o.x = v.x < 0.f ? m.x : r.x; o.y = v.y < 0.f ? m.y : r.y; return o;
}

template <int ACT  > struct EpiBf16 {
    static constexpr bool PERM = true, AFTER_DRAIN = false, KEEP = false; static_assert(ACT == 0 || ACT == 1, "EpiBf16: ACT is 0 (none) or 1 (gelu_pk)");
    bf16_t* O; int ldc; const float* bias; int split_cols; size_t split_stride; float scale0;
    __device__ __forceinline__ void operator()(const f32x4 (&acc)[2][2][4][2], const Unit& u, int wr, int wc, int fr, int fq) const {
        const int row0 = u.pm * BM + wr * 64 + fr; int colt = u.pn * BM; bf16_t* base = O;
        float sc = 1.f; if (split_cols) { const int t = colt / split_cols; base += (size_t)t * split_stride; colt -= t * split_cols; if (t == 0) sc = scale0; }
        const int col0 = colt + wc * 32 + 8 * fq, bcol0 = u.pn * BM + wc * 32 + 8 * fq;
        f32x4 bv[2][2];
#pragma unroll
        for (int bj = 0; bj < 2; ++bj)
#pragma unroll
            for (int n = 0; n < 2; ++n) bv[bj][n] = bias ? *(const f32x4*)(bias + bcol0 + bj * HALF + 4 * n) : (f32x4){0.f, 0.f, 0.f, 0.f};
#pragma unroll
        for (int ai = 0; ai < 2; ++ai)
#pragma unroll
            for (int m = 0; m < 4; ++m) { bf16_t* rowp = base + (size_t)(row0 + ai * HALF + m * 16) * ldc + col0;
#pragma unroll
                for (int bj = 0; bj < 2; ++bj) { f32x4 v0 = acc[ai][bj][m][0] + bv[bj][0], v1 = acc[ai][bj][m][1] + bv[bj][1];
                    if (ACT == 1) { f32x2 a = gelu_pk((f32x2){v0[0], v0[1]}), b = gelu_pk((f32x2){v0[2], v0[3]}), c = gelu_pk((f32x2){v1[0], v1[1]}), d = gelu_pk((f32x2){v1[2], v1[3]});
                        v0 = (f32x4){a.x, a.y, b.x, b.y}; v1 = (f32x4){c.x, c.y, d.x, d.y}; }
                    v0 = v0 * sc; v1 = v1 * sc; u32x4 w; w.x = cvt_pk_bf16(v0[0], v0[1]); w.y = cvt_pk_bf16(v0[2], v0[3]); w.z = cvt_pk_bf16(v1[0], v1[1]); w.w = cvt_pk_bf16(v1[2], v1[3]);
                    *(u32x4*)(rowp + bj * HALF) = w; } }
    }
};


template <class Epi, class Sched, bool ALIGN_EPI = false, bool SP2 = false>
__device__ __forceinline__ void gemm_phase(PG8_LAS unsigned char* lds, const Gemm g, const Sched& S, const Epi& E) {
    int tid_l = threadIdx.x; asm volatile("" : "+v"(tid_l));
    const int tid = tid_l, wid = __builtin_amdgcn_readfirstlane(tid >> 6), lane = tid & 63, wr = wid >> 2, wc = wid & 3, fr = lane & 15, fq = lane >> 4;
    const int K = g.K, nt = K / BK;
    unsigned voffA[2], voffB[2];
#pragma unroll
    for (int i = 0; i < 2; ++i) { int R, C; stage_rc(tid * 16 + i * 8192, R, C); const int Rb = Epi::PERM ? ((R & ~31) + perm32(R & 31)) : R;
        voffA[i] = (unsigned)(R * g.lda + C) * 2u; voffB[i] = (unsigned)(Rb * g.ldb + C) * 2u; }
    const size_t kstep = (size_t)(BK * 2);
    const size_t hstepA = (size_t)HALF * g.lda * 2, hstepB = (size_t)HALF * g.ldb * 2;
    const size_t tstepA = 2 * hstepA, tstepB = 2 * hstepB;
    const unsigned ldsw = (unsigned)wid * 1024u;
    const int aoff = lds_byte(wr * 64 + fr, fq * 8), boff = lds_byte(wc * 32 + fr, fq * 8);
#define PG8_SA(b, h) (((b) * 2 + (h)) * HTB)
#define PG8_SB(b, h) ((4 + (b) * 2 + (h)) * HTB)
#define PG8_STAGE(bufoff, gbase, voff) do { _Pragma("unroll") for (int _i = 0; _i < 2; ++_i) \
        __builtin_amdgcn_global_load_lds((const unsigned*)((const char*)(gbase) + (voff)[_i]), (PG8_LAS unsigned*)(lds + (bufoff) + ldsw + _i * 8192), 16, 0, 0); } while (0)
#define PG8_LDA(dst, b, h) do { _Pragma("unroll") for (int m = 0; m < 4; ++m) _Pragma("unroll") for (int k = 0; k < 2; ++k) dst[m][k] = *(const PG8_LAS bf16x8*)(lds + PG8_SA(b, h) + aoff + m * 2048 + k * 1024); } while (0)
#define PG8_LDB(dst, b, h) do { _Pragma("unroll") for (int n = 0; n < 2; ++n) _Pragma("unroll") for (int k = 0; k < 2; ++k) dst[n][k] = *(const PG8_LAS bf16x8*)(lds + PG8_SB(b, h) + boff + n * 2048 + k * 1024); } while (0)
#define PG8_MMA(ai, bj, At, Bt) do { __builtin_amdgcn_s_setprio(1); _Pragma("unroll") for (int m = 0; m < 4; ++m) _Pragma("unroll") for (int n = 0; n < 2; ++n) _Pragma("unroll") for (int k = 0; k < 2; ++k) \
        acc[ai][bj][m][n] = __builtin_amdgcn_mfma_f32_16x16x32_bf16(Bt[n][k], At[m][k], acc[ai][bj][m][n], 0, 0, 0); __builtin_amdgcn_s_setprio(0); } while (0)
#define PG8_WAIT_V(n) asm volatile("s_waitcnt vmcnt(" #n ")" ::: "memory")
#define PG8_WAIT_L(n) asm volatile("s_waitcnt lgkmcnt(" #n ")" ::: "memory")
#define PG8_BAR __builtin_amdgcn_s_barrier()
#define PG8_SCHED __builtin_amdgcn_sched_barrier(0)
    Unit cur, nxt; int ui = 0;
    if (!S.next(0, cur)) return;
    f32x4 acc[2][2][4][2];
#pragma unroll
    for (int a = 0; a < 2; ++a)
#pragma unroll
        for (int b = 0; b < 2; ++b)
#pragma unroll
            for (int m = 0; m < 4; ++m)
#pragma unroll
                for (int n = 0; n < 2; ++n) acc[a][b][m][n] = (f32x4){0.f, 0.f, 0.f, 0.f};
    bf16x8 At[4][2], B0[2][2], B1[2][2];
    const char* cA = (const char*)g.A + (size_t)cur.pm * tstepA + (size_t)cur.ko * 2; const char* cB = (const char*)g.Bt + (size_t)cur.pn * tstepB + (size_t)cur.ko * 2;
    S.a_ready(cur);
    if constexpr (SP2) {
        PG8_STAGE(PG8_SB(0, 0), cB, voffB); PG8_STAGE(PG8_SB(0, 1), cB + hstepB, voffB); PG8_STAGE(PG8_SA(0, 0), cA, voffA); PG8_STAGE(PG8_SA(0, 1), cA + hstepA, voffA);
        if (wr == 1) PG8_BAR;
        PG8_WAIT_V(2); PG8_BAR;
        PG8_STAGE(PG8_SB(1, 0), cB + kstep, voffB); PG8_STAGE(PG8_SA(1, 0), cA + kstep, voffA); PG8_STAGE(PG8_SB(1, 1), cB + hstepB + kstep, voffB);
        PG8_WAIT_V(6); PG8_BAR;
    } else {
        PG8_STAGE(PG8_SB(0, 0), cB, voffB); PG8_STAGE(PG8_SA(0, 0), cA, voffA); PG8_STAGE(PG8_SB(0, 1), cB + hstepB, voffB); PG8_STAGE(PG8_SA(0, 1), cA + hstepA, voffA);
        if (wr == 1) PG8_BAR;
        PG8_WAIT_V(4); PG8_BAR;
        PG8_STAGE(PG8_SB(1, 0), cB + kstep, voffB); PG8_STAGE(PG8_SA(1, 0), cA + kstep, voffA); PG8_STAGE(PG8_SB(1, 1), cB + hstepB + kstep, voffB);
        PG8_WAIT_V(6); PG8_BAR;
    }
    for (;;) {
        const bool has_next = S.next(ui + 1, nxt);
        const char* nA = has_next ? (const char*)g.A + (size_t)nxt.pm * tstepA + (size_t)nxt.ko * 2 : cA; const char* nB = has_next ? (const char*)g.Bt + (size_t)nxt.pn * tstepB + (size_t)nxt.ko * 2 : cB;
        const int ntu = cur.nt ? cur.nt : nt;
#pragma unroll 1
        for (int t = 0; t < ntu; t += 2) {
            const bool last = (t == ntu - 2);
            const char* a1 = cA + (size_t)(t + 1) * kstep;
            const char* a2 = last ? nA : cA + (size_t)(t + 2) * kstep; const char* b2 = last ? nB : cB + (size_t)(t + 2) * kstep;
            const char* a3 = a2 + kstep; const char* b3 = b2 + kstep;
            if (last && has_next) S.a_ready(nxt);
            if constexpr (SP2) {
            PG8_LDB(B0, 0, 0); PG8_LDB(B1, 0, 1); PG8_SCHED; PG8_LDA(At, 0, 0); PG8_STAGE(PG8_SA(1, 1), a1 + hstepA, voffA);
            PG8_WAIT_V(8); PG8_WAIT_L(0); PG8_BAR; PG8_MMA(0, 0, At, B0); PG8_MMA(0, 1, At, B1); PG8_BAR; PG8_SCHED;
            PG8_LDA(At, 0, 1); PG8_STAGE(PG8_SB(0, 0), b2, voffB); PG8_STAGE(PG8_SB(0, 1), b2 + hstepB, voffB); PG8_STAGE(PG8_SA(0, 0), a2, voffA);
            PG8_WAIT_V(8); PG8_WAIT_L(0); PG8_BAR; PG8_MMA(1, 0, At, B0); PG8_MMA(1, 1, At, B1); PG8_BAR; PG8_SCHED;
            PG8_LDB(B0, 1, 0); PG8_LDB(B1, 1, 1); PG8_SCHED; PG8_LDA(At, 1, 0); PG8_STAGE(PG8_SA(0, 1), a2 + hstepA, voffA);
            PG8_WAIT_V(8); PG8_WAIT_L(0); PG8_BAR; PG8_MMA(0, 0, At, B0); PG8_MMA(0, 1, At, B1); PG8_BAR; PG8_SCHED;
            PG8_LDA(At, 1, 1); PG8_STAGE(PG8_SB(1, 0), b3, voffB); PG8_STAGE(PG8_SB(1, 1), b3 + hstepB, voffB); PG8_STAGE(PG8_SA(1, 0), a3, voffA);
            PG8_WAIT_V(8); PG8_WAIT_L(0); PG8_BAR; PG8_MMA(1, 0, At, B0); PG8_MMA(1, 1, At, B1); PG8_BAR; PG8_SCHED;
            } else {
            PG8_LDB(B0, 0, 0); PG8_SCHED; PG8_LDA(At, 0, 0); PG8_STAGE(PG8_SA(1, 1), a1 + hstepA, voffA);
            PG8_WAIT_L(8); PG8_BAR; PG8_WAIT_L(0); PG8_MMA(0, 0, At, B0); PG8_BAR; PG8_SCHED;
            PG8_LDB(B1, 0, 1); PG8_STAGE(PG8_SB(0, 0), b2, voffB);
            PG8_BAR; PG8_WAIT_L(0); PG8_MMA(0, 1, At, B1); PG8_BAR;
            PG8_LDA(At, 0, 1); PG8_STAGE(PG8_SA(0, 0), a2, voffA);
            PG8_BAR; PG8_WAIT_L(0); PG8_MMA(1, 0, At, B0); PG8_BAR; PG8_SCHED;
            PG8_STAGE(PG8_SB(0, 1), b2 + hstepB, voffB);
            PG8_WAIT_V(6); PG8_BAR; PG8_MMA(1, 1, At, B1); PG8_BAR;
            PG8_LDB(B0, 1, 0); PG8_SCHED; PG8_LDA(At, 1, 0); PG8_STAGE(PG8_SA(0, 1), a2 + hstepA, voffA);
            PG8_WAIT_L(8); PG8_BAR; PG8_WAIT_L(0); PG8_MMA(0, 0, At, B0); PG8_BAR; PG8_SCHED;
            PG8_LDB(B1, 1, 1); PG8_STAGE(PG8_SB(1, 0), b3, voffB);
            PG8_BAR; PG8_WAIT_L(0); PG8_MMA(0, 1, At, B1); PG8_BAR;
            PG8_LDA(At, 1, 1); PG8_STAGE(PG8_SA(1, 0), a3, voffA);
            PG8_BAR; PG8_WAIT_L(0); PG8_MMA(1, 0, At, B0); PG8_BAR; PG8_SCHED;
            PG8_STAGE(PG8_SB(1, 1), b3 + hstepB, voffB);
            PG8_WAIT_V(6); PG8_BAR; PG8_MMA(1, 1, At, B1); PG8_BAR;
            }
        }
        if constexpr (ALIGN_EPI) { if (wr == 0) PG8_BAR; }
        if constexpr (!Epi::AFTER_DRAIN) { E(acc, cur, wr, wc, fr, fq); S.done(cur); }
        if (!has_next) break;
        bool keep_acc = false; if constexpr (Epi::KEEP) keep_acc = E.keep(cur);
        if (!keep_acc) {
#pragma unroll
        for (int a = 0; a < 2; ++a)
#pragma unroll
            for (int b = 0; b < 2; ++b)
#pragma unroll
                for (int m = 0; m < 4; ++m)
#pragma unroll
                    for (int n = 0; n < 2; ++n) acc[a][b][m][n] = (f32x4){0.f, 0.f, 0.f, 0.f};
        }
        cur = nxt; cA = nA; cB = nB; ++ui;
        if constexpr (ALIGN_EPI) { if (wr == 1) PG8_BAR; }
    }
    PG8_WAIT_V(0);
    if constexpr (!ALIGN_EPI) { if (wr == 0) PG8_BAR; }
    PG8_BAR;
    if constexpr (Epi::AFTER_DRAIN) { E.fused(acc, cur, wr, wc, fr, fq, lds, wid, lane); S.done(cur); }
#undef PG8_SA
#undef PG8_SB
#undef PG8_STAGE
#undef PG8_LDA
#undef PG8_LDB
#undef PG8_MMA
#undef PG8_WAIT_V
#undef PG8_WAIT_L
#undef PG8_BAR
#undef PG8_SCHED
}
}
#include <hip/hip_bf16.h>
#include <cmath>
namespace attn_body {
using bf16=__hip_bfloat16;
using bf16x8=__attribute__((ext_vector_type(8)))short;
using s16x4=__attribute__((ext_vector_type(4)))short;
using f32x16=__attribute__((ext_vector_type(16)))float;
using u32x4=__attribute__((ext_vector_type(4)))unsigned;
using f32x4_t=__attribute__((ext_vector_type(4)))float;
constexpr int BATCH=16,NHEAD=8,SEQ=4096,D=64,DM=NHEAD*D;
constexpr int NW=8,QBLK=32,QB=QBLK*NW,KVBLK=64,NQB=SEQ/QB;
constexpr int ATTN_PITCH=DM, ATTN_UNIT_ROWS=QB, OPITCH=1024;
__device__ __forceinline__ int crow(int r,int hi){return (r&3)+8*(r>>2)+4*hi;}
#define SBAR() __builtin_amdgcn_sched_barrier(0)
__device__ __forceinline__ void cmask(f32x16&p0,f32x16&p1,int jb,int qrel,int hi){
  const float NEG=-INFINITY; int kb=64*jb+4*hi;
  #pragma unroll
  for(int r=0;r<16;++r){int kv=kb+(r&3)+8*(r>>2); if(kv>qrel)p0[r]=NEG; if(kv+32>qrel)p1[r]=NEG;}
}

constexpr int NSLOT=3, SLOTB=8192;
constexpr int LDS_K=0, LDS_V=NSLOT*SLOTB, LDS_WS=2*NSLOT*SLOTB, LDS_OST=LDS_WS+NW*64*4, LDS_KB=LDS_OST+NW*4096, LDS_NXT=LDS_KB+SEQ*4, LDS_BYTES=LDS_NXT+16;
constexpr float C2=0.125f*1.4426950408889634f;
__device__ __forceinline__ void glds16(const void*gsrc,unsigned lds_dst){unsigned keep;
  asm volatile("s_mov_b32 %0, m0\n\ts_mov_b32 m0, %2\n\ts_nop 0\n\tglobal_load_lds_dwordx4 %1, off\n\ts_mov_b32 m0, %0":"=&s"(keep):"v"(gsrc),"s"(lds_dst):"memory");}
__device__ __forceinline__ float max3f(float a,float b,float c){float r;asm("v_max3_f32 %0, %1, %2, %3":"=v"(r):"v"(a),"v"(b),"v"(c));return r;}
__device__ __forceinline__ float max2f(float a,float b){float r;asm("v_max_f32_e32 %0, %1, %2":"=v"(r):"v"(a),"v"(b));return r;}
__device__ __forceinline__ float fadd_s(float a,float b){float r;asm("v_add_f32_e32 %0, %1, %2":"=v"(r):"v"(a),"v"(b));return r;}
__device__ __forceinline__ float fsub_s(float a,float b){float r;asm("v_sub_f32_e32 %0, %1, %2":"=v"(r):"v"(a),"v"(b));return r;}
typedef float f32x2_t __attribute__((ext_vector_type(2))); typedef __bf16 bf16x2_t __attribute__((ext_vector_type(2)));
__device__ __forceinline__ unsigned cvtpk_s(float lo,float hi){f32x2_t v={lo,hi};bf16x2_t b=__builtin_convertvector(v,bf16x2_t);return __builtin_bit_cast(unsigned,b);}
#define WAIT_BAR(N) asm volatile("s_waitcnt vmcnt(" #N ") lgkmcnt(0)\n\ts_barrier":::"memory")

__device__ __forceinline__ void qkt(f32x16&p0,f32x16&p1,const char*Kslot,const bf16x8*qr,int r32,int hi){
  const char*kb=Kslot+hi*1024+r32*16;
  #pragma unroll
  for(int d0=0;d0<4;++d0){
    const bf16x8 b0=*reinterpret_cast<const bf16x8*>(kb+d0*2048);
    const bf16x8 b1=*reinterpret_cast<const bf16x8*>(kb+d0*2048+512);
    {p0=__builtin_amdgcn_mfma_f32_32x32x16_bf16(b0,qr[d0],p0,0,0,0);p1=__builtin_amdgcn_mfma_f32_32x32x16_bf16(b1,qr[d0],p1,0,0,0);}}
}
typedef __attribute__((address_space(3))) const char* lds_cptr;
typedef short v4i16_t __attribute__((ext_vector_type(4)));
__device__ __forceinline__ void kload8(bf16x8*kf,lds_cptr kp){
  kf[0]=*(const __attribute__((address_space(3))) bf16x8*)(kp);      kf[1]=*(const __attribute__((address_space(3))) bf16x8*)(kp+512);
  kf[2]=*(const __attribute__((address_space(3))) bf16x8*)(kp+2048); kf[3]=*(const __attribute__((address_space(3))) bf16x8*)(kp+2560);
  kf[4]=*(const __attribute__((address_space(3))) bf16x8*)(kp+4096); kf[5]=*(const __attribute__((address_space(3))) bf16x8*)(kp+4608);
  kf[6]=*(const __attribute__((address_space(3))) bf16x8*)(kp+6144); kf[7]=*(const __attribute__((address_space(3))) bf16x8*)(kp+6656);
}
__device__ __forceinline__ void kload2(bf16x8*kf,lds_cptr kp,int j){ kf[2*j]=*(const __attribute__((address_space(3))) bf16x8*)(kp+j*2048); kf[2*j+1]=*(const __attribute__((address_space(3))) bf16x8*)(kp+j*2048+512); }
__device__ __forceinline__ s16x4 vtr(lds_cptr p){ return __builtin_bit_cast(s16x4,__builtin_amdgcn_ds_read_tr16_b64_v4i16((__attribute__((address_space(3))) v4i16_t*)p)); }
__device__ __forceinline__ float rowmax(const f32x16&p0,const f32x16&p1){
  float a=max3f(p0[0],p0[1],p1[0]),b=max3f(p0[2],p0[3],p1[1]);a=max3f(a,p1[2],p1[3]);
  #pragma unroll
  for(int r=4;r<16;r+=4){a=max3f(a,p0[r],p0[r+1]);b=max3f(b,p0[r+2],p0[r+3]);a=max3f(a,p1[r],p1[r+1]);b=max3f(b,p1[r+2],p1[r+3]);}
  const float m=max2f(a,b);
  auto rr=__builtin_amdgcn_permlane32_swap(__float_as_uint(m),__float_as_uint(m),false,false);
  return max2f(__uint_as_float(rr[0]),__uint_as_float(rr[1]));
}
__device__ __forceinline__ void pv(f32x16*o,int vb,bf16x8 pa0,bf16x8 pa1,bf16x8 pa2,bf16x8 pa3){
  #pragma unroll
  for(int d0=0;d0<2;++d0){s16x4 lo[4],hi[4];
    #pragma unroll
    for(int ks=0;ks<4;++ks){
      asm volatile("ds_read_b64_tr_b16 %0,%1 offset:%c2":"=&v"(lo[ks]):"v"(vb),"i"(d0*4096+ks*1024):"memory");
      asm volatile("ds_read_b64_tr_b16 %0,%1 offset:%c2":"=&v"(hi[ks]):"v"(vb),"i"(d0*4096+ks*1024+512):"memory");}
    asm volatile("s_waitcnt lgkmcnt(0)":::"memory");SBAR();
    #define PK(k) (bf16x8){lo[k][0],lo[k][1],lo[k][2],lo[k][3],hi[k][0],hi[k][1],hi[k][2],hi[k][3]}
    o[d0]=__builtin_amdgcn_mfma_f32_32x32x16_bf16(pa0,PK(0),o[d0],0,0,0);
    o[d0]=__builtin_amdgcn_mfma_f32_32x32x16_bf16(pa1,PK(1),o[d0],0,0,0);
    o[d0]=__builtin_amdgcn_mfma_f32_32x32x16_bf16(pa2,PK(2),o[d0],0,0,0);
    o[d0]=__builtin_amdgcn_mfma_f32_32x32x16_bf16(pa3,PK(3),o[d0],0,0,0);
    #undef PK
  }
}

#ifndef ATTN_STORE16
#define ATTN_STORE16(p,v) (*(u32x4*)(p)=(v))
#endif
template<int THRL> __device__ __forceinline__ void attn_unit(int b,int h,int qb,const bf16*Q,const bf16*__restrict__ K,const bf16*__restrict__ V,bf16*O,const float*__restrict__ KBG,float sbound,unsigned*qctr,int qbase,int nxoff,char*shm){
  int tid_l=threadIdx.x; asm volatile("":"+v"(tid_l));
  const int tid=tid_l,lane=tid&63,r32=lane&31,hi=lane>>5; const int wid=__builtin_amdgcn_readfirstlane(tid>>6);
  const long rowbase=(long)b*SEQ; const int q0=qb*QB;
  const bf16*Qw=Q+(rowbase+q0+wid*QBLK)*DM+h*D;
  const bf16*Kh=K+rowbase*DM+h*D,*Vh=V+rowbase*DM+h*D;
  const lds_cptr shm3=(lds_cptr)shm;
  const unsigned lds0=(unsigned)(uintptr_t)shm;
  float*wsf=(float*)(shm+LDS_WS)+wid*64;
  const bf16*ksrc_=Kh+(long)lane*DM+wid*8;
  const bf16*vsrc_=Vh+(long)(16*(wid&3)+(lane>>2))*DM+(wid>>2)*32+(lane&3)*8;
  const unsigned kdst=lds0+LDS_K+wid*1024, vdst=lds0+LDS_V+wid*1024;
  #define DMA_K(t,slot) glds16(ksrc+(long)(t)*KVBLK*DM,(unsigned)__builtin_amdgcn_readfirstlane(kdst+(slot)))
  #define DMA_V(t,slot) glds16(vsrc+(long)(t)*KVBLK*DM,(unsigned)__builtin_amdgcn_readfirstlane(vdst+(slot)))
  const int vb0=(int)(lds0+LDS_V)+((lane>>4)&1)*32+(lane&3)*8+(4*hi+((lane&15)>>2))*64;
  const char*Kbase=shm+LDS_K; bf16x8 kf[8];
  const lds_cptr kp0=shm3+LDS_K+hi*1024+r32*16; const lds_cptr vp0=shm3+LDS_V+((lane>>4)&1)*32+(lane&3)*8+(4*hi+((lane&15)>>2))*64;
  int NT=(q0+QB)/KVBLK;
  {
    const float*kg=KBG+((long)b*NHEAD+h)*SEQ; const float ref=kg[q0]; float*kbl=(float*)(shm+LDS_KB);
    for(int j=tid;j<q0+QB;j+=NW*64)kbl[j]=kg[j]-ref;
    if(tid==0){ const unsigned nx=__hip_atomic_fetch_add(qctr,1u,__ATOMIC_RELAXED,__HIP_MEMORY_SCOPE_AGENT); *(volatile unsigned*)(shm+LDS_NXT+nxoff)=nx+(unsigned)qbase; }
    asm volatile("s_waitcnt vmcnt(0) lgkmcnt(0)\n\ts_barrier":::"memory"); }
  int tskip; { const float*kbl=(const float*)(shm+LDS_KB); const bool dead=(lane<NT-4)&&(kbl[64*lane+63]+sbound<-140.f); tskip=__builtin_popcountll(__ballot(dead))&~1; }
  tskip=__builtin_amdgcn_readfirstlane(tskip); NT-=tskip;
  const bf16*ksrc=ksrc_+(long)tskip*KVBLK*DM; const bf16*vsrc=vsrc_+(long)tskip*KVBLK*DM;
  const __attribute__((address_space(3))) float*kbp0=(const __attribute__((address_space(3))) float*)(shm3+LDS_KB)+4*hi+64*tskip;
  DMA_K(0,0);DMA_V(0,0);DMA_K(1,SLOTB);
  bf16x8 qr[4];
  #pragma unroll
  for(int d0=0;d0<4;++d0)qr[d0]=*reinterpret_cast<const bf16x8*>(&Qw[(long)r32*DM+d0*16+hi*8]);
  float mhat=0.f,l_reg=0.f;f32x16 o[2];o[0]=f32x16{};o[1]=f32x16{};
  const int qrel=wid*QBLK+r32;
  #define CMASK(P0,P1,t) do{int jb_=(t)-(NT-4); if(jb_>=0)cmask(P0,P1,jb_,qrel,hi);}while(0)
  #define KBP(t,i) (kbp0+64*(t)+(((i)<4)?8*(i):32+8*((i)-4)))
  #define KINIT(P0,P1,t,MH) do{ _Pragma("unroll") for(int k_=0;k_<4;++k_){ const f32x4_t a_=*(const __attribute__((address_space(3))) f32x4_t*)KBP(t,k_); const f32x4_t b_=*(const __attribute__((address_space(3))) f32x4_t*)KBP(t,k_+4); \
      P0[4*k_]=a_[0]-(MH);P0[4*k_+1]=a_[1]-(MH);P0[4*k_+2]=a_[2]-(MH);P0[4*k_+3]=a_[3]-(MH); P1[4*k_]=b_[0]-(MH);P1[4*k_+1]=b_[1]-(MH);P1[4*k_+2]=b_[2]-(MH);P1[4*k_+3]=b_[3]-(MH); } }while(0)
  #define KLD(G,t,i,P) do{ if(G){ const f32x4_t a_=*(const __attribute__((address_space(3))) f32x4_t*)KBP((t)+1,i); P[4*((i)&3)]=a_[0]; P[4*((i)&3)+1]=a_[1]; P[4*((i)&3)+2]=a_[2]; P[4*((i)&3)+3]=a_[3]; } }while(0)
  #define KSUB(G,i,P) do{ if(G){ P[4*((i)&3)]-=mhat; P[4*((i)&3)+1]-=mhat; P[4*((i)&3)+2]-=mhat; P[4*((i)&3)+3]-=mhat; } }while(0)
  bool resc=false;
  #define START(P0,P1) do{ const float rm=rowmax(P0,P1); resc=false; \
    { const float dl=__builtin_fmaxf(rm,0.f); mhat=fadd_s(mhat,dl); \
      _Pragma("unroll") for(int r=0;r<16;++r){P0[r]=fsub_s(P0[r],dl);P1[r]=fsub_s(P1[r],dl);} \
      } \
    _Pragma("unroll") for(int r=0;r<16;++r)P0[r]=__builtin_amdgcn_exp2f(P0[r]); }while(0)
  #define RESC() do{ if(resc){ asm volatile("s_waitcnt lgkmcnt(0)":::"memory"); \
      _Pragma("unroll") for(int d_=0;d_<2;++d_) _Pragma("unroll") for(int r=0;r<16;++r)o[d_][r]*=wsf[crow(r,hi)]; } }while(0)
  int sl_prev=0,sl_cur=0,sl_next=SLOTB;
  #define ROT() do{sl_prev=sl_cur;sl_cur=sl_next;sl_next=(sl_next==(NSLOT-1)*SLOTB)?0:sl_next+SLOTB;}while(0)
  DMA_K(2,2*SLOTB);
  WAIT_BAR(3);
  f32x16 pA0,pA1,pB0,pB1;
  mhat=((const float*)(shm+LDS_KB))[q0+qrel];
  KINIT(pA0,pA1,0,mhat);
  qkt(pA0,pA1,Kbase,qr,r32,hi);asm volatile("s_nop 15\n\ts_nop 7":"+v"(pA0),"+v"(pA1));CMASK(pA0,pA1,0);
  START(pA0,pA1);
  KINIT(pB0,pB1,1,mhat);
  _Pragma("unroll") for(int r=0;r<16;++r)pA1[r]=__builtin_amdgcn_exp2f(pA1[r]);
  WAIT_BAR(0);
  DMA_K(3,0);DMA_V(1,SLOTB);
  ROT();
  kload8(kf,kp0+sl_cur);
  WAIT_BAR(2);
  s16x4 vlo[8],vhi[8]; u32x4 pw0,pw1,pw2,pw3;
  #define PKW(P,B) cvtpk_s(P[B],P[B+1])
  #define PAF(k) __builtin_bit_cast(bf16x8,pw##k)
  #define VFR(i) (bf16x8){vlo[i][0],vlo[i][1],vlo[i][2],vlo[i][3],vhi[i][0],vhi[i][1],vhi[i][2],vhi[i][3]}
  #define PIN(x) asm volatile("":"+v"(x))
  #define MX3(a,b,c) __builtin_fmaxf(__builtin_fmaxf((a),(b)),(c))
  #define GAPA(MF,A0,A1,A2,A3,W0,W1,PW) do{ MF; sacc+=A0; sacc+=A1; sacc+=A2; sacc+=A3; PIN(sacc); W0; W1; PIN(PW); SBAR(); }while(0)
  #define EX(v) __builtin_amdgcn_exp2f(v)
  #define GAPB(MF,X,B) do{ MF; X[B]=EX(X[B]); X[B+1]=EX(X[B+1]); X[B+2]=EX(X[B+2]); X[B+3]=EX(X[B+3]); PIN(X); SBAR(); }while(0)
  #define VRD(i) do{ vlo[i]=vtr(vp_+(((i)>>2)*4096+((i)&3)*1024)); vhi[i]=vtr(vp_+(((i)>>2)*4096+((i)&3)*1024+512)); }while(0)
  #define KRD(G,j) do{ if(G){ kload2(kf,kp0+sl_next,j); SBAR(); } }while(0)
  #define STEP(C0,C1,P0,P1,t,GK,GV,GL) do{ SBAR(); \
    const lds_cptr vp_=vp0+sl_prev; \
    VRD(0); SBAR(); float sacc=(P0[0]+P0[1]); \
    GAPA(C0=__builtin_amdgcn_mfma_f32_32x32x16_bf16(kf[0],qr[0],C0,0,0,0), P0[2],P0[3],P0[4],P0[5],     pw0[0]=PKW(P0,0), pw0[1]=PKW(P0,2), pw0); \
    VRD(4); SBAR(); GAPA(C1=__builtin_amdgcn_mfma_f32_32x32x16_bf16(kf[1],qr[0],C1,0,0,0), P0[6],P0[7],P0[8],P0[9],     pw0[2]=PKW(P0,4), pw0[3]=PKW(P0,6), pw0); \
    VRD(1); SBAR(); GAPA(C0=__builtin_amdgcn_mfma_f32_32x32x16_bf16(kf[2],qr[1],C0,0,0,0),   P0[10],P0[11],P0[12],P0[13], pw1[0]=PKW(P0,8), pw1[1]=PKW(P0,10), pw1); \
    VRD(5); SBAR(); GAPA(C1=__builtin_amdgcn_mfma_f32_32x32x16_bf16(kf[3],qr[1],C1,0,0,0),   P0[14],P0[15],P1[0],P1[1],   pw1[2]=PKW(P0,12),pw1[3]=PKW(P0,14), pw1); \
    VRD(2); SBAR(); GAPA(C0=__builtin_amdgcn_mfma_f32_32x32x16_bf16(kf[4],qr[2],C0,0,0,0),   P1[2],P1[3],P1[4],P1[5],     pw2[0]=PKW(P1,0), pw2[1]=PKW(P1,2), pw2); \
    VRD(6); SBAR(); GAPA(C1=__builtin_amdgcn_mfma_f32_32x32x16_bf16(kf[5],qr[2],C1,0,0,0),   P1[6],P1[7],P1[8],P1[9],     pw2[2]=PKW(P1,4), pw2[3]=PKW(P1,6), pw2); \
    VRD(3); SBAR(); GAPA(C0=__builtin_amdgcn_mfma_f32_32x32x16_bf16(kf[6],qr[3],C0,0,0,0),   P1[10],P1[11],P1[12],P1[13], pw3[0]=PKW(P1,8), pw3[1]=PKW(P1,10), pw3); \
    VRD(7); SBAR(); GAPA(C1=__builtin_amdgcn_mfma_f32_32x32x16_bf16(kf[7],qr[3],C1,0,0,0),   P1[14],P1[15],0.f,0.f,       pw3[2]=PKW(P1,12),pw3[3]=PKW(P1,14), pw3); \
    l_reg+=sacc; \
    if(GK){DMA_K((t)+3,sl_cur);} if(GV){DMA_V((t)+1,sl_next);} \
    CMASK(C0,C1,t); \
    { float a=MX3(C0[0],C0[1],C1[0]),b=MX3(C0[2],C0[3],C1[1]); a=MX3(a,C1[2],C1[3]); \
      _Pragma("unroll") for(int r=4;r<16;r+=4){a=MX3(a,C0[r],C0[r+1]);b=MX3(b,C0[r+2],C0[r+3]);a=MX3(a,C1[r],C1[r+1]);b=MX3(b,C1[r+2],C1[r+3]);} \
      float rm=__builtin_fmaxf(a,b); { auto rr=__builtin_amdgcn_permlane32_swap(__float_as_uint(rm),__float_as_uint(rm),false,false); rm=__builtin_fmaxf(__uint_as_float(rr[0]),__uint_as_float(rr[1])); } \
      resc=false; \
      if(__builtin_expect(__any(rm>(float)THRL),0)){ const float dl=__builtin_fmaxf(rm,0.f); mhat+=dl; \
        _Pragma("unroll") for(int r=0;r<16;++r){C0[r]-=dl;C1[r]-=dl;} \
        const float f=__builtin_amdgcn_exp2f(-dl); l_reg*=f; if(hi==0)wsf[r32]=f; resc=true; } } \
    SBAR(); \
    KLD(GL,t,0,P0); GAPB(o[0]=__builtin_amdgcn_mfma_f32_32x32x16_bf16(PAF(0),VFR(0),o[0],0,0,0), C0,0); \
    KLD(GL,t,1,P0); KSUB(GL,0,P0); GAPB(o[1]=__builtin_amdgcn_mfma_f32_32x32x16_bf16(PAF(0),VFR(4),o[1],0,0,0), C0,4); \
    KRD(GL,0); KLD(GL,t,2,P0); KSUB(GL,1,P0); GAPB(o[0]=__builtin_amdgcn_mfma_f32_32x32x16_bf16(PAF(1),VFR(1),o[0],0,0,0), C0,8); \
    KRD(GL,1); KLD(GL,t,3,P0); KSUB(GL,2,P0); GAPB(o[1]=__builtin_amdgcn_mfma_f32_32x32x16_bf16(PAF(1),VFR(5),o[1],0,0,0), C0,12); \
    KRD(GL,2); KLD(GL,t,4,P1); KSUB(GL,3,P0); GAPB(o[0]=__builtin_amdgcn_mfma_f32_32x32x16_bf16(PAF(2),VFR(2),o[0],0,0,0), C1,0); \
    KRD(GL,3); KLD(GL,t,5,P1); KSUB(GL,4,P1); GAPB(o[1]=__builtin_amdgcn_mfma_f32_32x32x16_bf16(PAF(2),VFR(6),o[1],0,0,0), C1,4); \
    KLD(GL,t,6,P1); KSUB(GL,5,P1); GAPB(o[0]=__builtin_amdgcn_mfma_f32_32x32x16_bf16(PAF(3),VFR(3),o[0],0,0,0), C1,8); \
    KLD(GL,t,7,P1); KSUB(GL,6,P1); GAPB(o[1]=__builtin_amdgcn_mfma_f32_32x32x16_bf16(PAF(3),VFR(7),o[1],0,0,0), C1,12); \
    KSUB(GL,7,P1); \
    }while(0)
  int t=1;
  #undef CMASK
  #define CMASK(P0,P1,t) do{}while(0)
  for(;t+5<NT;t+=2){
    STEP(pB0,pB1,pA0,pA1,t,true,true,true);     WAIT_BAR(2); RESC(); ROT();
    STEP(pA0,pA1,pB0,pB1,t+1,true,true,true);   WAIT_BAR(2); RESC(); ROT();
  }
  #undef CMASK
  #define CMASK(P0,P1,t) do{int jb_=(t)-(NT-4); if(jb_>=0)cmask(P0,P1,jb_,qrel,hi);}while(0)
  #define ENDW(tt) do{ if((tt)+3<NT){WAIT_BAR(2);} else if((tt)+2<NT){WAIT_BAR(1);} else {WAIT_BAR(0);} }while(0)
  for(;t+1<NT;t+=2){
    STEP(pB0,pB1,pA0,pA1,t,(t+3<NT),(t+1<NT),(t+1<NT));       ENDW(t);   RESC(); ROT();
    STEP(pA0,pA1,pB0,pB1,t+1,(t+4<NT),(t+2<NT),(t+2<NT));     ENDW(t+1); RESC(); ROT();
  }
  STEP(pB0,pB1,pA0,pA1,NT-1,false,false,false); RESC();
  { float sacc=pB0[0]+pB0[1]; _Pragma("unroll") for(int r=2;r<16;++r)sacc+=pB0[r]; _Pragma("unroll") for(int r=0;r<16;++r)sacc+=pB1[r]; l_reg+=sacc;
    pw0=(u32x4){PKW(pB0,0),PKW(pB0,2),PKW(pB0,4),PKW(pB0,6)};pw1=(u32x4){PKW(pB0,8),PKW(pB0,10),PKW(pB0,12),PKW(pB0,14)};pw2=(u32x4){PKW(pB1,0),PKW(pB1,2),PKW(pB1,4),PKW(pB1,6)};pw3=(u32x4){PKW(pB1,8),PKW(pB1,10),PKW(pB1,12),PKW(pB1,14)};
    SBAR(); pv(o,vb0+sl_cur,PAF(0),PAF(1),PAF(2),PAF(3)); }
  #undef PKW
  #undef PAF
  #undef VFR
  #undef PIN
  #undef MX3
  #undef GAPA
  #undef GAPB
  #undef EX
  #undef VRD
  #undef KRD
  #undef STEP
  #undef ENDW
  {auto rr=__builtin_amdgcn_permlane32_swap(__float_as_uint(l_reg),__float_as_uint(l_reg),false,false);l_reg=__uint_as_float(rr[0])+__uint_as_float(rr[1]);}
  if(hi==0)wsf[32+r32]=l_reg;asm volatile("s_waitcnt lgkmcnt(0)":::"memory");
  float rli[16];
  #pragma unroll
  for(int r=0;r<16;++r)rli[r]=__builtin_amdgcn_rcpf(wsf[32+crow(r,hi)]);
  bf16*Ow=O+(rowbase+q0+wid*QBLK)*OPITCH+h*D;
  { bf16*stg=(bf16*)(shm+LDS_OST)+wid*2048;
    #pragma unroll
    for(int r=0;r<16;++r){const int orow=crow(r,hi);
      #pragma unroll
      for(int d0=0;d0<2;++d0)stg[orow*64+d0*32+r32]=__float2bfloat16(o[d0][r]*rli[r]);}
    asm volatile("s_waitcnt lgkmcnt(0)":::"memory");
    #pragma unroll
    for(int i=0;i<4;++i){const int row=i*8+(lane>>3),ch=lane&7; const u32x4 v=*(const u32x4*)(stg+row*64+ch*8); ATTN_STORE16(Ow+(long)row*OPITCH+ch*8,v);} }
  asm volatile("s_waitcnt lgkmcnt(0)\n\ts_barrier":::"memory");
  #undef DMA_K
  #undef DMA_V
  #undef CMASK
  #undef KINIT
  #undef KLD
  #undef KSUB
  #undef KBP
  #undef START
  #undef RESC
  #undef ROT
}
constexpr int ATTN_LDS_BYTES=LDS_BYTES;
struct AttnTensors { const bf16* Q; const bf16* K; const bf16* V; bf16* O; const float* KB; };
template<int THRL=8> __device__ __forceinline__ void attn_phase(char*lds,const AttnTensors&T,float sbound,unsigned*qctr,int bx,int G){
  constexpr int NU=BATCH*NHEAD*NQB; int u=bx,nxoff=0;
  _Pragma("unroll 1") while(u<NU){ const int qb=NQB-1-u/(BATCH*NHEAD), bh=u%(BATCH*NHEAD);
    attn_unit<THRL>(bh/NHEAD,bh%NHEAD,qb,T.Q,T.K,T.V,T.O,T.KB,sbound,qctr,G,nxoff,lds);
    u=(int)*(volatile unsigned*)(lds+LDS_NXT+nxoff); u=__builtin_amdgcn_readfirstlane(u); nxoff^=4; }
}
#undef SBAR
#undef WAIT_BAR
}
namespace cg = cooperative_groups;
#define LAS __attribute__((address_space(3)))
typedef unsigned short bf16;
using pg8::f32x4; using pg8::u32x4; using pg8::Unit; using pg8::cvt_pk_bf16;
typedef unsigned u32x2 __attribute__((ext_vector_type(2)));

constexpr int NB = 16, SEQ = 4096, T = NB * SEQ, D = 1024, FF = 4096, INC = 5128, NIN = 5376, UP = 640, NLAYER = 2;
constexpr float EPS = 1e-6f, LOG2E = 1.4426950408889634f, C2Q = 0.125f * LOG2E;
enum { I_X = 0, I_MIXN, I_WIN, I_BF, I_QN, I_KN, I_ARE, I_AIM, I_LDT, I_BRE, I_BIM, I_CRE, I_CIM, I_SD, I_WGLU, I_PW, I_PS, I_WBA, I_WBS, I_WBP, I_BG, I_WOUT, I_MLPN, I_WUP, I_WDN, N_IN };

constexpr size_t MiB = 1u << 20;
constexpr size_t WL_STRIDE = 48 * MiB;
constexpr size_t WL_WIN = 0, WL_WA = 11 * MiB  , WL_WOUT = 13 * MiB, WL_WUP = 15 * MiB, WL_WDN = 23 * MiB,
                 WL_WGLU = 31 * MiB, WL_TZ = 32 * MiB, WL_MEND = 42 * MiB, WL_DL = 46 * MiB;
constexpr size_t WS_ACAT = 96 * MiB;
constexpr size_t WS_XB = 96 * MiB, WS_SSQ = 224 * MiB, WS_Q = 228 * MiB, WS_K = 292 * MiB, WS_V = 356 * MiB, WS_MERGED = WS_K, WS_U = 420 * MiB, WS_UPOOL = 460 * MiB,
                 WS_GATES = 492 * MiB, WS_FLOG = 876 * MiB, WS_KB = 878 * MiB, WS_S = 880 * MiB, WS_YPRE = 896 * MiB, WS_YSSM = 928 * MiB, WS_POOLED = 960 * MiB,
                 WS_DBG = 992 * MiB, WS_SSQ1 = 994 * MiB  , WS_END = 1001 * MiB, WS_ACT = WS_U;
static_assert(WS_ACT + (size_t)T * FF * 2 <= WS_POOLED && WS_MERGED + (size_t)T * D * 2 <= WS_ACT, "act overlay");
constexpr int LDS_BYTES = 147456;

constexpr int N_PHASES_ = 1 + 9 * NLAYER;
struct Params { const float* in[N_IN]; float* out; unsigned char* ws; int ph_lo, ph_hi, dbg, pad; };

__device__ __forceinline__ u32x4 pack8(f32x4 a, f32x4 b) { u32x4 w; w.x = cvt_pk_bf16(a[0], a[1]); w.y = cvt_pk_bf16(a[2], a[3]); w.z = cvt_pk_bf16(b[0], b[1]); w.w = cvt_pk_bf16(b[2], b[3]); return w; }
__device__ __forceinline__ void unpack8(u32x4 w, f32x4& a, f32x4& b) {
    a[0] = __uint_as_float(w.x << 16); a[1] = __uint_as_float(w.x & 0xffff0000u); a[2] = __uint_as_float(w.y << 16); a[3] = __uint_as_float(w.y & 0xffff0000u);
    b[0] = __uint_as_float(w.z << 16); b[1] = __uint_as_float(w.z & 0xffff0000u); b[2] = __uint_as_float(w.w << 16); b[3] = __uint_as_float(w.w & 0xffff0000u); }
__device__ __forceinline__ float bf2f(bf16 v) { return __uint_as_float((unsigned)v << 16); }
__device__ __forceinline__ float dot4(f32x4 a) { return (a[0] * a[0] + a[1] * a[1]) + (a[2] * a[2] + a[3] * a[3]); }
__device__ __forceinline__ float row_rstd(const float* ssq, int row) {
    const f32x4* p = (const f32x4*)(ssq + (size_t)row * 16); const f32x4 a = p[0], b = p[1], c = p[2], d = p[3];
    const float s = ((a[0] + a[1]) + (a[2] + a[3])) + ((b[0] + b[1]) + (b[2] + b[3])) + ((c[0] + c[1]) + (c[2] + c[3])) + ((d[0] + d[1]) + (d[2] + d[3]));
    return __builtin_amdgcn_rsqf(s * (1.0f / D) + EPS); }
__device__ __forceinline__ float sigm(float x) { return __builtin_amdgcn_rcpf(1.0f + __expf(-x)); }
__device__ __forceinline__ f32x4 sigm4(f32x4 x) { f32x4 r; r[0] = sigm(x[0]); r[1] = sigm(x[1]); r[2] = sigm(x[2]); r[3] = sigm(x[3]); return r; }
__device__ __forceinline__ f32x4 sigm4_fold(f32x4 a, float rsn, f32x4 bn) {
    f32x4 r;
#pragma unroll
    for (int e = 0; e < 4; ++e) r[e] = __builtin_amdgcn_rcpf(1.0f + __builtin_amdgcn_exp2f(a[e] * rsn + bn[e]));
    return r; }
__device__ __forceinline__ float gelu_t(float y) { const float z = 1.5957691216057308f * (y + 0.044715f * y * y * y); return y * __builtin_amdgcn_rcpf(1.0f + __expf(-z)); }
__device__ __forceinline__ f32x4 gelu4(f32x4 x) { f32x4 r; r[0] = gelu_t(x[0]); r[1] = gelu_t(x[1]); r[2] = gelu_t(x[2]); r[3] = gelu_t(x[3]); return r; }
__device__ __forceinline__ float logsig(float x) { return fminf(x, 0.f) - log1pf(__expf(-fabsf(x))); }

struct EpiIn {
    static constexpr bool PERM = true, AFTER_DRAIN = false, KEEP = false;
    bf16 *q, *k, *v, *U, *upool, *gates; float* flog; const float* ssq; const float *qg, *kg, *bgate, *bforget;
    __device__ __forceinline__ void operator()(const f32x4 (&acc)[2][2][4][2], const Unit& u, int wr, int wc, int fr, int fq) const {
        const int tile = u.pn, row0 = u.pm * 256 + wr * 64 + fr, cc0 = wc * 32 + 8 * fq;
        float rsv[2][4];
#pragma unroll
        for (int ai = 0; ai < 2; ++ai)
#pragma unroll
            for (int m = 0; m < 4; ++m) rsv[ai][m] = row_rstd(ssq, row0 + ai * 128 + m * 16);
        if (tile < 4) {
            const bool isq = tile < 2; const float* gp = (isq ? qg : kg) + 8 * fq; bf16* O = isq ? q : k; const int head = (tile & 1) * 4 + wc; const float sc = isq ? C2Q : 1.f;
            f32x4 g[2][2];
#pragma unroll
            for (int bj = 0; bj < 2; ++bj)
#pragma unroll
                for (int n = 0; n < 2; ++n) g[bj][n] = *(const f32x4*)(gp + 32 * bj + 4 * n);
#pragma unroll
            for (int ai = 0; ai < 2; ++ai)
#pragma unroll
                for (int m = 0; m < 4; ++m) { const int row = row0 + ai * 128 + m * 16; const float rs = rsv[ai][m];
                    f32x4 vv[2][2]; float ss = 0.f;
#pragma unroll
                    for (int bj = 0; bj < 2; ++bj)
#pragma unroll
                        for (int n = 0; n < 2; ++n) { vv[bj][n] = acc[ai][bj][m][n] * rs; ss += dot4(vv[bj][n]); }
                    ss += __shfl_xor(ss, 16); ss += __shfl_xor(ss, 32);
                    const float r = __builtin_amdgcn_rsqf(ss * (1.0f / 64.0f) + EPS) * sc;
#pragma unroll
                    for (int bj = 0; bj < 2; ++bj) *(u32x4*)(O + (size_t)row * 512 + head * 64 + 32 * bj + 8 * fq) = pack8(vv[bj][0] * r * g[bj][0], vv[bj][1] * r * g[bj][1]); __builtin_amdgcn_sched_barrier(0); }
        } else if (tile < 8) {
#pragma unroll
            for (int ai = 0; ai < 2; ++ai)
#pragma unroll
                for (int m = 0; m < 4; ++m) { const int row = row0 + ai * 128 + m * 16; const float rs = rsv[ai][m];
#pragma unroll
                    for (int bj = 0; bj < 2; ++bj) { const int cc = 128 * bj + cc0; bf16* dst;
                        if (tile < 6) dst = v + (size_t)row * 512 + (tile - 4) * 256 + cc;
                        else if (tile == 6) { const int g = cc >> 4, ci0 = cc & 15, b = row >> 12, s = row & 4095; dst = U + ((size_t)(g * 2048 + b * 128 + (s >> 5)) * UP + (s & 31) * 16 + ci0); }
                        else dst = upool + (size_t)row * 256 + cc;
                        *(u32x4*)dst = pack8(acc[ai][bj][m][0] * rs, acc[ai][bj][m][1] * rs); } __builtin_amdgcn_sched_barrier(0); }
        } else if (tile < 20) {
#pragma unroll
            for (int bj = 0; bj < 2; ++bj) { const int col = (tile - 8) * 256 + 128 * bj + cc0; const f32x4 b0 = *(const f32x4*)(bgate + col) * (-LOG2E), b1 = *(const f32x4*)(bgate + col + 4) * (-LOG2E);
#pragma unroll
                for (int ai = 0; ai < 2; ++ai)
#pragma unroll
                    for (int m = 0; m < 4; ++m) { const int row = row0 + ai * 128 + m * 16; const float rs = rsv[ai][m];
                        *(u32x4*)(gates + (size_t)row * 3072 + col) = pack8(sigm4_fold(acc[ai][bj][m][0], rs * (-LOG2E), b0), sigm4_fold(acc[ai][bj][m][1], rs * (-LOG2E), b1)); __builtin_amdgcn_sched_barrier(0); } }
        } else {
            if (wc == 0 && fq == 0) { const f32x4 b0 = *(const f32x4*)(bforget), b1 = *(const f32x4*)(bforget + 4);
#pragma unroll
                for (int ai = 0; ai < 2; ++ai)
#pragma unroll
                    for (int m = 0; m < 4; ++m) { const int row = row0 + ai * 128 + m * 16; const float rs = rsv[ai][m];
                        const f32x4 x0 = acc[ai][0][m][0] * rs + b0, x1 = acc[ai][0][m][1] * rs + b1; f32x4 o0, o1;
#pragma unroll
                        for (int e = 0; e < 4; ++e) { o0[e] = logsig(x0[e]); o1[e] = logsig(x1[e]); }
                        *(f32x4*)(flog + (size_t)row * 8) = o0; *(f32x4*)(flog + (size_t)row * 8 + 4) = o1; } }
        }
    }
};
struct EpiSend {
    static constexpr bool PERM = true, AFTER_DRAIN = false, KEEP = false;
    float* S;
    __device__ __forceinline__ void operator()(const f32x4 (&acc)[2][2][4][2], const Unit& u, int wr, int wc, int fr, int fq) const {
        const int row0 = u.pm * 256 + wr * 64 + fr, cc0 = wc * 32 + 8 * fq;
#pragma unroll
        for (int ai = 0; ai < 2; ++ai)
#pragma unroll
            for (int m = 0; m < 4; ++m) { float* p = S + (size_t)(row0 + ai * 128 + m * 16) * 128 + cc0; *(f32x4*)p = acc[ai][0][m][0]; *(f32x4*)(p + 4) = acc[ai][0][m][1]; }
    }
};
struct EpiSsmY {
    static constexpr bool PERM = true, AFTER_DRAIN = false, KEEP = false;
    const bf16* U; const float* sd; bf16* ypre;
    __device__ __forceinline__ void operator()(const f32x4 (&acc)[2][2][4][2], const Unit& u, int wr, int wc, int fr, int fq) const {
        const int g = u.pm >> 3, pnl = u.pn & 1, row0 = u.pm * 256 + wr * 64 + fr, cc0 = wc * 32 + 8 * fq;
        u32x4 uw[2][2][4];
#pragma unroll
        for (int bj = 0; bj < 2; ++bj)
#pragma unroll
            for (int ai = 0; ai < 2; ++ai)
#pragma unroll
                for (int m = 0; m < 4; ++m) uw[bj][ai][m] = *(const u32x4*)(U + (size_t)(row0 + ai * 128 + m * 16) * UP + pnl * 256 + 128 * bj + cc0);
#pragma unroll
        for (int bj = 0; bj < 2; ++bj) { const int colidx = pnl * 256 + 128 * bj + cc0, t = colidx >> 4, co0 = colidx & 15;
            const f32x4 d0 = *(const f32x4*)(sd + g * 16 + co0), d1 = *(const f32x4*)(sd + g * 16 + co0 + 4);
#pragma unroll
            for (int ai = 0; ai < 2; ++ai)
#pragma unroll
                for (int m = 0; m < 4; ++m) { const int grow = row0 + ai * 128 + m * 16, rl = grow & 2047, b = rl >> 7, c = rl & 127;
                    f32x4 ua, ub; unpack8(uw[bj][ai][m], ua, ub);
                    *(u32x4*)(ypre + (size_t)(b * 4096 + c * 32 + t) * 256 + g * 16 + co0) = pack8(gelu4(acc[ai][bj][m][0] + d0 * ua), gelu4(acc[ai][bj][m][1] + d1 * ub)); } }
    }
};
struct EpiGlu {
    static constexpr bool PERM = true, AFTER_DRAIN = false, KEEP = false;
    bf16* yssm;
    __device__ __forceinline__ void operator()(const f32x4 (&acc)[2][2][4][2], const Unit& u, int wr, int wc, int fr, int fq) const {
        const int row0 = u.pm * 256 + wr * 64 + fr, col = u.pn * 128 + wc * 32 + 8 * fq;
#pragma unroll
        for (int ai = 0; ai < 2; ++ai)
#pragma unroll
            for (int m = 0; m < 4; ++m) { const int row = row0 + ai * 128 + m * 16;
                *(u32x4*)(yssm + (size_t)row * 1024 + 512 + col) = pack8(acc[ai][0][m][0] * sigm4(acc[ai][1][m][0]), acc[ai][0][m][1] * sigm4(acc[ai][1][m][1])); __builtin_amdgcn_sched_barrier(0); }
    }
};
struct EpiGate3 {
    static constexpr bool PERM = true, AFTER_DRAIN = false, KEEP = true;
    const bf16* gates; bf16* merged;
    __device__ __forceinline__ bool keep(const Unit& u) const { return u.ko != 768; }
    __device__ __forceinline__ void operator()(f32x4 (&acc)[2][2][4][2], const Unit& u, int wr, int wc, int fr, int fq) const {
        const int row0 = u.pm * 256 + wr * 64 + fr, cc0 = wc * 32 + 8 * fq, gi = (u.ko == 0) ? 0 : (u.ko == 512) ? 1 : 2;
        const bf16* gp = gates + (size_t)row0 * 3072 + gi * 1024 + u.pn * 256 + cc0; bf16* mp = merged + (size_t)row0 * 1024 + u.pn * 256 + cc0;
#pragma unroll
        for (int ai = 0; ai < 2; ++ai) { u32x4 gw[4][2], hw[4][2];
#pragma unroll
            for (int m = 0; m < 4; ++m)
#pragma unroll
                for (int bj = 0; bj < 2; ++bj) { const bf16* p = gp + (size_t)(ai * 128 + m * 16) * 3072 + 128 * bj; gw[m][bj] = *(const u32x4*)p; if (gi != 2) hw[m][bj] = *(const u32x4*)(p + 1024); }
#pragma unroll
            for (int m = 0; m < 4; ++m)
#pragma unroll
                for (int bj = 0; bj < 2; ++bj) { f32x4 ga, gb; unpack8(gw[m][bj], ga, gb);
                    if (gi != 2) { f32x4 ha, hb; unpack8(hw[m][bj], ha, hb);
#pragma unroll
                        for (int e = 0; e < 4; ++e) { ga[e] *= __builtin_amdgcn_rcpf(fmaxf(ha[e], 1e-30f)); gb[e] *= __builtin_amdgcn_rcpf(fmaxf(hb[e], 1e-30f)); }
                        acc[ai][bj][m][0] *= ga; acc[ai][bj][m][1] *= gb; }
                    else *(u32x4*)(mp + (size_t)(ai * 128 + m * 16) * 1024 + 128 * bj) = pack8(acc[ai][bj][m][0] * ga, acc[ai][bj][m][1] * gb); } }
    }
};
struct TriOrder {
    pg8::StaticOrder S;
    __device__ __forceinline__ bool next(int i, Unit& u) const { const int ib = i / 3, gi = i - 3 * ib; if (!S.next(ib, u)) return false; u.ko = (gi == 0) ? 0 : (gi == 1) ? 512 : 768; u.nt = (gi == 0) ? 8 : 4; return true; }
    __device__ __forceinline__ void a_ready(const Unit&) const {}
    __device__ __forceinline__ void done(const Unit&) const {}
};
template <int MODE> struct EpiRes {
    static constexpr bool PERM = true, AFTER_DRAIN = false, KEEP = false;
    const float* xin; float* xout; bf16* xb; float* ssq; bool next; const float* ssq_in;
    __device__ __forceinline__ void operator()(const f32x4 (&acc)[2][2][4][2], const Unit& u, int wr, int wc, int fr, int fq) const {
        const int row0 = u.pm * 256 + wr * 64 + fr, cc0 = wc * 32 + 8 * fq; const size_t off0 = (size_t)row0 * 1024 + u.pn * 256 + cc0;
#pragma unroll
        for (int ai = 0; ai < 2; ++ai) { f32x4 ra[4][2], rb[4][2]; float rs2[4];
            if (MODE == 1) {
#pragma unroll
                for (int m = 0; m < 4; ++m) { const float r = row_rstd(ssq_in, row0 + ai * 128 + m * 16); rs2[m] = r * r; } }
#pragma unroll
            for (int m = 0; m < 4; ++m)
#pragma unroll
                for (int bj = 0; bj < 2; ++bj) { const size_t off = off0 + (size_t)(ai * 128 + m * 16) * 1024 + 128 * bj;
                    if (MODE == 0) { ra[m][bj] = *(const f32x4*)(xin + off); rb[m][bj] = *(const f32x4*)(xin + off + 4); } else unpack8(*(const u32x4*)(xb + off), ra[m][bj], rb[m][bj]); }
#pragma unroll
            for (int m = 0; m < 4; ++m) { const int row = row0 + ai * 128 + m * 16; float ss = 0.f;
#pragma unroll
                for (int bj = 0; bj < 2; ++bj) { const size_t off = off0 + (size_t)(ai * 128 + m * 16) * 1024 + 128 * bj;
                    const f32x4 a = (MODE == 1) ? ra[m][bj] + acc[ai][bj][m][0] * rs2[m] : ra[m][bj] + acc[ai][bj][m][0], b = (MODE == 1) ? rb[m][bj] + acc[ai][bj][m][1] * rs2[m] : rb[m][bj] + acc[ai][bj][m][1];
                    if (MODE == 1) { *(f32x4*)(xout + off) = a; *(f32x4*)(xout + off + 4) = b; }
                    if (MODE == 0 || next) { *(u32x4*)(xb + off) = pack8(a, b); ss += dot4(a) + dot4(b); } }
                if (MODE == 0 || next) { ss += __shfl_xor(ss, 16); ss += __shfl_xor(ss, 32); if (fq == 0) ssq[(size_t)row * 16 + u.pn * 4 + wc] = ss; } }
            __builtin_amdgcn_sched_barrier(0); }
    }
};
struct EpiUp {
    static constexpr bool PERM = true, AFTER_DRAIN = false, KEEP = false;
    bf16* act;
    __device__ __forceinline__ void operator()(const f32x4 (&acc)[2][2][4][2], const Unit& u, int wr, int wc, int fr, int fq) const {
        const int row0 = u.pm * 256 + wr * 64 + fr, cc0 = wc * 32 + 8 * fq;
#pragma unroll
        for (int ai = 0; ai < 2; ++ai)
#pragma unroll
            for (int m = 0; m < 4; ++m) { const int row = row0 + ai * 128 + m * 16;
#pragma unroll
                for (int bj = 0; bj < 2; ++bj) { f32x4 a = acc[ai][bj][m][0], b = acc[ai][bj][m][1];
#pragma unroll
                    for (int e = 0; e < 4; ++e) { const float x0 = fmaxf(a[e], 0.f), x1 = fmaxf(b[e], 0.f); a[e] = x0 * x0; b[e] = x1 * x1; }
                    *(u32x4*)(act + (size_t)row * FF + u.pn * 256 + 128 * bj + cc0) = pack8(a, b); } __builtin_amdgcn_sched_barrier(0); }
    }
};
__device__ __forceinline__ void flog_panel(const bf16* xb, const bf16* wf, const float* ssq, const float* bforget, float* flog, int pm, int wave, int lane) {
    typedef short bf16x8_t __attribute__((ext_vector_type(8)));
    const int fr = lane & 15, fq = lane >> 4, r0 = pm * 256 + wave * 32;
    const bf16* a0 = xb + (size_t)(r0 + fr) * D + 8 * fq; const bf16* a1 = a0 + (size_t)16 * D; const bf16* bp = wf + (size_t)fr * D + 8 * fq;
    f32x4 c0 = {0.f, 0.f, 0.f, 0.f}, c1 = c0;
#pragma unroll 8
    for (int ks = 0; ks < D / 32; ++ks) { const bf16x8_t bv = *(const bf16x8_t*)(bp + 32 * ks), x0 = *(const bf16x8_t*)(a0 + 32 * ks), x1 = *(const bf16x8_t*)(a1 + 32 * ks);
        c0 = __builtin_amdgcn_mfma_f32_16x16x32_bf16(bv, x0, c0, 0, 0, 0); c1 = __builtin_amdgcn_mfma_f32_16x16x32_bf16(bv, x1, c1, 0, 0, 0); }
    if (fq < 2) { const f32x4 bb = *(const f32x4*)(bforget + 4 * fq);
        const float rs0 = row_rstd(ssq, r0 + fr), rs1 = row_rstd(ssq, r0 + 16 + fr); f32x4 o0, o1;
#pragma unroll
        for (int e = 0; e < 4; ++e) { o0[e] = logsig(c0[e] * rs0 + bb[e]); o1[e] = logsig(c1[e] * rs1 + bb[e]); }
        *(f32x4*)(flog + (size_t)(r0 + fr) * 8 + 4 * fq) = o0; *(f32x4*)(flog + (size_t)(r0 + 16 + fr) * 8 + 4 * fq) = o1; }
}
struct BatchOrder {
    int nG, nMg, nNg, G, c;
    __device__ __forceinline__ bool next(int i, Unit& u) const { const long L = (long)i * G + c; if (L >= (long)nG * nMg * nNg) return false;
        const int l = (int)L, per = nMg * nNg, g = l / per, r = l % per; u.pm = g * nMg + (r % nMg); u.pn = g * nNg + (r / nMg); return true; }
    __device__ __forceinline__ void a_ready(const Unit&) const {}
    __device__ __forceinline__ void done(const Unit&) const {}
};

#define LDS_WAIT() asm volatile("s_waitcnt lgkmcnt(0)" ::: "memory")
__device__ __forceinline__ float wave_sum(float v) {
#pragma unroll
    for (int o = 1; o < 64; o <<= 1) v += __shfl_xor(v, o);
    return v; }
__device__ __forceinline__ unsigned f2bf(float f) { unsigned u = __builtin_bit_cast(unsigned, f); return (u + 0x7fffu + ((u >> 16) & 1u)) >> 16; }
__device__ __forceinline__ unsigned pk2(float lo, float hi) { return f2bf(lo) | (f2bf(hi) << 16); }
__device__ __forceinline__ int dst_row(int mode, int n) {
    if (mode == 1) {
        if (n < 1024) { const int base = n & ~511, nn = n & 511, h = nn >> 6, d = nn & 63; return base + (h >> 2) * 256 + (d >> 5) * 128 + (h & 3) * 32 + (d & 31); }
        if (n < 1536) return n;
        if (n < 1544) return 5120 + (n - 1536);
        return n - 8; }
    if (mode == 2) { const int hb = n >> 8, nn = n & 255; return (nn >> 7) * 256 + hb * 128 + (nn & 127); }
    return n; }
__device__ __forceinline__ void tr_item(const float* W, int K, int N, bf16* WT, int ldt, int mode, const float* ksc, LAS float* scr, int item, int lane) {
    const int nblk = (N + 31) / 32, kb = item / nblk, nb = item % nblk, k0 = 64 * kb, n0 = 32 * nb; const int nn = n0 + (lane & 31); const bool ok = nn < N;
#pragma unroll 8
    for (int i = 0; i < 32; ++i) { const int kk = 2 * i + (lane >> 5); float w = ok ? W[(size_t)(k0 + kk) * N + nn] : 0.f; if (ksc) w *= ksc[k0 + kk]; scr[kk * 33 + (lane & 31)] = w; }
    LDS_WAIT(); asm volatile("" ::: "memory");
    const int c = lane & 7;
#pragma unroll
    for (int j = 0; j < 4; ++j) { const int n = (lane >> 3) + 8 * j; const LAS float* s = scr + (8 * c) * 33 + n;
        u32x4 o; o.x = pk2(s[0 * 33], s[1 * 33]); o.y = pk2(s[2 * 33], s[3 * 33]); o.z = pk2(s[4 * 33], s[5 * 33]); o.w = pk2(s[6 * 33], s[7 * 33]);
        if (n0 + n < N) *(u32x4*)(WT + (size_t)dst_row(mode, n0 + n) * ldt + k0 + 8 * c) = o; }
    LDS_WAIT(); asm volatile("" ::: "memory");
}
__device__ __forceinline__ void sincos_d(double x, double& s, double& c) {
    const double q = rint(x * 0.6366197723675814); const int n = (int)q;
    double r = fma(-q, 1.5707963267948966, x); r = fma(-q, 6.123233995736766e-17, r);
    const double r2 = r * r;
    const double sp = r * (1.0 + r2 * (-1.0 / 6 + r2 * (1.0 / 120 + r2 * (-1.0 / 5040 + r2 * (1.0 / 362880 + r2 * (-1.0 / 39916800 + r2 * (1.0 / 6227020800.0)))))));
    const double cp = 1.0 + r2 * (-0.5 + r2 * (1.0 / 24 + r2 * (-1.0 / 720 + r2 * (1.0 / 40320 + r2 * (-1.0 / 3628800 + r2 * (1.0 / 479001600 + r2 * (-1.0 / 87178291200.0)))))));
    const int k = n & 3; s = (k == 0) ? sp : (k == 1) ? cp : (k == 2) ? -sp : -cp; c = (k == 0) ? cp : (k == 1) ? -sp : (k == 2) ? -cp : sp; }
__device__ __forceinline__ double exp_small_d(double x) {
    double r = 1.0 / 479001600; r = r * x + 1.0 / 39916800; r = r * x + 1.0 / 3628800; r = r * x + 1.0 / 362880; r = r * x + 1.0 / 40320; r = r * x + 1.0 / 5040; r = r * x + 1.0 / 720;
    r = r * x + 1.0 / 120; r = r * x + 1.0 / 24; r = r * x + 1.0 / 6; r = r * x + 0.5; r = r * x + 1.0; r = r * x + 1.0; return r; }

__device__ __forceinline__ void ssm_gen(const Params& P, int l, int g, LAS unsigned char* lds, int tid) {
    LAS float* Ap = (LAS float*)lds;
    LAS float* Bb = Ap + 33 * 128;
    LAS float* Cc = Bb + 2048;
    LAS float* Kl = Cc + 2048;
    LAS float* Cf = Kl + 8192;
    const float* are = P.in[I_ARE] + (size_t)l * 1024 + g * 64; const float* aim = P.in[I_AIM] + (size_t)l * 1024 + g * 64;
    const float* bre = P.in[I_BRE] + (size_t)l * 16384 + g * 1024; const float* bim = P.in[I_BIM] + (size_t)l * 16384 + g * 1024;
    const float* cre = P.in[I_CRE] + (size_t)l * 16384 + g * 1024; const float* cim = P.in[I_CIM] + (size_t)l * 16384 + g * 1024;
    bf16* Tz = (bf16*)(P.ws + l * WL_STRIDE + WL_TZ) + (size_t)g * 512 * UP; bf16* Me = (bf16*)(P.ws + l * WL_STRIDE + WL_MEND) + (size_t)g * 256 * 512;
    float* DL = (float*)(P.ws + l * WL_STRIDE + WL_DL) + g * 128;
    if (tid < 64) { const int n = tid; const double dt = (double)expf(P.in[I_LDT][l * 16 + g]); const double ar = (double)are[n], ai = (double)aim[n];
        const double mag = exp_small_d(ar * dt); double sn, cs; sincos_d(ai * dt, sn, cs); const double abr = mag * cs, abi = mag * sn, den = ar * ar + ai * ai, nr = abr - 1.0, ni = abi;
        Cf[2 * n] = (float)((nr * ar + ni * ai) / den); Cf[2 * n + 1] = (float)((ni * ar - nr * ai) / den);
        double pr = 1.0, pi = 0.0;
        for (int k = 0; k <= 32; ++k) { Ap[(k * 64 + n) * 2] = (float)pr; Ap[(k * 64 + n) * 2 + 1] = (float)pi; const double t = pr * abr - pi * abi; pi = pr * abi + pi * abr; pr = t; }
        DL[2 * n] = Ap[(32 * 64 + n) * 2]; DL[2 * n + 1] = Ap[(32 * 64 + n) * 2 + 1]; }
    __syncthreads();
    for (int e = tid; e < 1024; e += 512) { const int n = e >> 4; const float cr = Cf[2 * n], ci = Cf[2 * n + 1], br = bre[e], bi = bim[e];
        Bb[2 * e] = cr * br - ci * bi; Bb[2 * e + 1] = cr * bi + ci * br; Cc[2 * e] = cre[e]; Cc[2 * e + 1] = cim[e]; }
    __syncthreads();
    for (int e = tid; e < 8192; e += 512) { const int lag = e >> 8, co = (e >> 4) & 15, ci = e & 15; float s = 0.f;
        for (int n = 0; n < 64; ++n) { const float cr = Cc[(co * 64 + n) * 2], cI = Cc[(co * 64 + n) * 2 + 1], ar = Ap[(lag * 64 + n) * 2], aI = Ap[(lag * 64 + n) * 2 + 1];
            const float car = cr * ar - cI * aI, cai = cr * aI + cI * ar; s += car * Bb[(n * 16 + ci) * 2] - cai * Bb[(n * 16 + ci) * 2 + 1]; }
        Kl[e] = s; }
    __syncthreads();
    for (int ch = tid; ch < 512 * 80; ch += 512) { const int row = ch / 80, cq = ch % 80, t = row >> 4, co = row & 15; float v[8];
        if (cq < 64) { const int j = cq >> 1, ci0 = (cq & 1) * 8;
#pragma unroll
            for (int i = 0; i < 8; ++i) v[i] = (j <= t) ? Kl[(t - j) * 256 + co * 16 + ci0 + i] : 0.f;
        } else { const int n0 = (cq - 64) * 8;
#pragma unroll
            for (int i = 0; i < 8; ++i) { const int nn = n0 + i, n = nn & 63; const float cr = Cc[(co * 64 + n) * 2], cI = Cc[(co * 64 + n) * 2 + 1], ar = Ap[((t + 1) * 64 + n) * 2], aI = Ap[((t + 1) * 64 + n) * 2 + 1];
                v[i] = (nn < 64) ? (cr * ar - cI * aI) : -(cr * aI + cI * ar); } }
        u32x4 o; o.x = pk2(v[0], v[1]); o.y = pk2(v[2], v[3]); o.z = pk2(v[4], v[5]); o.w = pk2(v[6], v[7]); *(u32x4*)(Tz + (size_t)row * UP + cq * 8) = o; }
    for (int ch = tid; ch < 256 * 64; ch += 512) { const int row = ch >> 6, cq = ch & 63, j = cq >> 1, ci0 = (cq & 1) * 8; float v[8];
#pragma unroll
        for (int i = 0; i < 8; ++i) { const int n = row & 63; const float ar = Ap[((31 - j) * 64 + n) * 2], aI = Ap[((31 - j) * 64 + n) * 2 + 1], br = Bb[(n * 16 + ci0 + i) * 2], bI = Bb[(n * 16 + ci0 + i) * 2 + 1];
            v[i] = (row < 64) ? (ar * br - aI * bI) : (row < 128) ? (ar * bI + aI * br) : 0.f; }
        u32x4 o; o.x = pk2(v[0], v[1]); o.y = pk2(v[2], v[3]); o.z = pk2(v[4], v[5]); o.w = pk2(v[6], v[7]); *(u32x4*)(Me + (size_t)row * 512 + cq * 8) = o; }
    __syncthreads();
}
__device__ __forceinline__ void wp_item(const Params& P, int l, int item, int lane) {
    const int kc = item >> 4, nb = item & 15, k0 = kc * 8, g = k0 >> 6, c0 = k0 & 63, n = nb * 64 + lane;
    const float* pw = P.in[I_PW] + (size_t)l * 16384 + g * 4096 + c0 * 64; const float* ps = P.in[I_PS] + l * 256 + g * 64; const float* wb = P.in[I_WBP] + (size_t)l * 262144 + (size_t)(g * 64) * 1024 + n;
    float a[8] = {0, 0, 0, 0, 0, 0, 0, 0};
    for (int d = 0; d < 64; ++d) { const float w = wb[(size_t)d * 1024] * ps[d];
#pragma unroll
        for (int i = 0; i < 8; ++i) a[i] += pw[i * 64 + d] * w; }
    u32x4 o; o.x = pk2(a[0], a[1]); o.y = pk2(a[2], a[3]); o.z = pk2(a[4], a[5]); o.w = pk2(a[6], a[7]);
    *(u32x4*)((bf16*)(P.ws + l * WL_STRIDE + WL_WA) + (size_t)n * 1024 + 768 + k0) = o;
}
__device__ __forceinline__ void prologue(const Params& P, LAS unsigned char* lds, int tid, int lane, int wave, int bx, int G) {
    for (int it = bx; it < NLAYER * 16; it += G) ssm_gen(P, it >> 4, it & 15, lds, tid);
    __syncthreads();
    LAS float* scr = (LAS float*)(lds + wave * 16384);
    const int gw = bx * 8 + wave, NGW = G * 8;
    constexpr int I_IN = 16 * 161, I_A = 8 * 32, I_S = 4 * 32, I_O = 16 * 32, I_U = 16 * 128, I_D = 64 * 32, I_G = 4 * 16, I_P = 512, I_Z = 31, PER = I_IN + I_A + I_S + I_O + I_U + I_D + I_G + I_P + I_Z;
    const int nssm = (G > 2 * NLAYER * 16) ? NLAYER * 16 : 0;
    for (int it = (bx - nssm) * 8 + wave; bx >= nssm && it < NLAYER * PER; it += (G - nssm) * 8) { const int l = it / PER; int r = it % PER; unsigned char* wl = P.ws + l * WL_STRIDE;
        if (r < I_IN) { tr_item(P.in[I_WIN] + (size_t)l * D * INC, D, INC, (bf16*)(wl + WL_WIN), D, 1, P.in[I_MIXN] + l * D, scr, r, lane); continue; } r -= I_IN;
        if (r < I_A) { tr_item(P.in[I_WBA] + (size_t)l * 512 * D, 512, D, (bf16*)(wl + WL_WA), 1024, 0, nullptr, scr, r, lane); continue; } r -= I_A;
        if (r < I_S) { tr_item(P.in[I_WBS] + (size_t)l * 256 * D, 256, D, (bf16*)(wl + WL_WA) + 512, 1024, 0, nullptr, scr, r, lane); continue; } r -= I_S;
        if (r < I_O) { tr_item(P.in[I_WOUT] + (size_t)l * D * D, D, D, (bf16*)(wl + WL_WOUT), D, 0, nullptr, scr, r, lane); continue; } r -= I_O;
        if (r < I_U) { tr_item(P.in[I_WUP] + (size_t)l * D * FF, D, FF, (bf16*)(wl + WL_WUP), D, 0, P.in[I_MLPN] + l * D, scr, r, lane); continue; } r -= I_U;
        if (r < I_D) { tr_item(P.in[I_WDN] + (size_t)l * FF * D, FF, D, (bf16*)(wl + WL_WDN), FF, 0, nullptr, scr, r, lane); continue; } r -= I_D;
        if (r < I_G) { tr_item(P.in[I_WGLU] + (size_t)l * 256 * 512, 256, 512, (bf16*)(wl + WL_WGLU), 256, 2, nullptr, scr, r, lane); continue; } r -= I_G;
        if (r < I_P) { wp_item(P, l, r, lane); continue; } r -= I_P;
        { u32x4* z = (u32x4*)((bf16*)(wl + WL_WIN) + (size_t)(5128 + 8 * r) * D) + lane; const u32x4 zero = {0u, 0u, 0u, 0u};
#pragma unroll
          for (int i = 0; i < 16; ++i) z[64 * i] = zero; }
    }
    const float* x = P.in[I_X]; bf16* xb = (bf16*)(P.ws + WS_XB); float* ssq = (float*)(P.ws + WS_SSQ);
    for (int m0 = gw * 4; m0 < T; m0 += NGW * 4) {
        f32x4 v[4][4]; float sq[4];
#pragma unroll
        for (int r = 0; r < 4; ++r) { const f32x4* xr = (const f32x4*)(x + (size_t)(m0 + r) * D) + lane;
#pragma unroll
            for (int j = 0; j < 4; ++j) v[r][j] = xr[64 * j]; }
#pragma unroll
        for (int r = 0; r < 4; ++r) { float s = 0.f;
#pragma unroll
            for (int j = 0; j < 4; ++j) s += dot4(v[r][j]);
            sq[r] = wave_sum(s); }
#pragma unroll
        for (int r = 0; r < 4; ++r) { u32x2* o = (u32x2*)(xb + (size_t)(m0 + r) * D) + lane;
#pragma unroll
            for (int j = 0; j < 4; ++j) { u32x2 w; w.x = cvt_pk_bf16(v[r][j][0], v[r][j][1]); w.y = cvt_pk_bf16(v[r][j][2], v[r][j][3]); o[64 * j] = w; }
            if (lane < 16) ssq[(size_t)(m0 + r) * 16 + lane] = (lane == 0) ? sq[r] : 0.f; } }
}
__device__ __forceinline__ void fcum_seq(const float* flog, float* kb, int sq, LAS unsigned char* lds, int tid, int lane, int wave) {
    const int b = sq >> 3, h = sq & 7; LAS float* wt = (LAS float*)lds;
    float v[8]; float run = 0.f;
#pragma unroll
    for (int i = 0; i < 8; ++i) { run += flog[((size_t)b * SEQ + tid * 8 + i) * 8 + h]; v[i] = run; }
    float inc = run;
#pragma unroll
    for (int o = 1; o < 64; o <<= 1) { const float t = __shfl_up(inc, o); if (lane >= o) inc += t; }
    if (lane == 63) wt[wave] = inc;
    __syncthreads();
    float off = inc - run;
    for (int w = 0; w < wave; ++w) off += wt[w];
#pragma unroll
    for (int i = 0; i < 8; ++i) kb[(size_t)sq * SEQ + tid * 8 + i] = -LOG2E * (off + v[i]);
    __syncthreads();
}
template <int W> __device__ __forceinline__ void pool_item(const bf16* up, bf16* acat, int tok, int ch0) {
    const int s = tok & (SEQ - 1); f32x4 sa = {0.f, 0.f, 0.f, 0.f}, sb = sa, ca = sa, cb = sa; u32x4 r[W];
#pragma unroll
    for (int j = 0; j < W; ++j) r[j] = (j <= s) ? *(const u32x4*)(up + (size_t)(tok - ((j <= s) ? j : 0)) * 256 + ch0) : (u32x4){0u, 0u, 0u, 0u};
#pragma unroll
    for (int j = 0; j < W; ++j) { f32x4 a, b; unpack8(r[j], a, b); if (j == 0) { ca = a; cb = b; } sa += a; sb += b; }
    const float inv = 1.0f / (float)((s + 1 < W) ? s + 1 : W);
    *(u32x4*)(acat + (size_t)tok * 1024 + 768 + ch0) = pack8(sa * inv - ca, sb * inv - cb);
}
__device__ __forceinline__ void pool_pass(const bf16* up, bf16* acat, int gwave, int nwaves, int lane) {
    for (int wi = gwave; wi < (T / 8) * 4; wi += nwaves) { const int g = wi & 3, tok = (wi >> 2) * 8 + (lane >> 3), ch0 = g * 64 + (lane & 7) * 8;
        if (g == 0) pool_item<2>(up, acat, tok, ch0); else if (g == 1) pool_item<4>(up, acat, tok, ch0); else if (g == 2) pool_item<8>(up, acat, tok, ch0); else pool_item<16>(up, acat, tok, ch0); }
}
__device__ __forceinline__ void state_scan(const float* S, const float* DL, bf16* U, int gid) {
    const int g = gid >> 10, b = (gid >> 6) & 15, n = gid & 63; const float dr = DL[g * 128 + 2 * n], di = DL[g * 128 + 2 * n + 1];
    float xr = 0.f, xi = 0.f; const size_t r0 = (size_t)g * 2048 + b * 128;
#pragma unroll 8
    for (int c = 0; c < 128; ++c) { const float sr = S[(r0 + c) * 128 + n], si = S[(r0 + c) * 128 + 64 + n];
        U[(r0 + c) * UP + 512 + n] = (bf16)f2bf(xr); U[(r0 + c) * UP + 576 + n] = (bf16)f2bf(xi);
        const float t = dr * xr - di * xi + sr; xi = dr * xi + di * xr + si; xr = t; }
}

#define XB_TMO      128
#define XB_XCNT(j)  (256  + 64 * (j))
#define XB_XSUB(j)  (1280 + 64 * (j))
#define XB_XGEN(j)  (2304 + 64 * (j))
#define XB_TOP      3328
#define XB_TOPGEN   3392
#define XCD_BAR_WORDS 3456
#define XB_SPIN_CAP (1u << 18)

__device__ __forceinline__ unsigned xb_ld(unsigned* p)              { return __hip_atomic_load(p, __ATOMIC_RELAXED, __HIP_MEMORY_SCOPE_AGENT); }
__device__ __forceinline__ unsigned xb_add(unsigned* p, unsigned v) { return __hip_atomic_fetch_add(p, v, __ATOMIC_RELAXED, __HIP_MEMORY_SCOPE_AGENT); }
__device__ __forceinline__ unsigned xb_xcc_id() { return (unsigned)__builtin_amdgcn_s_getreg((3 << 11) | 20) & 0xFu; }
#define XB_SPIN(cond, bar) do { unsigned _sp = 0; while (cond) { __builtin_amdgcn_s_sleep(1); \
    if ((++_sp & 255u) == 0u) { if (xb_ld(&(bar)[XB_TMO])) break; if (_sp > XB_SPIN_CAP) { atomicAdd(&(bar)[XB_TMO], 1u); break; } } } } while (0)

struct XcdBarrier {
    unsigned* bar; unsigned x;
    volatile LAS unsigned* st;
};

__device__ __forceinline__ XcdBarrier xcd_barrier_post(unsigned* bar, volatile LAS unsigned* st) {
    XcdBarrier b; b.bar = bar; b.x = xb_xcc_id(); b.st = st;
    if (threadIdx.x == 0) (void)xb_add(&bar[XB_XCNT(b.x)], 1u);
    return b;
}
__device__ __forceinline__ void xcd_barrier_complete(unsigned* bar, unsigned x, unsigned& nloc, unsigned& nx) {
    const unsigned G = gridDim.x * gridDim.y * gridDim.z;
    unsigned sum, cnt, mine, sp = 0u;
    for (;;) {
        sum = 0u; cnt = 0u; mine = 0u;
#pragma unroll
        for (unsigned j = 0; j < 16; ++j) { const unsigned c = xb_ld(&bar[XB_XCNT(j)]); sum += c; cnt += (c > 0u) ? 1u : 0u; mine = (j == x) ? c : mine; }
        if (sum == G) break;
        __builtin_amdgcn_s_sleep(1);
        if ((++sp & 255u) == 0u) { if (xb_ld(&bar[XB_TMO])) break; if (sp > XB_SPIN_CAP) { atomicAdd(&bar[XB_TMO], 1u); break; } }
    }
    nloc = mine > 0u ? mine : 1u; nx = cnt > 0u ? cnt : 1u;
}

__device__ __forceinline__ void xcd_barrier(const XcdBarrier& b) {
    asm volatile("s_waitcnt vmcnt(0)" ::: "memory");
    __syncthreads();
    if (threadIdx.x == 0) {
        unsigned* bar = b.bar;
        __builtin_amdgcn_s_waitcnt(0);
        unsigned nloc = b.st[0], nx = b.st[1];
        if (nloc == 0u) { xcd_barrier_complete(bar, b.x, nloc, nx); b.st[0] = nloc; b.st[1] = nx; }
        const unsigned old = xb_add(&bar[XB_XSUB(b.x)], 1u);
        const unsigned gen = old / nloc;
        if (old + 1u == (gen + 1u) * nloc) {
            __builtin_amdgcn_fence(__ATOMIC_RELEASE, "agent");
            asm volatile("s_waitcnt vmcnt(0)" ::: "memory");
            const unsigned og = xb_add(&bar[XB_TOP], 1u);
            const unsigned tg = og / nx;
            if (og + 1u == (tg + 1u) * nx) xb_add(&bar[XB_TOPGEN], 1u);
            else XB_SPIN(xb_ld(&bar[XB_TOPGEN]) == tg, bar);
            __builtin_amdgcn_fence(__ATOMIC_ACQUIRE, "agent");
            xb_add(&bar[XB_XGEN(b.x)], 1u);
            asm volatile("s_waitcnt vmcnt(0)" ::: "memory");
        } else {
            XB_SPIN(xb_ld(&bar[XB_XGEN(b.x)]) == gen, bar);
            __builtin_amdgcn_fence(__ATOMIC_ACQUIRE, "agent");
            asm volatile("s_waitcnt vmcnt(0)" ::: "memory");
        }
    }
    __syncthreads();
}

constexpr size_t WS_BAR = 1000 * MiB;
#define GB_CNT(g) (4096 + 64 * (g))
__device__ __forceinline__ void group_barrier(unsigned* bar, volatile LAS unsigned* st, unsigned grp, unsigned nloc) {
    asm volatile("s_waitcnt vmcnt(0)" ::: "memory");
    __syncthreads();
    if (threadIdx.x == 0) {
        const unsigned k = st[2] + 1u; st[2] = k;
        __builtin_amdgcn_fence(__ATOMIC_RELEASE, "agent");
        asm volatile("s_waitcnt vmcnt(0)" ::: "memory");
        (void)xb_add(&bar[GB_CNT(grp)], 1u);
        const unsigned target = k * nloc;
        XB_SPIN(xb_ld(&bar[GB_CNT(grp)]) < target, bar);
        __builtin_amdgcn_fence(__ATOMIC_ACQUIRE, "agent");
        asm volatile("s_waitcnt vmcnt(0)" ::: "memory");
    }
    __syncthreads();
}
constexpr int LDS_BARST = 131072 + 1024;
#ifndef PHM
#define PHM 0x3ff
#endif
#ifndef PROBE
#define PROBE 0
#endif
typedef const __attribute__((address_space(4))) Params* KArgP;
__global__ void __launch_bounds__(512, 2) fwd_kernel(Params P) {
    extern __shared__ __attribute__((aligned(16))) unsigned char lds_raw[];
    cg::grid_group grid = cg::this_grid();
    LAS unsigned char* lds = (LAS unsigned char*)lds_raw;
    const int ph_lo = P.ph_lo, ph_hi = P.ph_hi;
    if (threadIdx.x < 4) ((volatile LAS unsigned*)(lds + LDS_BARST))[threadIdx.x] = 0u;
    __syncthreads();
#define PH_BEGIN() int tid = threadIdx.x; asm volatile("" : "+v"(tid)); const int lane = tid & 63, wave = __builtin_amdgcn_readfirstlane(tid >> 6); (void)lane; (void)wave; \
    KArgP pk = (KArgP)__builtin_amdgcn_kernarg_segment_ptr(); asm volatile("" : "+s"(pk)); unsigned char* const ws = pk->ws; unsigned char* const wl = ws + l * WL_STRIDE; (void)wl; \
    const int G = gridDim.x, bx = blockIdx.x; (void)G; (void)bx
#define RUN(k) (ph_lo <= (k) && (k) < ph_hi)
#define EN(j) ((PHM >> (j)) & 1)
#ifndef REP
#define REP 0
#endif
#define REPL(j) _Pragma("unroll 1") for (int rep_ = (((REP) >> (j)) & 1) ? 0 : 1; rep_ < 2; ++rep_)
#define STAMP(i) do { if (PROBE && blockIdx.x == 0 && threadIdx.x == 0) { KArgP pq = (KArgP)__builtin_amdgcn_kernarg_segment_ptr(); asm volatile("" : "+s"(pq)); ((unsigned long long*)(pq->ws + WS_DBG))[i] = __builtin_amdgcn_s_memrealtime(); } } while (0)
#define SEAM(k) do { if (RUN(k) && RUN((k) + 1)) { if ((k) == 0) { grid.sync(); KArgP pb = (KArgP)__builtin_amdgcn_kernarg_segment_ptr(); asm volatile("" : "+s"(pb)); (void)xcd_barrier_post((unsigned*)(pb->ws + WS_BAR), (volatile LAS unsigned*)(lds + LDS_BARST)); } \
        else { KArgP pb = (KArgP)__builtin_amdgcn_kernarg_segment_ptr(); asm volatile("" : "+s"(pb)); XcdBarrier xb_; xb_.bar = (unsigned*)(pb->ws + WS_BAR); xb_.x = xb_xcc_id(); xb_.st = (volatile LAS unsigned*)(lds + LDS_BARST); xcd_barrier(xb_); } } STAMP((k) + 1); } while (0)
#define WSP(T_, off) ((T_*)(ws + (off)))
#ifndef LOCAL_SEAMS
#define LOCAL_SEAMS 0
#endif
#define SEAM_L(k) do { if (LOCAL_SEAMS && (gridDim.x % 8u) == 0u) { if (RUN(k) && RUN((k) + 1)) { KArgP pb = (KArgP)__builtin_amdgcn_kernarg_segment_ptr(); asm volatile("" : "+s"(pb)); \
        group_barrier((unsigned*)(pb->ws + WS_BAR), (volatile LAS unsigned*)(lds + LDS_BARST), blockIdx.x % 8u, gridDim.x / 8u); } STAMP((k) + 1); } else SEAM(k); } while (0)
    STAMP(0);
#ifdef EXTRA_SYNC
    if (ph_hi - ph_lo > 1) { _Pragma("unroll 1") for (int i_ = 0; i_ < EXTRA_SYNC; ++i_) grid.sync(); }
#endif
    if (RUN(0) && EN(0)) { const int l = 0; PH_BEGIN(); if (bx == 0) { for (int i = tid; i < 8192 + 256; i += 512) ((unsigned*)(ws + WS_BAR))[i] = 0u;   } const Params& Pc = *(const Params*)pk; prologue(Pc, lds, tid, lane, wave, bx, G); }
    SEAM(0);
#pragma unroll 1
    for (int l = 0; l < NLAYER; ++l) {
        const int p0 = 1 + 9 * l;
        if (RUN(p0) && EN(1)) REPL(1) {
            PH_BEGIN();
            pg8::Gemm g{WSP(bf16, WS_XB), (const bf16*)(wl + WL_WIN), T, 5120, D, D, D}; pg8::StaticOrder S; S.init(T, 5120, G, bx);
            EpiIn E{WSP(bf16, WS_Q), WSP(bf16, WS_K), WSP(bf16, WS_V), WSP(bf16, WS_U), WSP(bf16, WS_UPOOL), WSP(bf16, WS_GATES), WSP(float, WS_FLOG), WSP(float, WS_SSQ),
                    pk->in[I_QN] + l * 64, pk->in[I_KN] + l * 64, pk->in[I_BG] + l * 3072, pk->in[I_BF] + l * 8};
            pg8::gemm_phase<EpiIn, pg8::StaticOrder, true, true>(lds, g, S, E);
            for (int pm = bx; pm < T / 256; pm += G) flog_panel(WSP(bf16, WS_XB), (const bf16*)(wl + WL_WIN) + (size_t)5120 * D, WSP(float, WS_SSQ), pk->in[I_BF] + l * 8, WSP(float, WS_FLOG), pm, wave, lane); }
        SEAM(p0);
        if (RUN(p0 + 1) && EN(2)) REPL(2) {
            PH_BEGIN();
            for (int sq = bx; sq < NB * 8; sq += G) fcum_seq(WSP(float, WS_FLOG), WSP(float, WS_KB), sq, lds, tid, lane, wave);
            pool_pass(WSP(bf16, WS_UPOOL), WSP(bf16, WS_ACAT), bx * 8 + wave, G * 8, lane);
            __syncthreads();
            pg8::Gemm g{WSP(bf16, WS_U), (const bf16*)(wl + WL_MEND), 16 * 2048, 16 * 256, 512, UP, 512}; BatchOrder S{16, 8, 1, G, bx};
            EpiSend E{WSP(float, WS_S)};
            pg8::gemm_phase<EpiSend, BatchOrder, true, true>(lds, g, S, E); }
        SEAM(p0 + 1);
        if (RUN(p0 + 2) && EN(3)) {
            { PH_BEGIN();
              for (int gid = bx * 512 + tid; gid < 16384; gid += G * 512) state_scan(WSP(float, WS_S), (const float*)(wl + WL_DL), WSP(bf16, WS_U), gid);
              __syncthreads(); }
            { PH_BEGIN();
              float sb; { const float qa = fabsf(pk->in[I_QN][l * 64 + lane]), ka = fabsf(pk->in[I_KN][l * 64 + lane]); float qm = qa, km = ka;
#pragma unroll
                  for (int o = 1; o < 64; o <<= 1) { qm = fmaxf(qm, __shfl_xor(qm, o)); km = fmaxf(km, __shfl_xor(km, o)); }
                  sb = __uint_as_float(__builtin_amdgcn_readfirstlane(__float_as_uint(64.0f * C2Q * qm * km * 1.02f + 1.0f))); }
              const attn_body::AttnTensors AT{WSP(const attn_body::bf16, WS_Q), WSP(const attn_body::bf16, WS_K), WSP(const attn_body::bf16, WS_V), WSP(attn_body::bf16, WS_ACAT), WSP(const float, WS_KB)};
              attn_body::attn_phase<8>((char*)lds_raw, AT, sb, (unsigned*)(ws + WS_BAR) + 8192 + 64 * l, bx, G); } }
        SEAM(p0 + 2);
        if (RUN(p0 + 3) && EN(4)) REPL(4) {
            PH_BEGIN();
            pg8::Gemm g{WSP(bf16, WS_U), (const bf16*)(wl + WL_TZ), 16 * 2048, 16 * 512, UP, UP, UP}; BatchOrder S{16, 8, 2, G, bx};
            EpiSsmY E{WSP(bf16, WS_U), pk->in[I_SD] + l * 256, WSP(bf16, WS_YPRE)};
            pg8::gemm_phase<EpiSsmY, BatchOrder, true, true>(lds, g, S, E); }
        SEAM(p0 + 3);
        if (RUN(p0 + 4) && EN(5)) REPL(5) {
            PH_BEGIN();
            pg8::Gemm g{WSP(bf16, WS_YPRE), (const bf16*)(wl + WL_WGLU), T, 512, 256, 256, 256}; pg8::StaticOrder S; S.init(T, 512, G, bx);
            EpiGlu E{WSP(bf16, WS_ACAT)};
            pg8::gemm_phase<EpiGlu, pg8::StaticOrder, true, true>(lds, g, S, E); }
        SEAM_L(p0 + 4);
        if (RUN(p0 + 5) && EN(6)) REPL(6) {
            PH_BEGIN(); TriOrder S; S.S.init(T, D, G, bx);
            pg8::Gemm g{WSP(bf16, WS_ACAT), (const bf16*)(wl + WL_WA), T, D, 512, 1024, 1024}; EpiGate3 E{WSP(bf16, WS_GATES), WSP(bf16, WS_MERGED)};
            pg8::gemm_phase<EpiGate3, TriOrder, true, true>(lds, g, S, E); }
        SEAM_L(p0 + 5);
        if (RUN(p0 + 6) && EN(7)) REPL(7) {
            PH_BEGIN();
            pg8::Gemm g{WSP(bf16, WS_MERGED), (const bf16*)(wl + WL_WOUT), T, D, D, D, D}; pg8::StaticOrder S; S.init(T, D, G, bx);
            EpiRes<0> E{(l == 0) ? pk->in[I_X] : (const float*)pk->out, nullptr, WSP(bf16, WS_XB), WSP(float, WS_SSQ1), true, nullptr};
            pg8::gemm_phase<EpiRes<0>, pg8::StaticOrder, true, true>(lds, g, S, E); }
        SEAM_L(p0 + 6);
        if (RUN(p0 + 7) && EN(8)) REPL(8) {
            PH_BEGIN();
            pg8::Gemm g{WSP(bf16, WS_XB), (const bf16*)(wl + WL_WUP), T, FF, D, D, D}; pg8::StaticOrder S; S.init(T, FF, G, bx);
            EpiUp E{WSP(bf16, WS_ACT)};
            pg8::gemm_phase<EpiUp, pg8::StaticOrder, true, true>(lds, g, S, E); }
        SEAM_L(p0 + 7);
        if (RUN(p0 + 8) && EN(9)) REPL(9) {
            PH_BEGIN();
            pg8::Gemm g{WSP(bf16, WS_ACT), (const bf16*)(wl + WL_WDN), T, D, FF, FF, FF}; pg8::StaticOrder S; S.init(T, D, G, bx);
            EpiRes<1> E{nullptr, pk->out, WSP(bf16, WS_XB), WSP(float, WS_SSQ), l + 1 < NLAYER, WSP(const float, WS_SSQ1)};
            pg8::gemm_phase<EpiRes<1>, pg8::StaticOrder, true, true>(lds, g, S, E); }
        SEAM(p0 + 8);
    }
#if PROBE
    grid.sync(); STAMP(N_PHASES_);
    if (blockIdx.x == 0) { KArgP pq = (KArgP)__builtin_amdgcn_kernarg_segment_ptr(); const unsigned long long* ts = (const unsigned long long*)(pq->ws + WS_DBG); float* out = pq->out;
        if (threadIdx.x == 0) out[0] = (float)(ts[PROBE_A1] - ts[PROBE_A0]) * 0.0025f; }
#endif
#undef RUN
#undef SEAM
}
constexpr int N_PHASES = 1 + 9 * NLAYER;

#ifndef MK_PER_PHASE
#define MK_PER_PHASE 0
#endif
extern "C" void kernel_launch(void* const* d_in, const int* in_sizes, int n_in, void* d_out, int out_size, void* d_ws, size_t ws_size, hipStream_t stream) {
    static int grid = 0;
    if (grid == 0) {
        if (n_in != N_IN || in_sizes[0] != T * D || out_size != T * D || ws_size < WS_END) { fprintf(stderr, "kernel_launch: unexpected shapes (n_in %d, in0 %d, out %d, ws %zu)\n", n_in, n_in > 0 ? in_sizes[0] : -1, out_size, ws_size); grid = -1; return; }
        int dev = 0, cus = 0, per_cu = 0;
        if (hipGetDevice(&dev) != hipSuccess || hipDeviceGetAttribute(&cus, hipDeviceAttributeMultiprocessorCount, dev) != hipSuccess) { grid = -1; return; }
        if (hipFuncSetAttribute((const void*)fwd_kernel, hipFuncAttributeMaxDynamicSharedMemorySize, LDS_BYTES) != hipSuccess) { fprintf(stderr, "kernel_launch: hipFuncSetAttribute failed\n"); grid = -1; return; }
        if (hipOccupancyMaxActiveBlocksPerMultiprocessor(&per_cu, (const void*)fwd_kernel, 512, LDS_BYTES) != hipSuccess || per_cu < 1) { fprintf(stderr, "kernel_launch: occupancy query says %d\n", per_cu); per_cu = 1; }
        (void)hipGetLastError();
        grid = cus;
    }
    if (grid < 0) return;
    Params p{};
    for (int i = 0; i < N_IN; ++i) p.in[i] = (const float*)d_in[i];
    p.out = (float*)d_out; p.ws = (unsigned char*)d_ws; p.dbg = 0; p.pad = 0;
#if MK_PER_PHASE
    for (int k = 0; k < N_PHASES; ++k) { p.ph_lo = k; p.ph_hi = k + 1; hipLaunchKernelGGL(fwd_kernel, dim3(grid), dim3(512), LDS_BYTES, stream, p); }
#else
    p.ph_lo = 0; p.ph_hi = N_PHASES;
    void* args[] = {&p};
    const hipError_t e = hipLaunchCooperativeKernel((const void*)fwd_kernel, dim3(grid), dim3(512), args, LDS_BYTES, stream);
    if (e != hipSuccess) fprintf(stderr, "kernel_launch: cooperative launch failed: %s (grid %d)\n", hipGetErrorString(e), grid);
#endif
}
```
